# Optimizing an MI355X kernel written in HIP

```python
import math
import jax, jax.numpy as jnp
from jax import lax
import numpy as np

D_MODEL = 1024
BATCH = 2
SEQ = 8192
DEPTH = 4

N_MIXERS = 2
N_HGRN_LAYERS = (DEPTH + 1) // 2
N_HYENA_LAYERS = DEPTH // 2
HG_EXPAND = 128
HG_HEADS = D_MODEL // HG_EXPAND
HG_DK = HG_EXPAND
HG_DV = D_MODEL // HG_HEADS
HG_CHUNK = 64
HY_SHORT_CONV = 3
HY_FILTER_WIDTH = 64
HY_FILTER_INNER = 2
HY_EMB_DIM = 33
HY_BANDS = (HY_EMB_DIM - 1) // 2
HY_MAX_DECAY = math.log(1e-2) / 0.3
HY_MIN_DECAY = math.log(1e-2) / 1.5
D_FF = 4 * D_MODEL
NORM_EPS = 1e-6

kernel_name = "hybrid_hgrn2_hyena_adaln_encoder"


def rms_norm(x, g):
    xf = x.astype(jnp.float32)
    y = xf * lax.rsqrt(jnp.mean(xf * xf, axis=-1, keepdims=True) + NORM_EPS)
    return (y * g.astype(jnp.float32)).astype(x.dtype)


def adaln_params(c, w, b):
    m = jax.nn.silu(c) @ w + b
    shift, scale, gate = jnp.split(m[:, None, :], 3, axis=-1)
    return shift, scale, gate


def gla_chunk_scan(q, k, v, log_f):
    n, L, H, DK = q.shape
    DV = v.shape[-1]
    C = HG_CHUNK
    nc = L // C

    def to_chunks(a):
        return a.reshape(n, nc, C, H, a.shape[-1]).transpose(1, 0, 3, 2, 4)

    qc, kc, vc, gc = to_chunks(q), to_chunks(k), to_chunks(v), to_chunks(log_f)
    bc = jnp.cumsum(gc, axis=-2)
    lower = jnp.tril(jnp.ones((C, C), dtype=bool))[:, :, None]

    def step(S, inp):
        qt, kt, vt, bt = inp
        rel = bt[:, :, :, None, :] - bt[:, :, None, :, :]
        decay = jnp.where(lower, jnp.exp(jnp.where(lower, rel, 0.0)), 0.0)
        attn = jnp.einsum('nhtd,nhsd,nhtsd->nhts', qt, kt, decay)
        o = (jnp.einsum('nhts,nhsv->nhtv', attn, vt)
             + jnp.einsum('nhtd,nhdv->nhtv', qt * jnp.exp(bt), S))
        b_end = bt[:, :, -1:, :]
        S = (jnp.exp(b_end[:, :, 0, :])[..., None] * S
             + jnp.einsum('nhsd,nhsv->nhdv', kt * jnp.exp(b_end - bt), vt))
        return S, o

    S0 = jnp.zeros((n, H, DK, DV), jnp.float32)
    _, o = lax.scan(step, S0, (qc, kc, vc, bc))
    return o.transpose(1, 0, 3, 2, 4).reshape(n, L, H, DV)


def hgrn2_mixer(h, w_in, lower_bound, norm_g, w_out):
    B, L, _ = h.shape
    proj = (h @ w_in).astype(jnp.float32)
    q, i, z_fwd, z_bwd, gate = jnp.split(proj, 5, axis=-1)
    q = jax.nn.silu(q)
    z = jnp.stack([z_fwd, z_bwd], axis=0)
    lb = lower_bound.astype(jnp.float32)[:, None, None, :]
    log_f = jnp.log(lb + (1.0 - lb) * jax.nn.sigmoid(z))
    k = (1.0 - lb) * jax.nn.sigmoid(-z)
    q2 = jnp.concatenate([q, q[:, ::-1]], axis=0)
    v2 = jnp.concatenate([i, i[:, ::-1]], axis=0)
    k2 = jnp.concatenate([k[0], k[1][:, ::-1]], axis=0)
    g2 = jnp.concatenate([log_f[0], log_f[1][:, ::-1]], axis=0)
    heads = lambda a: a.reshape(2 * B, L, HG_HEADS, -1)
    o = gla_chunk_scan(heads(q2), heads(k2), heads(v2), heads(g2))
    o = o[:B] + o[B:, ::-1]
    o = o * lax.rsqrt(jnp.mean(o * o, axis=-1, keepdims=True) + NORM_EPS)
    o = o * norm_g.astype(jnp.float32) * jax.nn.silu(gate.reshape(B, L, HG_HEADS, HG_DV))
    return (o.reshape(B, L, D_MODEL) @ w_out.astype(jnp.float32)).astype(h.dtype)


def short_conv_centred(u, w, b):
    up = jnp.pad(u, ((0, 0), (1, 1), (0, 0)))
    return up[:, :-2] * w[0] + up[:, 1:-1] * w[1] + up[:, 2:] * w[2] + b


def hyena_filter(L, w_in, w_mid, b, freq, w_out):
    f32 = jnp.float32
    t = jnp.linspace(0.0, 1.0, L, dtype=f32)[:, None]
    bands = jnp.linspace(1e-4, HY_BANDS - 1.0, HY_BANDS, dtype=f32)
    ang = (2.0 * math.pi / L) * jnp.arange(L, dtype=f32)[:, None] * bands
    emb = jnp.concatenate([t, jnp.cos(ang), -jnp.sin(ang)], axis=-1)
    freq = freq.astype(f32)
    b = b.astype(f32)
    hdn = jnp.sin(freq * (emb @ w_in.astype(f32) + b[0]))
    for m in range(HY_FILTER_INNER):
        hdn = jnp.sin(freq * (hdn @ w_mid[m].astype(f32) + b[m + 1]))
    hf = (hdn @ w_out.astype(f32)).reshape(L, 2, D_MODEL)
    deltas = jnp.abs(jnp.linspace(HY_MIN_DECAY, HY_MAX_DECAY, D_MODEL, dtype=f32))
    hf = hf * jnp.exp(-t * deltas)[:, None, :]
    h_fwd, h_bwd = hf[:, 0], hf[:, 1]
    return jnp.concatenate([h_fwd, jnp.zeros((1, D_MODEL), f32), h_bwd[:0:-1]], axis=0)


def hyena_mixer(h, w_in, b_in, conv_w, conv_b, f_w_in, f_w_mid, f_b, f_freq, f_w_out, skip, w_out):
    B, L, _ = h.shape
    u = short_conv_centred(h @ w_in + b_in, conv_w, conv_b)
    x0, x1, v = jnp.split(u, 3, axis=-1)
    z = (x1 * v).astype(jnp.float32)
    filt = hyena_filter(L, f_w_in, f_w_mid, f_b, f_freq, f_w_out)
    zf = jnp.fft.rfft(z, n=2 * L, axis=1)
    hf = jnp.fft.rfft(filt, axis=0)
    y = jnp.fft.irfft(zf * hf[None], n=2 * L, axis=1)[:, :L]
    y = y + skip.astype(jnp.float32) * z
    y = (x0.astype(jnp.float32) * y).astype(h.dtype)
    return y @ w_out


def setup_inputs(seed: int = 0) -> dict:
    key = jax.random.key(seed)
    ks = jax.random.split(key, 24)
    D, NA, NB, W = D_MODEL, N_HGRN_LAYERS, N_HYENA_LAYERS, HY_FILTER_WIDTH
    nrm = lambda k, s: jax.random.normal(k, s, jnp.float32)
    return {
        "x": nrm(ks[0], (BATCH, SEQ, D)),
        "c": nrm(ks[1], (BATCH, D)),
        "ada_w": nrm(ks[2], (DEPTH, 2, D, 3 * D)) * (0.5 * D ** -0.5),
        "ada_b": nrm(ks[3], (DEPTH, 2, 3 * D)) * 0.02,
        "norm_g": 1.0 + 0.02 * nrm(ks[4], (DEPTH, 2, D)),
        "hg_w_in": nrm(ks[5], (NA, D, 5 * D)) * D ** -0.5,
        "hg_lower_bounds": nrm(ks[6], (2, NA, D)) * 0.1,
        "hg_norm_g": 1.0 + 0.02 * nrm(ks[7], (NA, HG_DV)),
        "hg_w_out": nrm(ks[8], (NA, D, D)) * D ** -0.5,
        "hy_w_in": nrm(ks[9], (NB, D, 3 * D)) * D ** -0.5,
        "hy_b_in": nrm(ks[10], (NB, 3 * D)) * 0.02,
        "hy_conv_w": nrm(ks[11], (NB, HY_SHORT_CONV, 3 * D)) * HY_SHORT_CONV ** -0.5,
        "hy_conv_b": nrm(ks[12], (NB, 3 * D)) * 0.02,
        "hy_filt_w_in": nrm(ks[13], (NB, HY_EMB_DIM, W)) * HY_EMB_DIM ** -0.5,
        "hy_filt_w_mid": nrm(ks[14], (NB, HY_FILTER_INNER, W, W)) * W ** -0.5,
        "hy_filt_b": nrm(ks[15], (NB, HY_FILTER_INNER + 1, W)) * 0.1,
        "hy_filt_freq": 1.0 + 0.1 * nrm(ks[16], (NB, W)),
        "hy_filt_w_out": nrm(ks[17], (NB, W, 2 * D)) * (0.05 * W ** -0.5),
        "hy_skip": nrm(ks[18], (NB, D)),
        "hy_w_out": nrm(ks[19], (NB, D, D)) * D ** -0.5,
        "mlp_w1": nrm(ks[20], (DEPTH, D, D_FF)) * D ** -0.5,
        "mlp_w2": nrm(ks[21], (DEPTH, D_FF, D)) * D_FF ** -0.5,
        "final_g": 1.0 + 0.02 * nrm(ks[22], (D,)),
    }


def reference(x, c, ada_w, ada_b, norm_g, hg_w_in, hg_lower_bounds, hg_norm_g, hg_w_out,
              hy_w_in, hy_b_in, hy_conv_w, hy_conv_b, hy_filt_w_in, hy_filt_w_mid, hy_filt_b,
              hy_filt_freq, hy_filt_w_out, hy_skip, hy_w_out, mlp_w1, mlp_w2, final_g):
    lbs = jax.nn.softmax(hg_lower_bounds.astype(jnp.float32), axis=1)
    lbs = jnp.cumsum(lbs, axis=1) - lbs[:, :1]
    for i in range(DEPTH):
        j = i // N_MIXERS
        shift, scale, gate = adaln_params(c, ada_w[i, 0], ada_b[i, 0])
        hn = rms_norm(x, norm_g[i, 0]) * (1.0 + scale) + shift
        if i % N_MIXERS == 0:
            mix = hgrn2_mixer(hn, hg_w_in[j], lbs[:, j], hg_norm_g[j], hg_w_out[j])
        else:
            mix = hyena_mixer(hn, hy_w_in[j], hy_b_in[j], hy_conv_w[j], hy_conv_b[j],
                              hy_filt_w_in[j], hy_filt_w_mid[j], hy_filt_b[j], hy_filt_freq[j],
                              hy_filt_w_out[j], hy_skip[j], hy_w_out[j])
        x = x + gate * mix
        shift, scale, gate = adaln_params(c, ada_w[i, 1], ada_b[i, 1])
        hn = rms_norm(x, norm_g[i, 1]) * (1.0 + scale) + shift
        x = x + gate * (jnp.square(jax.nn.relu(hn @ mlp_w1[i])) @ mlp_w2[i])
    return rms_norm(x, final_g)
```

```cpp
#include <hip/hip_runtime.h>
#include <cstdio>
#include <cstdint>

#ifndef MK_PER_PHASE
#define MK_PER_PHASE 0
#endif

#define GAS __attribute__((address_space(1)))
#define LAS __attribute__((address_space(3)))
typedef unsigned short u16;
typedef float f32x4 __attribute__((ext_vector_type(4)));
typedef float f32x2 __attribute__((ext_vector_type(2)));
typedef short bf16x8 __attribute__((ext_vector_type(8)));
typedef unsigned u32x4 __attribute__((ext_vector_type(4)));
typedef unsigned u32x2 __attribute__((ext_vector_type(2)));
typedef _Float16 h16x2 __attribute__((ext_vector_type(2)));

constexpr int D = 1024, NB = 2, SEQ = 8192, M = NB * SEQ, DEPTH = 4, NH = 8, DK = 128, DV = 128, CH = 64, NCH = SEQ / CH, FF = 4096;
constexpr int FW = 64, EMB = 33;
constexpr float NORM_EPS = 1e-6f;
constexpr float HY_MAX_DECAY = -15.350567286626973f;
constexpr float HY_MIN_DECAY = -3.0701134573253946f;

constexpr size_t MiB = 1u << 20;
constexpr size_t WS_CTL = 0, CTL_ZERO_BYTES = 1 * MiB;
constexpr size_t WS_ADA = 1 * MiB;
constexpr size_t WS_HDN = 2 * MiB;
constexpr size_t WS_W = 8 * MiB;
constexpr size_t WS_WIN = WS_W, WS_WOUT = WS_W + 10 * MiB, WS_W1 = WS_W + 12 * MiB, WS_W2 = WS_W + 20 * MiB;
constexpr size_t WS_HN = 36 * MiB;
constexpr size_t WS_Q = 68 * MiB, WS_V = 100 * MiB, WS_GT = 132 * MiB, WS_GF = 164 * MiB, WS_GB = 196 * MiB, WS_S = 228 * MiB;
constexpr size_t WS_H = 228 * MiB;
constexpr size_t WS_U = 68 * MiB;
constexpr size_t WS_ZT = 164 * MiB;
constexpr size_t WS_FT = 228 * MiB;
constexpr size_t WS_HS = 292 * MiB;
constexpr size_t WS_END = 356 * MiB;
constexpr int CW_BAR = 4096;

constexpr int RING_BYTES = 131072;
constexpr int LDSCTL_OFF = RING_BYTES, MISC_OFF = LDSCTL_OFF + 320;
constexpr int LDS_BYTES = 147456;

__device__ __forceinline__ unsigned f2bf(float f) { unsigned u = __builtin_bit_cast(unsigned, f); return (u + 0x7fffu + ((u >> 16) & 1u)) >> 16; }
__device__ __forceinline__ unsigned pk2(float lo, float hi) { return f2bf(lo) | (f2bf(hi) << 16); }
__device__ __forceinline__ float bf2f(unsigned b) { return __builtin_bit_cast(float, b << 16); }
__device__ __forceinline__ unsigned pkh2(float lo, float hi) { h16x2 v; v.x = (_Float16)lo; v.y = (_Float16)hi; return __builtin_bit_cast(unsigned, v); }
__device__ __forceinline__ float h2f(unsigned short b) { return (float)__builtin_bit_cast(_Float16, b); }
__device__ __forceinline__ float sin_rev(float r) { return __builtin_amdgcn_sinf(r); }
__device__ __forceinline__ float cos_rev(float r) { return __builtin_amdgcn_cosf(r); }
__device__ __forceinline__ float fast_sin(float x) { float r = x * 0.15915494309189535f; r = r - floorf(r); return sin_rev(r); }
__device__ __forceinline__ float sigmoidf_(float x) { return 1.0f / (1.0f + __expf(-x)); }
__device__ __forceinline__ float siluf_(float x) { return x / (1.0f + __expf(-x)); }
__device__ __forceinline__ float wave_sum(float v) {
#pragma unroll
    for (int o = 1; o < 64; o <<= 1) v += __shfl_xor(v, o);
    return v;
}
#define LDS_WAIT() asm volatile("s_waitcnt lgkmcnt(0)" ::: "memory")

#define CAS __attribute__((address_space(4)))
__device__ __forceinline__ int opq_tid() { int t = threadIdx.x; asm volatile("" : "+v"(t)); return t; }
__device__ __forceinline__ int opq_s(int x) { asm volatile("" : "+s"(x)); return x; }
__device__ __forceinline__ const float* arg_in(int i) { const CAS char* p = (const CAS char*)__builtin_amdgcn_kernarg_segment_ptr(); asm volatile("" : "+s"(p)); return *(const float* const CAS*)(p + 8 * i); }
__device__ __forceinline__ float* arg_out() { const CAS char* p = (const CAS char*)__builtin_amdgcn_kernarg_segment_ptr(); asm volatile("" : "+s"(p)); return *(float* const CAS*)(p + 8 * 23); }
__device__ __forceinline__ unsigned char* arg_ws() { const CAS char* p = (const CAS char*)__builtin_amdgcn_kernarg_segment_ptr(); asm volatile("" : "+s"(p)); return *(unsigned char* const CAS*)(p + 8 * 24); }

namespace pg8 {
#define PG8_LAS __attribute__((address_space(3)))
typedef unsigned short bf16_t;
constexpr int BM = 256, BK = 64, HALF = 128, HTB = HALF * BK * 2, STAGE_BYTES = 8 * HTB, NXCD = 8, WGM = 8;
__host__ __device__ __forceinline__ int lds_byte(int r, int c) { const int st = (r >> 4) * 2 + (c >> 5), rr = r & 15, cc = c & 31, ob = rr * 64 + cc * 2; return st * 1024 + (ob ^ (((ob >> 9) & 1) << 5)); }
__host__ __device__ __forceinline__ void stage_rc(int b, int& R, int& C) { const int st = b / 1024, sb = b % 1024, swz = sb ^ (((sb >> 9) & 1) << 5); R = (st >> 1) * 16 + swz / 64; C = (st & 1) * 32 + (swz % 64) / 2; }
__host__ __device__ __forceinline__ int perm32(int rho) { const int n = rho >> 4, i = rho & 15; return 8 * (i >> 2) + 4 * n + (i & 3); }
struct Unit { int pm, pn; };
struct Gemm { const bf16_t* A; const bf16_t* Bt; int M, N, K; };
struct StaticOrder {
    int nM, nN, nwg, G, c;
    __host__ __device__ void init(int M_, int N_, int G_, int c_) { nM = M_ / BM; nN = N_ / BM; nwg = nM * nN; G = G_; c = c_; }
    __host__ __device__ bool next(int i, Unit& u) const {
        const long L = (long)i * G + c; if (L >= nwg) return false;
        int wgid = (int)L; { const int q = nwg / NXCD, r = nwg % NXCD, xcd = wgid % NXCD, off = wgid / NXCD; wgid = (xcd < r ? xcd * (q + 1) : r * (q + 1) + (xcd - r) * q) + off; }
        const int nig = WGM * nN, gid = wgid / nig, fm = gid * WGM, gsz = (nM - fm) < WGM ? (nM - fm) : WGM;
        u.pm = fm + ((wgid % nig) % gsz); u.pn = (wgid % nig) / gsz; return true;
    }
    __device__ __forceinline__ void a_ready(const Unit&) const {}
    __device__ __forceinline__ void done(const Unit&) const {}
};
__device__ __forceinline__ unsigned cvt_pk_bf16(float lo, float hi) { unsigned r; asm volatile("v_cvt_pk_bf16_f32 %0, %1, %2" : "=v"(r) : "v"(lo), "v"(hi)); return r; }

template <class Epi, class Sched, bool ALIGN_EPI = false, bool SP2 = false>
__device__ __forceinline__ void gemm_phase(PG8_LAS unsigned char* lds, const Gemm g, const Sched& S, const Epi& E) {
    const int tid = opq_tid(), wid = __builtin_amdgcn_readfirstlane(tid >> 6), lane = tid & 63, wr = wid >> 2, wc = wid & 3, fr = lane & 15, fq = lane >> 4;
    const int K = g.K, nt = K / BK;
    unsigned voffA[2], voffB[2];
#pragma unroll
    for (int i = 0; i < 2; ++i) { int R, C; stage_rc(tid * 16 + i * 8192, R, C); const int Rb = Epi::PERM ? ((R & ~31) + perm32(R & 31)) : R;
        voffA[i] = (unsigned)(R * K + C) * 2u; voffB[i] = (unsigned)(Rb * K + C) * 2u; }
    const size_t kstep = (size_t)(BK * 2);
    const size_t hstep = (size_t)HALF * K * 2;
    const size_t tstep = 2 * hstep;
    const unsigned ldsw = (unsigned)wid * 1024u;
    const int aoff = lds_byte(wr * 64 + fr, fq * 8), boff = lds_byte(wc * 32 + fr, fq * 8);
#define PG8_SA(b, h) (((b) * 2 + (h)) * HTB)
#define PG8_SB(b, h) ((4 + (b) * 2 + (h)) * HTB)
#define PG8_STAGE(bufoff, gbase, voff) do { _Pragma("unroll") for (int _i = 0; _i < 2; ++_i) \
        __builtin_amdgcn_global_load_lds((const unsigned*)((const char*)(gbase) + (voff)[_i]), (PG8_LAS unsigned*)(lds + (bufoff) + ldsw + _i * 8192), 16, 0, 0); } while (0)
#define PG8_LDA(dst, b, h) do { _Pragma("unroll") for (int m = 0; m < 4; ++m) _Pragma("unroll") for (int k = 0; k < 2; ++k) dst[m][k] = *(const PG8_LAS bf16x8*)(lds + PG8_SA(b, h) + aoff + m * 2048 + k * 1024); } while (0)
#define PG8_LDB(dst, b, h) do { _Pragma("unroll") for (int n = 0; n < 2; ++n) _Pragma("unroll") for (int k = 0; k < 2; ++k) dst[n][k] = *(const PG8_LAS bf16x8*)(lds + PG8_SB(b, h) + boff + n * 2048 + k * 1024); } while (0)
#define PG8_MMA(ai, bj, At, Bt) do { __builtin_amdgcn_s_setprio(1); _Pragma("unroll") for (int m = 0; m < 4; ++m) _Pragma("unroll") for (int n = 0; n < 2; ++n) _Pragma("unroll") for (int k = 0; k < 2; ++k) \
        acc[ai][bj][m][n] = __builtin_amdgcn_mfma_f32_16x16x32_bf16(Bt[n][k], At[m][k], acc[ai][bj][m][n], 0, 0, 0); __builtin_amdgcn_s_setprio(0); } while (0)
#define PG8_WAIT_V(n) asm volatile("s_waitcnt vmcnt(" #n ")" ::: "memory")
#define PG8_WAIT_L(n) asm volatile("s_waitcnt lgkmcnt(" #n ")" ::: "memory")
#define PG8_BAR __builtin_amdgcn_s_barrier()
#define PG8_SCHED __builtin_amdgcn_sched_barrier(0)
    Unit cur, nxt; int ui = 0;
    if (!S.next(0, cur)) return;
    f32x4 acc[2][2][4][2];
#pragma unroll
    for (int a = 0; a < 2; ++a)
#pragma unroll
        for (int b = 0; b < 2; ++b)
#pragma unroll
            for (int m = 0; m < 4; ++m)
#pragma unroll
                for (int n = 0; n < 2; ++n) acc[a][b][m][n] = (f32x4){0.f, 0.f, 0.f, 0.f};
    bf16x8 At[4][2], B0[2][2], B1[2][2];
    const char* cA = (const char*)g.A + (size_t)cur.pm * tstep; const char* cB = (const char*)g.Bt + (size_t)cur.pn * tstep;
    S.a_ready(cur);
    if constexpr (SP2) {
        PG8_STAGE(PG8_SB(0, 0), cB, voffB); PG8_STAGE(PG8_SB(0, 1), cB + hstep, voffB); PG8_STAGE(PG8_SA(0, 0), cA, voffA); PG8_STAGE(PG8_SA(0, 1), cA + hstep, voffA);
        if (wr == 1) PG8_BAR;
        PG8_WAIT_V(2); PG8_BAR;
        PG8_STAGE(PG8_SB(1, 0), cB + kstep, voffB); PG8_STAGE(PG8_SA(1, 0), cA + kstep, voffA); PG8_STAGE(PG8_SB(1, 1), cB + hstep + kstep, voffB);
        PG8_WAIT_V(6); PG8_BAR;
    } else {
        PG8_STAGE(PG8_SB(0, 0), cB, voffB); PG8_STAGE(PG8_SA(0, 0), cA, voffA); PG8_STAGE(PG8_SB(0, 1), cB + hstep, voffB); PG8_STAGE(PG8_SA(0, 1), cA + hstep, voffA);
        if (wr == 1) PG8_BAR;
        PG8_WAIT_V(4); PG8_BAR;
        PG8_STAGE(PG8_SB(1, 0), cB + kstep, voffB); PG8_STAGE(PG8_SA(1, 0), cA + kstep, voffA); PG8_STAGE(PG8_SB(1, 1), cB + hstep + kstep, voffB);
        PG8_WAIT_V(6); PG8_BAR;
    }
    for (;;) {
        const bool has_next = S.next(ui + 1, nxt);
        const char* nA = has_next ? (const char*)g.A + (size_t)nxt.pm * tstep : cA; const char* nB = has_next ? (const char*)g.Bt + (size_t)nxt.pn * tstep : cB;
        for (int t = 0; t < nt; t += 2) {
            const bool last = (t == nt - 2);
            const char* a1 = cA + (size_t)(t + 1) * kstep;
            const char* a2 = last ? nA : cA + (size_t)(t + 2) * kstep; const char* b2 = last ? nB : cB + (size_t)(t + 2) * kstep;
            const char* a3 = a2 + kstep; const char* b3 = b2 + kstep;
            if (last && has_next) S.a_ready(nxt);
            if constexpr (SP2) {
            PG8_LDB(B0, 0, 0); PG8_LDB(B1, 0, 1); PG8_SCHED; PG8_LDA(At, 0, 0); PG8_STAGE(PG8_SA(1, 1), a1 + hstep, voffA);
            PG8_WAIT_V(8); PG8_WAIT_L(0); PG8_BAR; PG8_MMA(0, 0, At, B0); PG8_MMA(0, 1, At, B1); PG8_BAR; PG8_SCHED;
            PG8_LDA(At, 0, 1); PG8_STAGE(PG8_SB(0, 0), b2, voffB); PG8_STAGE(PG8_SB(0, 1), b2 + hstep, voffB); PG8_STAGE(PG8_SA(0, 0), a2, voffA);
            PG8_WAIT_V(8); PG8_WAIT_L(0); PG8_BAR; PG8_MMA(1, 0, At, B0); PG8_MMA(1, 1, At, B1); PG8_BAR; PG8_SCHED;
            PG8_LDB(B0, 1, 0); PG8_LDB(B1, 1, 1); PG8_SCHED; PG8_LDA(At, 1, 0); PG8_STAGE(PG8_SA(0, 1), a2 + hstep, voffA);
            PG8_WAIT_V(8); PG8_WAIT_L(0); PG8_BAR; PG8_MMA(0, 0, At, B0); PG8_MMA(0, 1, At, B1); PG8_BAR; PG8_SCHED;
            PG8_LDA(At, 1, 1); PG8_STAGE(PG8_SB(1, 0), b3, voffB); PG8_STAGE(PG8_SB(1, 1), b3 + hstep, voffB); PG8_STAGE(PG8_SA(1, 0), a3, voffA);
            PG8_WAIT_V(8); PG8_WAIT_L(0); PG8_BAR; PG8_MMA(1, 0, At, B0); PG8_MMA(1, 1, At, B1); PG8_BAR; PG8_SCHED;
            } else {
            PG8_LDB(B0, 0, 0); PG8_SCHED; PG8_LDA(At, 0, 0); PG8_STAGE(PG8_SA(1, 1), a1 + hstep, voffA);
            PG8_WAIT_L(8); PG8_BAR; PG8_WAIT_L(0); PG8_MMA(0, 0, At, B0); PG8_BAR; PG8_SCHED;
            PG8_LDB(B1, 0, 1); PG8_STAGE(PG8_SB(0, 0), b2, voffB);
            PG8_BAR; PG8_WAIT_L(0); PG8_MMA(0, 1, At, B1); PG8_BAR;
            PG8_LDA(At, 0, 1); PG8_STAGE(PG8_SA(0, 0), a2, voffA);
            PG8_BAR; PG8_WAIT_L(0); PG8_MMA(1, 0, At, B0); PG8_BAR; PG8_SCHED;
            PG8_STAGE(PG8_SB(0, 1), b2 + hstep, voffB);
            PG8_WAIT_V(6); PG8_BAR; PG8_MMA(1, 1, At, B1); PG8_BAR;
            PG8_LDB(B0, 1, 0); PG8_SCHED; PG8_LDA(At, 1, 0); PG8_STAGE(PG8_SA(0, 1), a2 + hstep, voffA);
            PG8_WAIT_L(8); PG8_BAR; PG8_WAIT_L(0); PG8_MMA(0, 0, At, B0); PG8_BAR; PG8_SCHED;
            PG8_LDB(B1, 1, 1); PG8_STAGE(PG8_SB(1, 0), b3, voffB);
            PG8_BAR; PG8_WAIT_L(0); PG8_MMA(0, 1, At, B1); PG8_BAR;
            PG8_LDA(At, 1, 1); PG8_STAGE(PG8_SA(1, 0), a3, voffA);
            PG8_BAR; PG8_WAIT_L(0); PG8_MMA(1, 0, At, B0); PG8_BAR; PG8_SCHED;
            PG8_STAGE(PG8_SB(1, 1), b3 + hstep, voffB);
            PG8_WAIT_V(6); PG8_BAR; PG8_MMA(1, 1, At, B1); PG8_BAR;
            }
        }
        if constexpr (ALIGN_EPI) { if (wr == 0) PG8_BAR; }
        E(acc, cur, wr, wc, fr, fq); S.done(cur);
        if (!has_next) break;
#pragma unroll
        for (int a = 0; a < 2; ++a)
#pragma unroll
            for (int b = 0; b < 2; ++b)
#pragma unroll
                for (int m = 0; m < 4; ++m)
#pragma unroll
                    for (int n = 0; n < 2; ++n) acc[a][b][m][n] = (f32x4){0.f, 0.f, 0.f, 0.f};
        cur = nxt; cA = nA; cB = nB; ++ui;
        if constexpr (ALIGN_EPI) { if (wr == 1) PG8_BAR; }
    }
    PG8_WAIT_V(0);
    if constexpr (!ALIGN_EPI) { if (wr == 0) PG8_BAR; }
    PG8_BAR;
#undef PG8_SA
#undef PG8_SB
#undef PG8_STAGE
#undef PG8_LDA
#undef PG8_LDB
#undef PG8_MMA
#undef PG8_WAIT_V
#undef PG8_WAIT_L
#undef PG8_BAR
#undef PG8_SCHED
}

struct EpiResid {
    static constexpr bool PERM = false, AFTER_DRAIN = false;
    const float* xin; float* xout; const float* gate;
    __device__ __forceinline__ void operator()(const f32x4 (&acc)[2][2][4][2], const Unit& u, int wr, int wc, int fr, int fq) const {
        const int row0 = u.pm * BM + wr * 64 + fr, col0 = u.pn * BM + wc * 32 + 4 * fq;
        const float* gp = gate + (u.pm >= (SEQ / BM) ? 3 * D : 0);
        f32x4 gv[2][2];
#pragma unroll
        for (int bj = 0; bj < 2; ++bj)
#pragma unroll
            for (int n = 0; n < 2; ++n) gv[bj][n] = *(const f32x4*)(gp + col0 + bj * HALF + n * 16);
#pragma unroll
        for (int ai = 0; ai < 2; ++ai)
#pragma unroll
            for (int m = 0; m < 4; ++m) { const size_t off = (size_t)(row0 + ai * HALF + m * 16) * D + col0;
#pragma unroll
                for (int bj = 0; bj < 2; ++bj)
#pragma unroll
                    for (int n = 0; n < 2; ++n) { const f32x4 xi = *(const f32x4*)(xin + off + bj * HALF + n * 16);
                        *(f32x4*)(xout + off + bj * HALF + n * 16) = xi + gv[bj][n] * acc[ai][bj][m][n]; } }
    }
};
struct EpiRelu2 {
    static constexpr bool PERM = true, AFTER_DRAIN = false;
    bf16_t* O; int ldc;
    __device__ __forceinline__ void operator()(const f32x4 (&acc)[2][2][4][2], const Unit& u, int wr, int wc, int fr, int fq) const {
        const int row0 = u.pm * BM + wr * 64 + fr, col0 = u.pn * BM + wc * 32 + 8 * fq;
#pragma unroll
        for (int ai = 0; ai < 2; ++ai)
#pragma unroll
            for (int m = 0; m < 4; ++m) { bf16_t* rowp = O + (size_t)(row0 + ai * HALF + m * 16) * ldc + col0;
#pragma unroll
                for (int bj = 0; bj < 2; ++bj) { f32x4 v0 = acc[ai][bj][m][0], v1 = acc[ai][bj][m][1];
#pragma unroll
                    for (int j = 0; j < 4; ++j) { const float a = fmaxf(v0[j], 0.f), b = fmaxf(v1[j], 0.f); v0[j] = a * a; v1[j] = b * b; }
                    u32x4 w; w.x = cvt_pk_bf16(v0[0], v0[1]); w.y = cvt_pk_bf16(v0[2], v0[3]); w.z = cvt_pk_bf16(v1[0], v1[1]); w.w = cvt_pk_bf16(v1[2], v1[3]);
                    *(u32x4*)(rowp + bj * HALF) = w; } }
    }
};
struct EpiBias {
    static constexpr bool PERM = true, AFTER_DRAIN = false;
    bf16_t* O; int ldc; const float* bias;
    __device__ __forceinline__ void operator()(const f32x4 (&acc)[2][2][4][2], const Unit& u, int wr, int wc, int fr, int fq) const {
        const int row0 = u.pm * BM + wr * 64 + fr, col0 = u.pn * BM + wc * 32 + 8 * fq;
        f32x4 bv[2][2];
#pragma unroll
        for (int bj = 0; bj < 2; ++bj)
#pragma unroll
            for (int n = 0; n < 2; ++n) bv[bj][n] = *(const f32x4*)(bias + col0 + bj * HALF + 4 * n);
#pragma unroll
        for (int ai = 0; ai < 2; ++ai)
#pragma unroll
            for (int m = 0; m < 4; ++m) { bf16_t* rowp = O + (size_t)(row0 + ai * HALF + m * 16) * ldc + col0;
#pragma unroll
                for (int bj = 0; bj < 2; ++bj) { const f32x4 v0 = acc[ai][bj][m][0] + bv[bj][0], v1 = acc[ai][bj][m][1] + bv[bj][1];
                    u32x4 w; w.x = cvt_pk_bf16(v0[0], v0[1]); w.y = cvt_pk_bf16(v0[2], v0[3]); w.z = cvt_pk_bf16(v1[0], v1[1]); w.w = cvt_pk_bf16(v1[2], v1[3]);
                    *(u32x4*)(rowp + bj * HALF) = w; } }
    }
};
struct EpiHgIn {
    static constexpr bool PERM = true, AFTER_DRAIN = false;
    bf16_t *Q, *V, *GT, *GF, *GB; const float* lbraw; int jl;
    __device__ __forceinline__ void operator()(const f32x4 (&acc)[2][2][4][2], const Unit& u, int wr, int wc, int fr, int fq) const {
        const int sec = u.pn >> 2;
        const int row0 = u.pm * BM + wr * 64 + fr, col0 = (u.pn & 3) * BM + wc * 32 + 8 * fq;
        bf16_t* base = sec == 0 ? Q : sec == 1 ? V : sec == 2 ? GF : sec == 3 ? GB : GT;
        float lb[2][8];
#pragma unroll
        for (int bj = 0; bj < 2; ++bj)
#pragma unroll
            for (int j = 0; j < 8; ++j) lb[bj][j] = 0.f;
        if ((sec == 2 || sec == 3) && jl == 1) {
            const float* r0 = lbraw + (size_t)(sec - 2) * 2 * D;
#pragma unroll
            for (int bj = 0; bj < 2; ++bj)
#pragma unroll
                for (int j = 0; j < 8; ++j) { const int c = col0 + bj * HALF + j; const float a0 = r0[c], a1 = r0[D + c]; lb[bj][j] = 1.0f / (1.0f + __expf(a0 - a1));   }
        }
#pragma unroll
        for (int ai = 0; ai < 2; ++ai)
#pragma unroll
            for (int m = 0; m < 4; ++m) { bf16_t* rowp = base + (size_t)(row0 + ai * HALF + m * 16) * D + col0;
#pragma unroll
                for (int bj = 0; bj < 2; ++bj) { float v[8];
#pragma unroll
                    for (int j = 0; j < 4; ++j) { v[j] = acc[ai][bj][m][0][j]; v[4 + j] = acc[ai][bj][m][1][j]; }
                    u32x4 w;
                    if (sec == 0 || sec == 4) {
#pragma unroll
                        for (int j = 0; j < 8; ++j) v[j] = siluf_(v[j]);
                        w.x = cvt_pk_bf16(v[0], v[1]); w.y = cvt_pk_bf16(v[2], v[3]); w.z = cvt_pk_bf16(v[4], v[5]); w.w = cvt_pk_bf16(v[6], v[7]);
                    } else if (sec == 1) {
                        w.x = cvt_pk_bf16(v[0], v[1]); w.y = cvt_pk_bf16(v[2], v[3]); w.z = cvt_pk_bf16(v[4], v[5]); w.w = cvt_pk_bf16(v[6], v[7]);
                    } else {
#pragma unroll
                        for (int j = 0; j < 8; ++j) { const float l = lb[bj][j]; const float f = l + (1.0f - l) * sigmoidf_(v[j]); v[j] = fmaxf(__logf(f), -100.0f); }
                        w.x = pkh2(v[0], v[1]); w.y = pkh2(v[2], v[3]); w.z = pkh2(v[4], v[5]); w.w = pkh2(v[6], v[7]);
                    }
                    *(u32x4*)(rowp + bj * HALF) = w; } }
    }
};
}

#define XB_TMO      128
#define XB_XCNT(j)  (256  + 64 * (j))
#define XB_XSUB(j)  (1280 + 64 * (j))
#define XB_XGEN(j)  (2304 + 64 * (j))
#define XB_TOP      3328
#define XB_TOPGEN   3392
#define XCD_BAR_WORDS 3456
#define XB_SPIN_CAP (1u << 18)
__device__ __forceinline__ unsigned xb_ld(unsigned* p)              { return __hip_atomic_load(p, __ATOMIC_RELAXED, __HIP_MEMORY_SCOPE_AGENT); }
__device__ __forceinline__ unsigned xb_add(unsigned* p, unsigned v) { return __hip_atomic_fetch_add(p, v, __ATOMIC_RELAXED, __HIP_MEMORY_SCOPE_AGENT); }
__device__ __forceinline__ unsigned xb_xcc_id() { return (unsigned)__builtin_amdgcn_s_getreg((3 << 11) | 20) & 0xFu; }
#define XB_SPIN(cond, bar) do { unsigned _sp = 0; while (cond) { __builtin_amdgcn_s_sleep(1); \
    if ((++_sp & 255u) == 0u) { if (xb_ld(&(bar)[XB_TMO])) break; if (_sp > XB_SPIN_CAP) { atomicAdd(&(bar)[XB_TMO], 1u); break; } } } } while (0)
struct XcdBarrier { unsigned* bar; unsigned x; volatile LAS unsigned* st; };
__device__ __forceinline__ XcdBarrier xcd_barrier_post(unsigned* bar, volatile LAS unsigned* st) {
    XcdBarrier b; b.bar = bar; b.x = xb_xcc_id(); b.st = st;
    if (threadIdx.x == 0) (void)xb_add(&bar[XB_XCNT(b.x)], 1u);
    return b;
}
__device__ __forceinline__ void xcd_barrier_complete(unsigned* bar, unsigned x, unsigned& nloc, unsigned& nx) {
    const unsigned G = gridDim.x * gridDim.y * gridDim.z;
    unsigned sum, cnt, mine, sp = 0u;
    for (;;) {
        sum = 0u; cnt = 0u; mine = 0u;
#pragma unroll
        for (unsigned j = 0; j < 16; ++j) { const unsigned c = xb_ld(&bar[XB_XCNT(j)]); sum += c; cnt += (c > 0u) ? 1u : 0u; mine = (j == x) ? c : mine; }
        if (sum == G) break;
        __builtin_amdgcn_s_sleep(1);
        if ((++sp & 255u) == 0u) { if (xb_ld(&bar[XB_TMO])) break; if (sp > XB_SPIN_CAP) { atomicAdd(&bar[XB_TMO], 1u); break; } }
    }
    nloc = mine > 0u ? mine : 1u; nx = cnt > 0u ? cnt : 1u;
}
__device__ __forceinline__ void xcd_barrier(const XcdBarrier& b) {
    asm volatile("s_waitcnt vmcnt(0)" ::: "memory");
    __syncthreads();
    if (threadIdx.x == 0) {
        unsigned* bar = b.bar;
        __builtin_amdgcn_s_waitcnt(0);
        unsigned nloc = b.st[0], nx = b.st[1];
        if (nloc == 0u) { xcd_barrier_complete(bar, b.x, nloc, nx); b.st[0] = nloc; b.st[1] = nx; }
        const unsigned old = xb_add(&bar[XB_XSUB(b.x)], 1u);
        const unsigned gen = old / nloc;
        if (old + 1u == (gen + 1u) * nloc) {
            __builtin_amdgcn_fence(__ATOMIC_RELEASE, "agent");
            asm volatile("s_waitcnt vmcnt(0)" ::: "memory");
            const unsigned og = xb_add(&bar[XB_TOP], 1u);
            const unsigned tg = og / nx;
            if (og + 1u == (tg + 1u) * nx) xb_add(&bar[XB_TOPGEN], 1u);
            else XB_SPIN(xb_ld(&bar[XB_TOPGEN]) == tg, bar);
            __builtin_amdgcn_fence(__ATOMIC_ACQUIRE, "agent");
            xb_add(&bar[XB_XGEN(b.x)], 1u);
            asm volatile("s_waitcnt vmcnt(0)" ::: "memory");
        } else {
            XB_SPIN(xb_ld(&bar[XB_XGEN(b.x)]) == gen, bar);
            __builtin_amdgcn_fence(__ATOMIC_ACQUIRE, "agent");
            asm volatile("s_waitcnt vmcnt(0)" ::: "memory");
        }
    }
    __syncthreads();
}

__device__ __forceinline__ void transpose_item(const float* W, int K, int N, u16* WT, LAS float* scr, int item, int lane) {
    const int nblk = N / 32, kb = item / nblk, nb = item % nblk, k0 = 64 * kb, n0 = 32 * nb;
#pragma unroll 8
    for (int i = 0; i < 32; ++i) { const int kk = 2 * i + (lane >> 5); scr[kk * 33 + (lane & 31)] = W[(size_t)(k0 + kk) * N + n0 + (lane & 31)]; }
    LDS_WAIT(); asm volatile("" ::: "memory");
    const int c = lane & 7;
#pragma unroll
    for (int j = 0; j < 4; ++j) { const int n = (lane >> 3) + 8 * j; const LAS float* s = scr + (8 * c) * 33 + n;
        u32x4 o; o.x = pk2(s[0 * 33], s[1 * 33]); o.y = pk2(s[2 * 33], s[3 * 33]); o.z = pk2(s[4 * 33], s[5 * 33]); o.w = pk2(s[6 * 33], s[7 * 33]);
        *(u32x4*)(WT + (size_t)(n0 + n) * K + k0 + 8 * c) = o; }
    LDS_WAIT(); asm volatile("" ::: "memory");
}
__device__ __forceinline__ void convert_weights(const float* w0, int K0, int N0, u16* o0, const float* w1, int K1, int N1, u16* o1, const float* w2, int K2, int N2, u16* o2,
                                                const float* w3, int K3, int N3, u16* o3, LAS float* scr, int gw, int NGW, int lane) {
    const int I0 = (K0 / 64) * (N0 / 32), I1 = (K1 / 64) * (N1 / 32), I2 = (K2 / 64) * (N2 / 32), I3 = (K3 / 64) * (N3 / 32);
    for (int it = gw; it < I0 + I1 + I2 + I3; it += NGW) {
        int r = it;
        if (r < I0) { transpose_item(w0, K0, N0, o0, scr, r, lane); continue; } r -= I0;
        if (r < I1) { transpose_item(w1, K1, N1, o1, scr, r, lane); continue; } r -= I1;
        if (r < I2) { transpose_item(w2, K2, N2, o2, scr, r, lane); continue; } r -= I2;
        transpose_item(w3, K3, N3, o3, scr, r, lane);
    }
}
__device__ __forceinline__ void norm_rows(const float* x, const float* g, const float* ada, u16* hn, int gw, int NGW, int lane) {
    for (int m = gw; m < M; m += NGW) {
        const int b = m >> 13;
        const f32x4* xr = (const f32x4*)(x + (size_t)m * D) + lane;
        f32x4 v[4]; float s = 0.f;
#pragma unroll
        for (int j = 0; j < 4; ++j) { v[j] = xr[64 * j]; s += (v[j].x * v[j].x + v[j].y * v[j].y) + (v[j].z * v[j].z + v[j].w * v[j].w); }
        const float r = 1.0f / sqrtf(wave_sum(s) * (1.0f / D) + NORM_EPS);
        u32x2* o8 = (u32x2*)(hn + (size_t)m * D) + lane;
#pragma unroll
        for (int j = 0; j < 4; ++j) { const int c = 4 * (lane + 64 * j);
            const f32x4 gg = *(const f32x4*)(g + c), sh = *(const f32x4*)(ada + b * 3 * D + c), sc = *(const f32x4*)(ada + b * 3 * D + D + c);
            const f32x4 y = v[j] * r * gg * (sc + 1.0f) + sh;
            u32x2 w; w.x = pk2(y.x, y.y); w.y = pk2(y.z, y.w); o8[64 * j] = w; }
    }
}
__device__ __forceinline__ void final_norm_rows(float* x, const float* g, int gw, int NGW, int lane) {
    for (int m = gw; m < M; m += NGW) {
        f32x4* xr = (f32x4*)(x + (size_t)m * D) + lane;
        f32x4 v[4]; float s = 0.f;
#pragma unroll
        for (int j = 0; j < 4; ++j) { v[j] = xr[64 * j]; s += (v[j].x * v[j].x + v[j].y * v[j].y) + (v[j].z * v[j].z + v[j].w * v[j].w); }
        const float r = 1.0f / sqrtf(wave_sum(s) * (1.0f / D) + NORM_EPS);
#pragma unroll
        for (int j = 0; j < 4; ++j) { const f32x4 gg = *(const f32x4*)(g + 4 * (lane + 64 * j)); xr[64 * j] = v[j] * r * gg; }
    }
}

__device__ __forceinline__ void phase_p0(const float* cin, const float* ada_w, const float* ada_b, float* ADA,
                                         const float* fwin, const float* fwmid, const float* fb, const float* ffreq, float* HDN,
                                         LAS unsigned char* lds, int tid, int blk, int G) {
    LAS float* sc = (LAS float*)lds;
    LAS float* red = sc + 2048;
    for (int i = tid; i < 2 * D; i += 512) sc[i] = siluf_(cin[i]);
    __syncthreads();
    {
        const int cl = tid & 31, ks = tid >> 5;
        for (int gidx = blk; gidx < 8 * 96; gidx += G) {
            const int mat = gidx / 96, col0 = (gidx % 96) * 32;
            const float* w = ada_w + (size_t)mat * D * 3 * D + col0 + cl;
            float a0 = 0.f, a1 = 0.f;
#pragma unroll 8
            for (int k = ks * 64; k < ks * 64 + 64; ++k) { const float wv = w[(size_t)k * 3 * D]; a0 += sc[k] * wv; a1 += sc[D + k] * wv; }
            red[(ks * 2 + 0) * 32 + cl] = a0; red[(ks * 2 + 1) * 32 + cl] = a1;
            __syncthreads();
            if (tid < 64) { const int b = tid >> 5; float s = ada_b[mat * 3 * D + col0 + cl];
                for (int k2 = 0; k2 < 16; ++k2) s += red[(k2 * 2 + b) * 32 + cl];
                ADA[(size_t)(mat * 2 + b) * 3 * D + col0 + cl] = s; }
            __syncthreads();
        }
    }
    {
        LAS float* emb = (LAS float*)lds + 4096;
        LAS float* hA = emb + 8 * 36;
        LAS float* hB = hA + 512;
        for (int it = blk; it < 2 * (SEQ / 8); it += G) {
            const int j = it / (SEQ / 8), t0 = (it % (SEQ / 8)) * 8;
            if (tid < 8 * EMB) { const int tl = tid / EMB, e = tid % EMB, t = t0 + tl; float val;
                if (e == 0) val = (float)t / (float)(SEQ - 1);
                else { const int bi = (e - 1) & 15; const float band = 1e-4f + (float)bi * ((15.0f - 1e-4f) / 15.0f);
                    float rv = (float)t * band * (1.0f / SEQ); rv = rv - floorf(rv); val = (e <= 16) ? cos_rev(rv) : -sin_rev(rv); }
                emb[tl * 36 + e] = val; }
            __syncthreads();
            const int tl = tid >> 6, w = tid & 63;
            const float fq_ = ffreq[j * FW + w];
            float a = fb[(j * 3 + 0) * FW + w];
            for (int e = 0; e < EMB; ++e) a += emb[tl * 36 + e] * fwin[(size_t)(j * EMB + e) * FW + w];
            hA[tl * 64 + w] = fast_sin(fq_ * a);
            __syncthreads();
            a = fb[(j * 3 + 1) * FW + w];
            for (int v = 0; v < FW; ++v) a += hA[tl * 64 + v] * fwmid[(size_t)((j * 2 + 0) * FW + v) * FW + w];
            hB[tl * 64 + w] = fast_sin(fq_ * a);
            __syncthreads();
            a = fb[(j * 3 + 2) * FW + w];
            for (int v = 0; v < FW; ++v) a += hB[tl * 64 + v] * fwmid[(size_t)((j * 2 + 1) * FW + v) * FW + w];
            HDN[((size_t)j * SEQ + t0 + tl) * FW + w] = fast_sin(fq_ * a);
            __syncthreads();
        }
    }
}
__device__ __forceinline__ void filter_gen(const float* HDNj, const float* fwout  , float* FT, int tid, int blk, int G) {
    for (int it = blk; it < 256 * 16; it += G) {
        const int cb = it >> 4, tb = it & 15, t = tb * 512 + tid;
        f32x4 hv[16];
        const f32x4* hp = (const f32x4*)(HDNj + (size_t)t * FW);
#pragma unroll
        for (int i = 0; i < 16; ++i) hv[i] = hp[i];
        const float tn = (float)t / (float)(SEQ - 1);
        for (int c8 = 0; c8 < 8; ++c8) {
            const int col = cb * 8 + c8, ch = col & (D - 1);
            float a = 0.f;
#pragma unroll
            for (int i = 0; i < 16; ++i) { const float* wp = fwout + (size_t)(4 * i) * 2 * D + col;
                a += hv[i].x * wp[0] + hv[i].y * wp[2 * D] + hv[i].z * wp[4 * D] + hv[i].w * wp[6 * D]; }
            const float delta = fabsf(HY_MIN_DECAY + (float)ch * ((HY_MAX_DECAY - HY_MIN_DECAY) / (float)(D - 1)));
            FT[(size_t)col * SEQ + t] = a * __expf(-tn * delta);
        }
    }
}

__device__ __forceinline__ void hg_scan1(const u16* GF, const u16* GB, const u16* V, u16* Sbuf, int tid, int blk, int G) {
    const int lane = tid & 63, wv = __builtin_amdgcn_readfirstlane(tid >> 6);
    const int q4 = lane >> 4, r16 = lane & 15;
    for (int wi = blk; wi < 256; wi += G) {
        const int n = wi >> 6, h = (wi >> 3) & 7, ds = wi & 7, dir = n >> 1, b = n & 1;
        const u16* Gp = (dir ? GB : GF) + (size_t)b * SEQ * D + h * DK + ds * 16 + r16;
        const u16* Vp = V + (size_t)b * SEQ * D + h * DV + wv * 16 + r16;
        u16* Sp = Sbuf + (size_t)(n * NH + h) * NCH * (DV * DK) + (size_t)(wv * 16 + r16) * DK + ds * 16 + 4 * q4;
        f32x4 S = (f32x4){0.f, 0.f, 0.f, 0.f};
        for (int step = 0; step < NCH; ++step) {
            const int c = dir ? (NCH - 1 - step) : step;
            { u32x2 w; w.x = pk2(S[0], S[1]); w.y = pk2(S[2], S[3]); *(u32x2*)(Sp + (size_t)c * (DV * DK)) = w; }
            const size_t trow = (size_t)c * CH;
            float gA[8], gB[8]; unsigned vA[8], vB[8];
#pragma unroll
            for (int j = 0; j < 8; ++j) { const size_t ta = (trow + 8 * q4 + j) * D, tb = (trow + 32 + 8 * q4 + j) * D;
                gA[j] = h2f(Gp[ta]); gB[j] = h2f(Gp[tb]); vA[j] = Vp[ta]; vB[j] = Vp[tb]; }
            float sA = 0.f, sB = 0.f;
#pragma unroll
            for (int j = 0; j < 8; ++j) { sA += gA[j]; sB += gB[j]; }
            float seg[8];
#pragma unroll
            for (int qq = 0; qq < 4; ++qq) { seg[qq] = __shfl(sA, r16 + 16 * qq); seg[4 + qq] = __shfl(sB, r16 + 16 * qq); }
            float tot = 0.f;
#pragma unroll
            for (int i = 0; i < 8; ++i) tot += seg[i];
            float offA = 0.f, offB = 0.f;
#pragma unroll
            for (int i = 0; i < 8; ++i) {
                const bool afterA = i > q4, beforeA = i < q4, afterB = i > 4 + q4, beforeB = i < 4 + q4;
                offA += (dir ? beforeA : afterA) ? seg[i] : 0.f;
                offB += (dir ? beforeB : afterB) ? seg[i] : 0.f;
            }
            float eA[8], eB[8];
            if (dir == 0) { float ra = offA, rb = offB;
#pragma unroll
                for (int j = 7; j >= 0; --j) { eA[j] = ra; ra += gA[j]; eB[j] = rb; rb += gB[j]; }
            } else { float ra = offA, rb = offB;
#pragma unroll
                for (int j = 0; j < 8; ++j) { eA[j] = ra; ra += gA[j]; eB[j] = rb; rb += gB[j]; }
            }
            bf16x8 fa0, fa1, fb0, fb1;
#pragma unroll
            for (int j = 0; j < 8; ++j) {
                const float ka = (1.0f - __expf(gA[j])) * __expf(eA[j]), kb = (1.0f - __expf(gB[j])) * __expf(eB[j]);
                fa0[j] = (short)f2bf(ka); fa1[j] = (short)f2bf(kb); fb0[j] = (short)vA[j]; fb1[j] = (short)vB[j];
            }
            const float etot = __expf(tot);
#pragma unroll
            for (int r = 0; r < 4; ++r) S[r] *= __shfl(etot, 4 * q4 + r);
            S = __builtin_amdgcn_mfma_f32_16x16x32_bf16(fa0, fb0, S, 0, 0, 0);
            S = __builtin_amdgcn_mfma_f32_16x16x32_bf16(fa1, fb1, S, 0, 0, 0);
        }
    }
}

constexpr int HO_LD = 136;
constexpr int HO_LV = 72;
constexpr int HO_QF = 0, HO_KF = 64 * HO_LD * 2, HO_QB = 2 * HO_KF, HO_KB = 3 * HO_KF, HO_VT = 4 * HO_KF, HO_AT = HO_VT + 128 * HO_LV * 2, HO_SEG = HO_AT + 64 * HO_LV * 2, HO_SSQ = HO_SEG + 2 * 4 * 128 * 4, HO_END = HO_SSQ + 64 * 8 * 4;
static_assert(HO_END <= RING_BYTES, "hg_out LDS");
__device__ __forceinline__ void hg_out(const u16* Qb, const u16* Vb, const u16* GTb, const u16* GF, const u16* GB, const u16* Sbuf, const float* hgn  , u16* ON,
                                       LAS unsigned char* lds, int tid, int blk, int G) {
    const int lane = tid & 63, wv = __builtin_amdgcn_readfirstlane(tid >> 6), q4 = lane >> 4, r16 = lane & 15;
    LAS u16* QF = (LAS u16*)(lds + HO_QF); LAS u16* KF = (LAS u16*)(lds + HO_KF); LAS u16* QBt = (LAS u16*)(lds + HO_QB); LAS u16* KBt = (LAS u16*)(lds + HO_KB);
    LAS u16* VT = (LAS u16*)(lds + HO_VT); LAS u16* AT = (LAS u16*)(lds + HO_AT); LAS float* SEG = (LAS float*)(lds + HO_SEG); LAS float* SSQ = (LAS float*)(lds + HO_SSQ);
    for (int it = blk; it < NB * NH * NCH; it += G) {
        const int b = it / (NH * NCH), h = (it / NCH) % NH, c = it % NCH;
        const size_t m0 = (size_t)b * SEQ + (size_t)c * CH;
        {
            const int d = tid & 127, ts = tid >> 7;
            const size_t gofs = (m0 + 16 * ts) * D + h * DK + d;
            float gf[16], gb[16], qv[16];
#pragma unroll
            for (int j = 0; j < 16; ++j) { gf[j] = h2f(GF[gofs + (size_t)j * D]); gb[j] = h2f(GB[gofs + (size_t)j * D]); qv[j] = bf2f(Qb[gofs + (size_t)j * D]); }
            { unsigned vv[16];
#pragma unroll
              for (int j = 0; j < 16; ++j) vv[j] = Vb[gofs + (size_t)j * D];
              u32x4 w0, w1; w0.x = vv[0] | (vv[1] << 16); w0.y = vv[2] | (vv[3] << 16); w0.z = vv[4] | (vv[5] << 16); w0.w = vv[6] | (vv[7] << 16);
              w1.x = vv[8] | (vv[9] << 16); w1.y = vv[10] | (vv[11] << 16); w1.z = vv[12] | (vv[13] << 16); w1.w = vv[14] | (vv[15] << 16);
              *(LAS u32x4*)(VT + d * HO_LV + 16 * ts) = w0; *(LAS u32x4*)(VT + d * HO_LV + 16 * ts + 8) = w1; }
            float pf[16], sb[16];
            { float r = 0.f;
#pragma unroll
              for (int j = 0; j < 16; ++j) { r += gf[j]; pf[j] = r; }
              SEG[(0 * 4 + ts) * 128 + d] = r; r = 0.f;
#pragma unroll
              for (int j = 15; j >= 0; --j) { r += gb[j]; sb[j] = r; }
              SEG[(1 * 4 + ts) * 128 + d] = r; }
            __syncthreads();
            float offf = 0.f, offb = 0.f;
#pragma unroll
            for (int s2 = 0; s2 < 4; ++s2) { const float a = SEG[(0 * 4 + s2) * 128 + d], bb = SEG[(1 * 4 + s2) * 128 + d]; offf += (s2 < ts) ? a : 0.f; offb += (s2 > ts) ? bb : 0.f; }
#pragma unroll
            for (int j = 0; j < 16; ++j) {
                const float bf_ = offf + pf[j], bb_ = offb + sb[j];
                const float kf = 1.0f - __expf(gf[j]), kb = 1.0f - __expf(gb[j]);
                const int o = (16 * ts + j) * HO_LD + d;
                QF[o] = (u16)f2bf(qv[j] * __expf(bf_)); KF[o] = (u16)f2bf(kf * __expf(fminf(-bf_, 80.f)));
                QBt[o] = (u16)f2bf(qv[j] * __expf(bb_)); KBt[o] = (u16)f2bf(kb * __expf(fminf(-bb_, 80.f)));
            }
        }
        __syncthreads();
#pragma unroll 1
        for (int tt = 0; tt < 2; ++tt) {
            const int tile = 2 * wv + tt, ti = tile >> 2, si = tile & 3;
            f32x4 af = (f32x4){0.f, 0.f, 0.f, 0.f}, ab = (f32x4){0.f, 0.f, 0.f, 0.f};
            if (ti >= si) {
#pragma unroll
                for (int kk = 0; kk < 4; ++kk) { const bf16x8 a = *(const LAS bf16x8*)(QF + (16 * ti + r16) * HO_LD + 32 * kk + 8 * q4), bb = *(const LAS bf16x8*)(KF + (16 * si + r16) * HO_LD + 32 * kk + 8 * q4);
                    af = __builtin_amdgcn_mfma_f32_16x16x32_bf16(a, bb, af, 0, 0, 0); }
            }
            if (ti <= si) {
#pragma unroll
                for (int kk = 0; kk < 4; ++kk) { const bf16x8 a = *(const LAS bf16x8*)(QBt + (16 * ti + r16) * HO_LD + 32 * kk + 8 * q4), bb = *(const LAS bf16x8*)(KBt + (16 * si + r16) * HO_LD + 32 * kk + 8 * q4);
                    ab = __builtin_amdgcn_mfma_f32_16x16x32_bf16(a, bb, ab, 0, 0, 0); }
            }
#pragma unroll
            for (int r = 0; r < 4; ++r) { const int t = 16 * ti + 4 * q4 + r, s = 16 * si + r16;
                const float vsum = (s <= t ? af[r] : 0.f) + (s >= t ? ab[r] : 0.f);
                AT[t * HO_LV + s] = (u16)f2bf(vsum); }
        }
        __syncthreads();
        f32x4 o[4];
#pragma unroll
        for (int ti = 0; ti < 4; ++ti) o[ti] = (f32x4){0.f, 0.f, 0.f, 0.f};
        {
#pragma unroll
            for (int kk = 0; kk < 2; ++kk) { const bf16x8 bv = *(const LAS bf16x8*)(VT + (16 * wv + r16) * HO_LV + 32 * kk + 8 * q4);
#pragma unroll
                for (int ti = 0; ti < 4; ++ti) { const bf16x8 a = *(const LAS bf16x8*)(AT + (16 * ti + r16) * HO_LV + 32 * kk + 8 * q4); o[ti] = __builtin_amdgcn_mfma_f32_16x16x32_bf16(a, bv, o[ti], 0, 0, 0); } }
            const u16* Sf = Sbuf + ((size_t)((0 * 2 + b) * NH + h) * NCH + c) * (DV * DK) + (size_t)(16 * wv + r16) * DK + 8 * q4;
            const u16* Sb = Sbuf + ((size_t)((1 * 2 + b) * NH + h) * NCH + c) * (DV * DK) + (size_t)(16 * wv + r16) * DK + 8 * q4;
#pragma unroll
            for (int kk = 0; kk < 4; ++kk) { const bf16x8 sf = *(const bf16x8*)(Sf + 32 * kk), sbv = *(const bf16x8*)(Sb + 32 * kk);
#pragma unroll
                for (int ti = 0; ti < 4; ++ti) { const bf16x8 a = *(const LAS bf16x8*)(QF + (16 * ti + r16) * HO_LD + 32 * kk + 8 * q4); o[ti] = __builtin_amdgcn_mfma_f32_16x16x32_bf16(a, sf, o[ti], 0, 0, 0);
                    const bf16x8 a2 = *(const LAS bf16x8*)(QBt + (16 * ti + r16) * HO_LD + 32 * kk + 8 * q4); o[ti] = __builtin_amdgcn_mfma_f32_16x16x32_bf16(a2, sbv, o[ti], 0, 0, 0); } }
        }
#pragma unroll
        for (int ti = 0; ti < 4; ++ti)
#pragma unroll
            for (int r = 0; r < 4; ++r) { float s = o[ti][r] * o[ti][r]; s += __shfl_xor(s, 1); s += __shfl_xor(s, 2); s += __shfl_xor(s, 4); s += __shfl_xor(s, 8);
                if (r16 == 0) SSQ[(16 * ti + 4 * q4 + r) * 8 + wv] = s; }
        __syncthreads();
        {
            const int dv = 16 * wv + r16; const float gn = hgn[dv];
#pragma unroll
            for (int ti = 0; ti < 4; ++ti)
#pragma unroll
                for (int r = 0; r < 4; ++r) { const int t = 16 * ti + 4 * q4 + r; const LAS f32x4* sp = (const LAS f32x4*)(SSQ + t * 8); const f32x4 s0 = sp[0], s1 = sp[1];
                    const float ss = (s0.x + s0.y + s0.z + s0.w) + (s1.x + s1.y + s1.z + s1.w);
                    const float rn = 1.0f / sqrtf(ss * (1.0f / DV) + NORM_EPS);
                    const size_t go = (m0 + t) * D + h * DV + dv;
                    ON[go] = (u16)f2bf(o[ti][r] * rn * gn * bf2f(GTb[go])); }
        }
        __syncthreads();
    }
}

__device__ __forceinline__ void hy_zprep(const u16* U, const float* cw  , const float* cbias  , f32x2* ZT, LAS unsigned char* lds, int tid, int blk, int G) {
    LAS float* zt = (LAS float*)lds;
    for (int it = blk; it < (SEQ / 64) * (D / 64); it += G) {
        const int tb = it >> 4, cbk = it & 15, t0 = tb * 64, c0 = cbk * 64;
        const int ch = tid & 63, tq = tid >> 6, c = c0 + ch;
        const float a0 = cw[0 * 3 * D + D + c], a1 = cw[1 * 3 * D + D + c], a2 = cw[2 * 3 * D + D + c], ab = cbias[D + c];
        const float v0 = cw[0 * 3 * D + 2 * D + c], v1 = cw[1 * 3 * D + 2 * D + c], v2 = cw[2 * 3 * D + 2 * D + c], vb = cbias[2 * D + c];
#pragma unroll
        for (int b = 0; b < 2; ++b) {
            float u1[10], uv[10];
#pragma unroll
            for (int i = 0; i < 10; ++i) { const int tt = t0 + tq * 8 - 1 + i; const bool ok = (tt >= 0) && (tt < SEQ);
                const size_t ro = ((size_t)b * SEQ + (ok ? tt : 0)) * (3 * D);
                u1[i] = ok ? bf2f(U[ro + D + c]) : 0.f; uv[i] = ok ? bf2f(U[ro + 2 * D + c]) : 0.f; }
#pragma unroll
            for (int i = 0; i < 8; ++i) { const float x1c = u1[i] * a0 + u1[i + 1] * a1 + u1[i + 2] * a2 + ab, vc = uv[i] * v0 + uv[i + 1] * v1 + uv[i + 2] * v2 + vb;
                zt[(ch * 65 + tq * 8 + i) * 2 + b] = x1c * vc; }
        }
        __syncthreads();
        { const int tt = tid & 63;
#pragma unroll
          for (int r = 0; r < 8; ++r) { const int chh = (tid >> 6) + 8 * r; f32x2 v; v.x = zt[(chh * 65 + tt) * 2]; v.y = zt[(chh * 65 + tt) * 2 + 1]; ZT[(size_t)(c0 + chh) * SEQ + t0 + tt] = v; } }
        __syncthreads();
    }
}
__device__ __forceinline__ void hy_gate(const u16* U, const float* cw, const float* cbias, const f32x2* YT, u16* YG, LAS unsigned char* lds, int tid, int blk, int G) {
    LAS float* zt = (LAS float*)lds;
    for (int it = blk; it < (SEQ / 64) * (D / 64); it += G) {
        const int tb = it >> 4, cbk = it & 15, t0 = tb * 64, c0 = cbk * 64;
        { const int tt = tid & 63;
#pragma unroll
          for (int r = 0; r < 8; ++r) { const int chh = (tid >> 6) + 8 * r; const f32x2 v = YT[(size_t)(c0 + chh) * SEQ + t0 + tt]; zt[(chh * 65 + tt) * 2] = v.x; zt[(chh * 65 + tt) * 2 + 1] = v.y; } }
        __syncthreads();
        const int ch = tid & 63, tq = tid >> 6, c = c0 + ch;
        const float a0 = cw[0 * 3 * D + c], a1 = cw[1 * 3 * D + c], a2 = cw[2 * 3 * D + c], ab = cbias[c];
#pragma unroll
        for (int b = 0; b < 2; ++b) {
            float u0[10];
#pragma unroll
            for (int i = 0; i < 10; ++i) { const int tt = t0 + tq * 8 - 1 + i; const bool ok = (tt >= 0) && (tt < SEQ);
                const size_t ro = ((size_t)b * SEQ + (ok ? tt : 0)) * (3 * D); u0[i] = ok ? bf2f(U[ro + c]) : 0.f; }
#pragma unroll
            for (int i = 0; i < 8; ++i) { const float x0c = u0[i] * a0 + u0[i + 1] * a1 + u0[i + 2] * a2 + ab;
                YG[((size_t)b * SEQ + t0 + tq * 8 + i) * D + c] = (u16)f2bf(x0c * zt[(ch * 65 + tq * 8 + i) * 2 + b]); }
        }
        __syncthreads();
    }
}
template <bool INV>
__device__ __forceinline__ void fft_pass(LAS f32x2* a, int ls  , int tid) {
    const int s = 1 << ls;
    const float inv4s = 1.0f / (float)(4 * s);
    for (int u = tid; u < 4096; u += 512) {
        const int j = u & (s - 1), base = ((u >> ls) << (ls + 2)) + j;
        f32x2 x0 = a[base], x1 = a[base + s], x2 = a[base + 2 * s], x3 = a[base + 3 * s];
        const float f1 = (float)j * inv4s;
        const float c1 = cos_rev(f1), s1 = sin_rev(f1), c2 = cos_rev(2.f * f1), s2 = sin_rev(2.f * f1), c3 = cos_rev(3.f * f1), s3 = sin_rev(3.f * f1);
        if (!INV) {
            const f32x2 t0 = x0 + x2, t1 = x0 - x2, t2 = x1 + x3, t3 = x1 - x3;
            const f32x2 y0 = t0 + t2, y2 = t0 - t2;
            f32x2 y1, y3; y1.x = t1.x + t3.y; y1.y = t1.y - t3.x; y3.x = t1.x - t3.y; y3.y = t1.y + t3.x;
            f32x2 z1, z2, z3;
            z1.x = y1.x * c1 + y1.y * s1; z1.y = y1.y * c1 - y1.x * s1;
            z2.x = y2.x * c2 + y2.y * s2; z2.y = y2.y * c2 - y2.x * s2;
            z3.x = y3.x * c3 + y3.y * s3; z3.y = y3.y * c3 - y3.x * s3;
            a[base] = y0; a[base + s] = z1; a[base + 2 * s] = z2; a[base + 3 * s] = z3;
        } else {
            f32x2 y1, y2, y3;
            y1.x = x1.x * c1 - x1.y * s1; y1.y = x1.y * c1 + x1.x * s1;
            y2.x = x2.x * c2 - x2.y * s2; y2.y = x2.y * c2 + x2.x * s2;
            y3.x = x3.x * c3 - x3.y * s3; y3.y = x3.y * c3 + x3.x * s3;
            const f32x2 t0 = x0 + y2, t1 = x0 - y2, t2 = y1 + y3, t3 = y1 - y3;
            f32x2 r1, r3; r1.x = t1.x - t3.y; r1.y = t1.y + t3.x; r3.x = t1.x + t3.y; r3.y = t1.y - t3.x;
            a[base] = t0 + t2; a[base + s] = r1; a[base + 2 * s] = t0 - t2; a[base + 3 * s] = r3;
        }
    }
}
__device__ __forceinline__ void fft_fwd(LAS f32x2* a, int tid) {
#pragma unroll 1
    for (int ls = 12; ls >= 0; ls -= 2) { fft_pass<false>(a, ls, tid); __syncthreads(); }
}
__device__ __forceinline__ void fft_inv(LAS f32x2* a, int tid) {
#pragma unroll 1
    for (int ls = 0; ls <= 12; ls += 2) { fft_pass<true>(a, ls, tid); __syncthreads(); }
}
__device__ __forceinline__ void hy_fftconv(f32x2* ZT, const float* FT, f32x2* HS, const float* skip, LAS unsigned char* lds, int tid, int blk, int G) {
    LAS f32x2* a = (LAS f32x2*)lds;
    f32x2* hs = HS + (size_t)blk * 16384;
    for (int ch = blk; ch < D; ch += G) {
        const float* hf = FT + (size_t)ch * SEQ; const float* hb = FT + (size_t)(D + ch) * SEQ;
        for (int i = tid; i < SEQ; i += 512) { f32x2 v; v.x = hf[i]; v.y = 0.f; a[i] = v; f32x2 w; w.x = (i == 0) ? 0.f : hb[SEQ - i]; w.y = 0.f; a[SEQ + i] = w; }
        __syncthreads();
        fft_fwd(a, tid);
        for (int p = tid; p < 2 * SEQ; p += 512) hs[p] = a[p] * (1.0f / 16384.0f);
        __syncthreads();
        f32x2* z = ZT + (size_t)ch * SEQ;
        for (int i = tid; i < SEQ; i += 512) { a[i] = z[i]; a[SEQ + i] = (f32x2){0.f, 0.f}; }
        __syncthreads();
        fft_fwd(a, tid);
        for (int p = tid; p < 2 * SEQ; p += 512) { const f32x2 x = a[p], hh = hs[p]; f32x2 r; r.x = x.x * hh.x - x.y * hh.y; r.y = x.x * hh.y + x.y * hh.x; a[p] = r; }
        __syncthreads();
        fft_inv(a, tid);
        const float sk = skip[ch];
        for (int i = tid; i < SEQ; i += 512) { const f32x2 zz = z[i], r = a[i]; z[i] = r + zz * sk; }
        __syncthreads();
    }
}

struct Args { const float* in[23]; float* out; unsigned char* ws; int ph_lo, ph_hi, li, pad; };

__global__ void __launch_bounds__(512, 2) mega_fwd(Args args) {
    extern __shared__ __attribute__((aligned(16))) unsigned char lds_raw[];
    LAS unsigned char* lds = (LAS unsigned char*)lds_raw;
    volatile LAS unsigned* MISC = (volatile LAS unsigned*)(lds + MISC_OFF);
    for (int u = threadIdx.x; u < (LDS_BYTES - LDSCTL_OFF) / 4; u += 512) ((LAS unsigned*)(lds + LDSCTL_OFF))[u] = 0u;
    __syncthreads();
    XcdBarrier bar; bar.bar = (unsigned*)(args.ws + WS_CTL) + CW_BAR + args.li * XCD_BAR_WORDS; bar.x = 0; bar.st = nullptr;
#if !MK_PER_PHASE
    bar = xcd_barrier_post((unsigned*)(args.ws + WS_CTL) + CW_BAR + args.li * XCD_BAR_WORDS, MISC + 8);
#endif
    const int lo = args.ph_lo, hi = args.ph_hi;
    int pc = 0;
#define RUN() (pc >= lo && pc < hi)
#if MK_PER_PHASE
#define SEAM() do { ++pc; } while (0)
#else
#define SEAM() do { ++pc; if (pc > lo && pc < hi) xcd_barrier(bar); } while (0)
#endif
#define COORDS() const int tid = opq_tid(), lane = tid & 63, wave = __builtin_amdgcn_readfirstlane(tid >> 6); const int G = opq_s((int)gridDim.x), blk = opq_s((int)blockIdx.x); \
                 const int gw = blk * 8 + wave, NGW = G * 8; unsigned char* ws = arg_ws(); (void)lane; (void)gw; (void)NGW; (void)ws
#define SCR() ((LAS float*)(lds + wave * 16384))

    if (RUN()) { COORDS(); phase_p0(arg_in(1), arg_in(2), arg_in(3), (float*)(ws + WS_ADA), arg_in(13), arg_in(14), arg_in(15), arg_in(16), (float*)(ws + WS_HDN), lds, tid, blk, G); }
    SEAM();

#pragma unroll 1
    for (int layer = 0; layer < DEPTH; ++layer) {
        const int jl = layer >> 1;
        if ((layer & 1) == 0) {
            if (RUN()) { COORDS();
                convert_weights(arg_in(5) + (size_t)jl * D * 5 * D, D, 5 * D, (u16*)(ws + WS_WIN), arg_in(8) + (size_t)jl * D * D, D, D, (u16*)(ws + WS_WOUT),
                                arg_in(20) + (size_t)layer * D * FF, D, FF, (u16*)(ws + WS_W1), arg_in(21) + (size_t)layer * FF * D, FF, D, (u16*)(ws + WS_W2), SCR(), gw, NGW, lane);
                norm_rows(layer == 0 ? arg_in(0) : arg_out(), arg_in(4) + (size_t)(layer * 2 + 0) * D, (const float*)(ws + WS_ADA) + (size_t)(layer * 2 + 0) * 2 * 3 * D, (u16*)(ws + WS_HN), gw, NGW, lane);
            }
            SEAM();
            if (RUN()) { COORDS();
                pg8::Gemm g{(const u16*)(ws + WS_HN), (const u16*)(ws + WS_WIN), M, 5 * D, D}; pg8::StaticOrder S; S.init(M, 5 * D, G, blk);
                pg8::EpiHgIn E{(u16*)(ws + WS_Q), (u16*)(ws + WS_V), (u16*)(ws + WS_GT), (u16*)(ws + WS_GF), (u16*)(ws + WS_GB), arg_in(6), jl};
                pg8::gemm_phase<pg8::EpiHgIn, pg8::StaticOrder, true, true>(lds, g, S, E);
            }
            SEAM();
            if (RUN()) { COORDS(); hg_scan1((const u16*)(ws + WS_GF), (const u16*)(ws + WS_GB), (const u16*)(ws + WS_V), (u16*)(ws + WS_S), tid, blk, G); }
            SEAM();
            if (RUN()) { COORDS(); hg_out((const u16*)(ws + WS_Q), (const u16*)(ws + WS_V), (const u16*)(ws + WS_GT), (const u16*)(ws + WS_GF), (const u16*)(ws + WS_GB), (const u16*)(ws + WS_S),
                              arg_in(7) + (size_t)jl * DV, (u16*)(ws + WS_HN), lds, tid, blk, G); }
            SEAM();
        } else {
            if (RUN()) { COORDS();
                convert_weights(arg_in(9) + (size_t)jl * D * 3 * D, D, 3 * D, (u16*)(ws + WS_WIN), arg_in(19) + (size_t)jl * D * D, D, D, (u16*)(ws + WS_WOUT),
                                arg_in(20) + (size_t)layer * D * FF, D, FF, (u16*)(ws + WS_W1), arg_in(21) + (size_t)layer * FF * D, FF, D, (u16*)(ws + WS_W2), SCR(), gw, NGW, lane);
                norm_rows(arg_out(), arg_in(4) + (size_t)(layer * 2 + 0) * D, (const float*)(ws + WS_ADA) + (size_t)(layer * 2 + 0) * 2 * 3 * D, (u16*)(ws + WS_HN), gw, NGW, lane);
                filter_gen((const float*)(ws + WS_HDN) + (size_t)jl * SEQ * FW, arg_in(17) + (size_t)jl * FW * 2 * D, (float*)(ws + WS_FT), tid, blk, G);
            }
            SEAM();
            if (RUN()) { COORDS();
                pg8::Gemm g{(const u16*)(ws + WS_HN), (const u16*)(ws + WS_WIN), M, 3 * D, D}; pg8::StaticOrder S; S.init(M, 3 * D, G, blk);
                pg8::EpiBias E{(u16*)(ws + WS_U), 3 * D, arg_in(10) + (size_t)jl * 3 * D};
                pg8::gemm_phase<pg8::EpiBias, pg8::StaticOrder, true, true>(lds, g, S, E);
            }
            SEAM();
            if (RUN()) { COORDS(); hy_zprep((const u16*)(ws + WS_U), arg_in(11) + (size_t)jl * 3 * 3 * D, arg_in(12) + (size_t)jl * 3 * D, (f32x2*)(ws + WS_ZT), lds, tid, blk, G); }
            SEAM();
            if (RUN()) { COORDS(); hy_fftconv((f32x2*)(ws + WS_ZT), (const float*)(ws + WS_FT), (f32x2*)(ws + WS_HS), arg_in(18) + (size_t)jl * D, lds, tid, blk, G); }
            SEAM();
            if (RUN()) { COORDS(); hy_gate((const u16*)(ws + WS_U), arg_in(11) + (size_t)jl * 3 * 3 * D, arg_in(12) + (size_t)jl * 3 * D, (const f32x2*)(ws + WS_ZT), (u16*)(ws + WS_HN), lds, tid, blk, G); }
            SEAM();
        }
        if (RUN()) { COORDS();
            pg8::Gemm g{(const u16*)(ws + WS_HN), (const u16*)(ws + WS_WOUT), M, D, D}; pg8::StaticOrder S; S.init(M, D, G, blk);
            pg8::EpiResid E{layer == 0 ? arg_in(0) : arg_out(), arg_out(), (const float*)(ws + WS_ADA) + (size_t)(layer * 2 + 0) * 2 * 3 * D + 2 * D};
            pg8::gemm_phase<pg8::EpiResid, pg8::StaticOrder, true, true>(lds, g, S, E);
        }
        SEAM();
        if (RUN()) { COORDS(); norm_rows(arg_out(), arg_in(4) + (size_t)(layer * 2 + 1) * D, (const float*)(ws + WS_ADA) + (size_t)(layer * 2 + 1) * 2 * 3 * D, (u16*)(ws + WS_HN), gw, NGW, lane); }
        SEAM();
        if (RUN()) { COORDS();
            pg8::Gemm g{(const u16*)(ws + WS_HN), (const u16*)(ws + WS_W1), M, FF, D}; pg8::StaticOrder S; S.init(M, FF, G, blk);
            pg8::EpiRelu2 E{(u16*)(ws + WS_H), FF};
            pg8::gemm_phase<pg8::EpiRelu2, pg8::StaticOrder, true, true>(lds, g, S, E);
        }
        SEAM();
        if (RUN()) { COORDS();
            pg8::Gemm g{(const u16*)(ws + WS_H), (const u16*)(ws + WS_W2), M, D, FF}; pg8::StaticOrder S; S.init(M, D, G, blk);
            pg8::EpiResid E{arg_out(), arg_out(), (const float*)(ws + WS_ADA) + (size_t)(layer * 2 + 1) * 2 * 3 * D + 2 * D};
            pg8::gemm_phase<pg8::EpiResid, pg8::StaticOrder, true, true>(lds, g, S, E);
        }
        SEAM();
    }
    if (RUN()) { COORDS(); final_norm_rows(arg_out(), arg_in(22), gw, NGW, lane); }
#undef RUN
#undef SEAM
#undef COORDS
#undef SCR
}

constexpr int N_PHASES = 1 + 2 * 8 + 2 * 9 + 1;

extern "C" void kernel_launch(void* const* d_in, const int* in_sizes, int n_in, void* d_out, int out_size, void* d_ws, size_t ws_size, hipStream_t stream) {
    static int grid = 0;
    if (grid == 0) {
        if (n_in != 23 || in_sizes[0] != M * D || out_size != M * D || ws_size < WS_END) {
            fprintf(stderr, "kernel_launch: unexpected problem: n_in %d in0 %d out %d ws %zu (need %zu)\n", n_in, n_in > 0 ? in_sizes[0] : -1, out_size, ws_size, (size_t)WS_END); grid = -1; return; }
        int dev = 0, cus = 0;
        if (hipGetDevice(&dev) != hipSuccess || hipDeviceGetAttribute(&cus, hipDeviceAttributeMultiprocessorCount, dev) != hipSuccess) { grid = -1; return; }
        if (hipFuncSetAttribute((const void*)mega_fwd, hipFuncAttributeMaxDynamicSharedMemorySize, LDS_BYTES) != hipSuccess) { fprintf(stderr, "kernel_launch: hipFuncSetAttribute failed\n"); grid = -1; return; }
        int per_cu = 0;
        if (hipOccupancyMaxActiveBlocksPerMultiprocessor(&per_cu, (const void*)mega_fwd, 512, LDS_BYTES) != hipSuccess || per_cu < 1)
            fprintf(stderr, "kernel_launch: occupancy query reports %d per CU\n", per_cu);
        (void)hipGetLastError();
        grid = cus;
    }
    if (grid < 0) return;
    if (hipMemsetAsync((char*)d_ws + WS_CTL, 0, CTL_ZERO_BYTES, stream) != hipSuccess) { fprintf(stderr, "kernel_launch: memset failed\n"); return; }
    Args a{};
    for (int i = 0; i < 23; ++i) a.in[i] = (const float*)d_in[i];
    a.out = (float*)d_out; a.ws = (unsigned char*)d_ws;
#if MK_PER_PHASE
    for (int p = 0; p < N_PHASES; ++p) { a.ph_lo = p; a.ph_hi = p + 1; a.li = 0; hipLaunchKernelGGL(mega_fwd, dim3(grid), dim3(512), LDS_BYTES, stream, a); }
#else
    a.ph_lo = 0; a.ph_hi = N_PHASES; a.li = 0;
    hipLaunchKernelGGL(mega_fwd, dim3(grid), dim3(512), LDS_BYTES, stream, a);
#endif
    const hipError_t le = hipPeekAtLastError();
    if (le != hipSuccess) fprintf(stderr, "kernel_launch: launch failed: %s\n", hipGetErrorName(le));
}
```

```cpp
#include <hip/hip_runtime.h>
#include <cstdio>
#include <cstdint>

#ifndef MK_PER_PHASE
#define MK_PER_PHASE 0
#endif

#define GAS __attribute__((address_space(1)))
#define LAS __attribute__((address_space(3)))
typedef unsigned short u16;
typedef float f32x4 __attribute__((ext_vector_type(4)));
typedef float f32x2 __attribute__((ext_vector_type(2)));
typedef short bf16x8 __attribute__((ext_vector_type(8)));
typedef unsigned u32x4 __attribute__((ext_vector_type(4)));
typedef unsigned u32x2 __attribute__((ext_vector_type(2)));
typedef _Float16 h16x2 __attribute__((ext_vector_type(2)));

constexpr int D = 1024, NB = 2, SEQ = 8192, M = NB * SEQ, DEPTH = 4, NH = 8, DK = 128, DV = 128, CH = 64, NCH = SEQ / CH, FF = 4096;
constexpr int FW = 64, EMB = 33;
constexpr float NORM_EPS = 1e-6f;
constexpr float HY_MAX_DECAY = -15.350567286626973f;
constexpr float HY_MIN_DECAY = -3.0701134573253946f;

constexpr size_t MiB = 1u << 20;
constexpr size_t WS_CTL = 0, CTL_ZERO_BYTES = 1 * MiB;
constexpr size_t WS_ADA = 1 * MiB;
constexpr size_t WS_HDN = 2 * MiB;
constexpr size_t WS_WOT = 6 * MiB;
constexpr size_t WS_W = 8 * MiB;
constexpr size_t WS_WIN = WS_W, WS_WOUT = WS_W + 10 * MiB, WS_W1 = WS_W + 12 * MiB, WS_W2 = WS_W + 20 * MiB;
constexpr size_t WS_HN = 36 * MiB;
constexpr size_t WS_Q = 68 * MiB, WS_V = 100 * MiB, WS_GT = 132 * MiB, WS_GF = 164 * MiB, WS_GB = 196 * MiB, WS_S = 228 * MiB;
constexpr size_t WS_H = 228 * MiB;
constexpr size_t WS_U = 68 * MiB;
constexpr size_t WS_ZT = 164 * MiB;
constexpr size_t WS_FT = 228 * MiB;
constexpr size_t WS_HS = 292 * MiB;
constexpr size_t WS_END = 356 * MiB;
constexpr int CW_BAR = 4096;

constexpr int RING_BYTES = 131072;
constexpr int LDSCTL_OFF = (16384 + 1024) * 8  , MISC_OFF = LDSCTL_OFF + 320;
constexpr int LDS_BYTES = 147456;

__device__ __forceinline__ unsigned f2bf(float f) { unsigned u = __builtin_bit_cast(unsigned, f); return (u + 0x7fffu + ((u >> 16) & 1u)) >> 16; }
__device__ __forceinline__ unsigned pk2(float lo, float hi) { return f2bf(lo) | (f2bf(hi) << 16); }
__device__ __forceinline__ float bf2f(unsigned b) { return __builtin_bit_cast(float, b << 16); }
__device__ __forceinline__ unsigned pkh2(float lo, float hi) { h16x2 v; v.x = (_Float16)lo; v.y = (_Float16)hi; return __builtin_bit_cast(unsigned, v); }
__device__ __forceinline__ float h2f(unsigned short b) { return (float)__builtin_bit_cast(_Float16, b); }
__device__ __forceinline__ float sin_rev(float r) { return __builtin_amdgcn_sinf(r); }
__device__ __forceinline__ float cos_rev(float r) { return __builtin_amdgcn_cosf(r); }
__device__ __forceinline__ float fast_sin(float x) { float r = x * 0.15915494309189535f; r = r - floorf(r); return sin_rev(r); }
__device__ __forceinline__ float sigmoidf_(float x) { return 1.0f / (1.0f + __expf(-x)); }
__device__ __forceinline__ float siluf_(float x) { return x / (1.0f + __expf(-x)); }
__device__ __forceinline__ float wave_sum(float v) {
#pragma unroll
    for (int o = 1; o < 64; o <<= 1) v += __shfl_xor(v, o);
    return v;
}
#define LDS_WAIT() asm volatile("s_waitcnt lgkmcnt(0)" ::: "memory")

#define CAS __attribute__((address_space(4)))
__device__ __forceinline__ int opq_tid() { int t = threadIdx.x; asm volatile("" : "+v"(t)); return t; }
__device__ __forceinline__ int opq_s(int x) { asm volatile("" : "+s"(x)); return x; }
__device__ __forceinline__ const float* arg_in(int i) { const CAS char* p = (const CAS char*)__builtin_amdgcn_kernarg_segment_ptr(); asm volatile("" : "+s"(p)); return *(const float* const CAS*)(p + 8 * i); }
__device__ __forceinline__ float* arg_out() { const CAS char* p = (const CAS char*)__builtin_amdgcn_kernarg_segment_ptr(); asm volatile("" : "+s"(p)); return *(float* const CAS*)(p + 8 * 23); }
__device__ __forceinline__ unsigned char* arg_ws() { const CAS char* p = (const CAS char*)__builtin_amdgcn_kernarg_segment_ptr(); asm volatile("" : "+s"(p)); return *(unsigned char* const CAS*)(p + 8 * 24); }

namespace pg8 {
#define PG8_LAS __attribute__((address_space(3)))
typedef unsigned short bf16_t;
constexpr int BM = 256, BK = 64, HALF = 128, HTB = HALF * BK * 2, STAGE_BYTES = 8 * HTB, NXCD = 8, WGM = 8;
__host__ __device__ __forceinline__ int lds_byte(int r, int c) { const int st = (r >> 4) * 2 + (c >> 5), rr = r & 15, cc = c & 31, ob = rr * 64 + cc * 2; return st * 1024 + (ob ^ (((ob >> 9) & 1) << 5)); }
__host__ __device__ __forceinline__ void stage_rc(int b, int& R, int& C) { const int st = b / 1024, sb = b % 1024, swz = sb ^ (((sb >> 9) & 1) << 5); R = (st >> 1) * 16 + swz / 64; C = (st & 1) * 32 + (swz % 64) / 2; }
__host__ __device__ __forceinline__ int perm32(int rho) { const int n = rho >> 4, i = rho & 15; return 8 * (i >> 2) + 4 * n + (i & 3); }
struct Unit { int pm, pn; };
struct Gemm { const bf16_t* A; const bf16_t* Bt; int M, N, K; };
struct StaticOrder {
    int nM, nN, nwg, G, c;
    __host__ __device__ void init(int M_, int N_, int G_, int c_) { nM = M_ / BM; nN = N_ / BM; nwg = nM * nN; G = G_; c = c_; }
    __host__ __device__ bool next(int i, Unit& u) const {
        const long L = (long)i * G + c; if (L >= nwg) return false;
        int wgid = (int)L; { const int q = nwg / NXCD, r = nwg % NXCD, xcd = wgid % NXCD, off = wgid / NXCD; wgid = (xcd < r ? xcd * (q + 1) : r * (q + 1) + (xcd - r) * q) + off; }
        const int nig = WGM * nN, gid = wgid / nig, fm = gid * WGM, gsz = (nM - fm) < WGM ? (nM - fm) : WGM;
        u.pm = fm + ((wgid % nig) % gsz); u.pn = (wgid % nig) / gsz; return true;
    }
    __device__ __forceinline__ void a_ready(const Unit&) const {}
    __device__ __forceinline__ void done(const Unit&) const {}
};
__device__ __forceinline__ unsigned cvt_pk_bf16(float lo, float hi) { unsigned r; asm volatile("v_cvt_pk_bf16_f32 %0, %1, %2" : "=v"(r) : "v"(lo), "v"(hi)); return r; }

template <class Epi, class Sched, bool ALIGN_EPI = false, bool SP2 = false>
__device__ __forceinline__ void gemm_phase(PG8_LAS unsigned char* lds, const Gemm g, const Sched& S, const Epi& E) {
    const int tid = opq_tid(), wid = __builtin_amdgcn_readfirstlane(tid >> 6), lane = tid & 63, wr = wid >> 2, wc = wid & 3, fr = lane & 15, fq = lane >> 4;
    const int K = g.K, nt = K / BK;
    unsigned voffA[2], voffB[2];
#pragma unroll
    for (int i = 0; i < 2; ++i) { int R, C; stage_rc(tid * 16 + i * 8192, R, C); const int Rb = Epi::PERM ? ((R & ~31) + perm32(R & 31)) : R;
        voffA[i] = (unsigned)(R * K + C) * 2u; voffB[i] = (unsigned)(Rb * K + C) * 2u; }
    const size_t kstep = (size_t)(BK * 2);
    const size_t hstep = (size_t)HALF * K * 2;
    const size_t tstep = 2 * hstep;
    const unsigned ldsw = (unsigned)wid * 1024u;
    const int aoff = lds_byte(wr * 64 + fr, fq * 8), boff = lds_byte(wc * 32 + fr, fq * 8);
#define PG8_SA(b, h) (((b) * 2 + (h)) * HTB)
#define PG8_SB(b, h) ((4 + (b) * 2 + (h)) * HTB)
#define PG8_STAGE(bufoff, gbase, voff) do { _Pragma("unroll") for (int _i = 0; _i < 2; ++_i) \
        __builtin_amdgcn_global_load_lds((const unsigned*)((const char*)(gbase) + (voff)[_i]), (PG8_LAS unsigned*)(lds + (bufoff) + ldsw + _i * 8192), 16, 0, 0); } while (0)
#define PG8_LDA(dst, b, h) do { _Pragma("unroll") for (int m = 0; m < 4; ++m) _Pragma("unroll") for (int k = 0; k < 2; ++k) dst[m][k] = *(const PG8_LAS bf16x8*)(lds + PG8_SA(b, h) + aoff + m * 2048 + k * 1024); } while (0)
#define PG8_LDB(dst, b, h) do { _Pragma("unroll") for (int n = 0; n < 2; ++n) _Pragma("unroll") for (int k = 0; k < 2; ++k) dst[n][k] = *(const PG8_LAS bf16x8*)(lds + PG8_SB(b, h) + boff + n * 2048 + k * 1024); } while (0)
#define PG8_MMA(ai, bj, At, Bt) do { __builtin_amdgcn_s_setprio(1); _Pragma("unroll") for (int m = 0; m < 4; ++m) _Pragma("unroll") for (int n = 0; n < 2; ++n) _Pragma("unroll") for (int k = 0; k < 2; ++k) \
        acc[ai][bj][m][n] = __builtin_amdgcn_mfma_f32_16x16x32_bf16(Bt[n][k], At[m][k], acc[ai][bj][m][n], 0, 0, 0); __builtin_amdgcn_s_setprio(0); } while (0)
#define PG8_WAIT_V(n) asm volatile("s_waitcnt vmcnt(" #n ")" ::: "memory")
#define PG8_WAIT_L(n) asm volatile("s_waitcnt lgkmcnt(" #n ")" ::: "memory")
#define PG8_BAR __builtin_amdgcn_s_barrier()
#define PG8_SCHED __builtin_amdgcn_sched_barrier(0)
    Unit cur, nxt; int ui = 0;
    if (!S.next(0, cur)) return;
    f32x4 acc[2][2][4][2];
#pragma unroll
    for (int a = 0; a < 2; ++a)
#pragma unroll
        for (int b = 0; b < 2; ++b)
#pragma unroll
            for (int m = 0; m < 4; ++m)
#pragma unroll
                for (int n = 0; n < 2; ++n) acc[a][b][m][n] = (f32x4){0.f, 0.f, 0.f, 0.f};
    bf16x8 At[4][2], B0[2][2], B1[2][2];
    const char* cA = (const char*)g.A + (size_t)cur.pm * tstep; const char* cB = (const char*)g.Bt + (size_t)cur.pn * tstep;
    S.a_ready(cur);
    if constexpr (SP2) {
        PG8_STAGE(PG8_SB(0, 0), cB, voffB); PG8_STAGE(PG8_SB(0, 1), cB + hstep, voffB); PG8_STAGE(PG8_SA(0, 0), cA, voffA); PG8_STAGE(PG8_SA(0, 1), cA + hstep, voffA);
        if (wr == 1) PG8_BAR;
        PG8_WAIT_V(2); PG8_BAR;
        PG8_STAGE(PG8_SB(1, 0), cB + kstep, voffB); PG8_STAGE(PG8_SA(1, 0), cA + kstep, voffA); PG8_STAGE(PG8_SB(1, 1), cB + hstep + kstep, voffB);
        PG8_WAIT_V(6); PG8_BAR;
    } else {
        PG8_STAGE(PG8_SB(0, 0), cB, voffB); PG8_STAGE(PG8_SA(0, 0), cA, voffA); PG8_STAGE(PG8_SB(0, 1), cB + hstep, voffB); PG8_STAGE(PG8_SA(0, 1), cA + hstep, voffA);
        if (wr == 1) PG8_BAR;
        PG8_WAIT_V(4); PG8_BAR;
        PG8_STAGE(PG8_SB(1, 0), cB + kstep, voffB); PG8_STAGE(PG8_SA(1, 0), cA + kstep, voffA); PG8_STAGE(PG8_SB(1, 1), cB + hstep + kstep, voffB);
        PG8_WAIT_V(6); PG8_BAR;
    }
    for (;;) {
        const bool has_next = S.next(ui + 1, nxt);
        const char* nA = has_next ? (const char*)g.A + (size_t)nxt.pm * tstep : cA; const char* nB = has_next ? (const char*)g.Bt + (size_t)nxt.pn * tstep : cB;
        for (int t = 0; t < nt; t += 2) {
            const bool last = (t == nt - 2);
            const char* a1 = cA + (size_t)(t + 1) * kstep;
            const char* a2 = last ? nA : cA + (size_t)(t + 2) * kstep; const char* b2 = last ? nB : cB + (size_t)(t + 2) * kstep;
            const char* a3 = a2 + kstep; const char* b3 = b2 + kstep;
            if (last && has_next) S.a_ready(nxt);
            if constexpr (SP2) {
            PG8_LDB(B0, 0, 0); PG8_LDB(B1, 0, 1); PG8_SCHED; PG8_LDA(At, 0, 0); PG8_STAGE(PG8_SA(1, 1), a1 + hstep, voffA);
            PG8_WAIT_V(8); PG8_WAIT_L(0); PG8_BAR; PG8_MMA(0, 0, At, B0); PG8_MMA(0, 1, At, B1); PG8_BAR; PG8_SCHED;
            PG8_LDA(At, 0, 1); PG8_STAGE(PG8_SB(0, 0), b2, voffB); PG8_STAGE(PG8_SB(0, 1), b2 + hstep, voffB); PG8_STAGE(PG8_SA(0, 0), a2, voffA);
            PG8_WAIT_V(8); PG8_WAIT_L(0); PG8_BAR; PG8_MMA(1, 0, At, B0); PG8_MMA(1, 1, At, B1); PG8_BAR; PG8_SCHED;
            PG8_LDB(B0, 1, 0); PG8_LDB(B1, 1, 1); PG8_SCHED; PG8_LDA(At, 1, 0); PG8_STAGE(PG8_SA(0, 1), a2 + hstep, voffA);
            PG8_WAIT_V(8); PG8_WAIT_L(0); PG8_BAR; PG8_MMA(0, 0, At, B0); PG8_MMA(0, 1, At, B1); PG8_BAR; PG8_SCHED;
            PG8_LDA(At, 1, 1); PG8_STAGE(PG8_SB(1, 0), b3, voffB); PG8_STAGE(PG8_SB(1, 1), b3 + hstep, voffB); PG8_STAGE(PG8_SA(1, 0), a3, voffA);
            PG8_WAIT_V(8); PG8_WAIT_L(0); PG8_BAR; PG8_MMA(1, 0, At, B0); PG8_MMA(1, 1, At, B1); PG8_BAR; PG8_SCHED;
            } else {
            PG8_LDB(B0, 0, 0); PG8_SCHED; PG8_LDA(At, 0, 0); PG8_STAGE(PG8_SA(1, 1), a1 + hstep, voffA);
            PG8_WAIT_L(8); PG8_BAR; PG8_WAIT_L(0); PG8_MMA(0, 0, At, B0); PG8_BAR; PG8_SCHED;
            PG8_LDB(B1, 0, 1); PG8_STAGE(PG8_SB(0, 0), b2, voffB);
            PG8_BAR; PG8_WAIT_L(0); PG8_MMA(0, 1, At, B1); PG8_BAR;
            PG8_LDA(At, 0, 1); PG8_STAGE(PG8_SA(0, 0), a2, voffA);
            PG8_BAR; PG8_WAIT_L(0); PG8_MMA(1, 0, At, B0); PG8_BAR; PG8_SCHED;
            PG8_STAGE(PG8_SB(0, 1), b2 + hstep, voffB);
            PG8_WAIT_V(6); PG8_BAR; PG8_MMA(1, 1, At, B1); PG8_BAR;
            PG8_LDB(B0, 1, 0); PG8_SCHED; PG8_LDA(At, 1, 0); PG8_STAGE(PG8_SA(0, 1), a2 + hstep, voffA);
            PG8_WAIT_L(8); PG8_BAR; PG8_WAIT_L(0); PG8_MMA(0, 0, At, B0); PG8_BAR; PG8_SCHED;
            PG8_LDB(B1, 1, 1); PG8_STAGE(PG8_SB(1, 0), b3, voffB);
            PG8_BAR; PG8_WAIT_L(0); PG8_MMA(0, 1, At, B1); PG8_BAR;
            PG8_LDA(At, 1, 1); PG8_STAGE(PG8_SA(1, 0), a3, voffA);
            PG8_BAR; PG8_WAIT_L(0); PG8_MMA(1, 0, At, B0); PG8_BAR; PG8_SCHED;
            PG8_STAGE(PG8_SB(1, 1), b3 + hstep, voffB);
            PG8_WAIT_V(6); PG8_BAR; PG8_MMA(1, 1, At, B1); PG8_BAR;
            }
        }
        if constexpr (ALIGN_EPI) { if (wr == 0) PG8_BAR; }
        E(acc, cur, wr, wc, fr, fq); S.done(cur);
        if (!has_next) break;
#pragma unroll
        for (int a = 0; a < 2; ++a)
#pragma unroll
            for (int b = 0; b < 2; ++b)
#pragma unroll
                for (int m = 0; m < 4; ++m)
#pragma unroll
                    for (int n = 0; n < 2; ++n) acc[a][b][m][n] = (f32x4){0.f, 0.f, 0.f, 0.f};
        cur = nxt; cA = nA; cB = nB; ++ui;
        if constexpr (ALIGN_EPI) { if (wr == 1) PG8_BAR; }
    }
    PG8_WAIT_V(0);
    if constexpr (!ALIGN_EPI) { if (wr == 0) PG8_BAR; }
    PG8_BAR;
#undef PG8_SA
#undef PG8_SB
#undef PG8_STAGE
#undef PG8_LDA
#undef PG8_LDB
#undef PG8_MMA
#undef PG8_WAIT_V
#undef PG8_WAIT_L
#undef PG8_BAR
#undef PG8_SCHED
}

struct EpiResid {
    static constexpr bool PERM = false, AFTER_DRAIN = false;
    const float* xin; float* xout; const float* gate;
    __device__ __forceinline__ void operator()(const f32x4 (&acc)[2][2][4][2], const Unit& u, int wr, int wc, int fr, int fq) const {
        const int row0 = u.pm * BM + wr * 64 + fr, col0 = u.pn * BM + wc * 32 + 4 * fq;
        const float* gp = gate + (u.pm >= (SEQ / BM) ? 3 * D : 0);
        f32x4 gv[2][2];
#pragma unroll
        for (int bj = 0; bj < 2; ++bj)
#pragma unroll
            for (int n = 0; n < 2; ++n) gv[bj][n] = *(const f32x4*)(gp + col0 + bj * HALF + n * 16);
#pragma unroll
        for (int ai = 0; ai < 2; ++ai)
#pragma unroll
            for (int m = 0; m < 4; ++m) { const size_t off = (size_t)(row0 + ai * HALF + m * 16) * D + col0;
#pragma unroll
                for (int bj = 0; bj < 2; ++bj)
#pragma unroll
                    for (int n = 0; n < 2; ++n) { const f32x4 xi = *(const f32x4*)(xin + off + bj * HALF + n * 16);
                        *(f32x4*)(xout + off + bj * HALF + n * 16) = xi + gv[bj][n] * acc[ai][bj][m][n]; } }
    }
};
struct EpiRelu2 {
    static constexpr bool PERM = true, AFTER_DRAIN = false;
    bf16_t* O; int ldc;
    __device__ __forceinline__ void operator()(const f32x4 (&acc)[2][2][4][2], const Unit& u, int wr, int wc, int fr, int fq) const {
        const int row0 = u.pm * BM + wr * 64 + fr, col0 = u.pn * BM + wc * 32 + 8 * fq;
#pragma unroll
        for (int ai = 0; ai < 2; ++ai)
#pragma unroll
            for (int m = 0; m < 4; ++m) { bf16_t* rowp = O + (size_t)(row0 + ai * HALF + m * 16) * ldc + col0;
#pragma unroll
                for (int bj = 0; bj < 2; ++bj) { f32x4 v0 = acc[ai][bj][m][0], v1 = acc[ai][bj][m][1];
#pragma unroll
                    for (int j = 0; j < 4; ++j) { const float a = fmaxf(v0[j], 0.f), b = fmaxf(v1[j], 0.f); v0[j] = a * a; v1[j] = b * b; }
                    u32x4 w; w.x = cvt_pk_bf16(v0[0], v0[1]); w.y = cvt_pk_bf16(v0[2], v0[3]); w.z = cvt_pk_bf16(v1[0], v1[1]); w.w = cvt_pk_bf16(v1[2], v1[3]);
                    *(u32x4*)(rowp + bj * HALF) = w; } }
    }
};
struct EpiBias {
    static constexpr bool PERM = true, AFTER_DRAIN = false;
    bf16_t* O; int ldc; const float* bias;
    __device__ __forceinline__ void operator()(const f32x4 (&acc)[2][2][4][2], const Unit& u, int wr, int wc, int fr, int fq) const {
        const int row0 = u.pm * BM + wr * 64 + fr, col0 = u.pn * BM + wc * 32 + 8 * fq;
        f32x4 bv[2][2];
#pragma unroll
        for (int bj = 0; bj < 2; ++bj)
#pragma unroll
            for (int n = 0; n < 2; ++n) bv[bj][n] = *(const f32x4*)(bias + col0 + bj * HALF + 4 * n);
#pragma unroll
        for (int ai = 0; ai < 2; ++ai)
#pragma unroll
            for (int m = 0; m < 4; ++m) { bf16_t* rowp = O + (size_t)(row0 + ai * HALF + m * 16) * ldc + col0;
#pragma unroll
                for (int bj = 0; bj < 2; ++bj) { const f32x4 v0 = acc[ai][bj][m][0] + bv[bj][0], v1 = acc[ai][bj][m][1] + bv[bj][1];
                    u32x4 w; w.x = cvt_pk_bf16(v0[0], v0[1]); w.y = cvt_pk_bf16(v0[2], v0[3]); w.z = cvt_pk_bf16(v1[0], v1[1]); w.w = cvt_pk_bf16(v1[2], v1[3]);
                    *(u32x4*)(rowp + bj * HALF) = w; } }
    }
};
struct EpiHgIn {
    static constexpr bool PERM = true, AFTER_DRAIN = false;
    bf16_t *Q, *V, *GT, *GF, *GB; const float* lbraw; int jl;
    __device__ __forceinline__ void operator()(const f32x4 (&acc)[2][2][4][2], const Unit& u, int wr, int wc, int fr, int fq) const {
        const int sec = u.pn >> 2;
        const int row0 = u.pm * BM + wr * 64 + fr, col0 = (u.pn & 3) * BM + wc * 32 + 8 * fq;
        bf16_t* base = sec == 0 ? Q : sec == 1 ? V : sec == 2 ? GF : sec == 3 ? GB : GT;
        float lb[2][8];
#pragma unroll
        for (int bj = 0; bj < 2; ++bj)
#pragma unroll
            for (int j = 0; j < 8; ++j) lb[bj][j] = 0.f;
        if ((sec == 2 || sec == 3) && jl == 1) {
            const float* r0 = lbraw + (size_t)(sec - 2) * 2 * D;
#pragma unroll
            for (int bj = 0; bj < 2; ++bj)
#pragma unroll
                for (int j = 0; j < 8; ++j) { const int c = col0 + bj * HALF + j; const float a0 = r0[c], a1 = r0[D + c]; lb[bj][j] = 1.0f / (1.0f + __expf(a0 - a1));   }
        }
#pragma unroll
        for (int ai = 0; ai < 2; ++ai)
#pragma unroll
            for (int m = 0; m < 4; ++m) { bf16_t* rowp = base + (size_t)(row0 + ai * HALF + m * 16) * D + col0;
#pragma unroll
                for (int bj = 0; bj < 2; ++bj) { float v[8];
#pragma unroll
                    for (int j = 0; j < 4; ++j) { v[j] = acc[ai][bj][m][0][j]; v[4 + j] = acc[ai][bj][m][1][j]; }
                    u32x4 w;
                    if (sec == 0 || sec == 4) {
#pragma unroll
                        for (int j = 0; j < 8; ++j) v[j] = siluf_(v[j]);
                        w.x = cvt_pk_bf16(v[0], v[1]); w.y = cvt_pk_bf16(v[2], v[3]); w.z = cvt_pk_bf16(v[4], v[5]); w.w = cvt_pk_bf16(v[6], v[7]);
                    } else if (sec == 1) {
                        w.x = cvt_pk_bf16(v[0], v[1]); w.y = cvt_pk_bf16(v[2], v[3]); w.z = cvt_pk_bf16(v[4], v[5]); w.w = cvt_pk_bf16(v[6], v[7]);
                    } else {
#pragma unroll
                        for (int j = 0; j < 8; ++j) { const float l = lb[bj][j]; const float f = l + (1.0f - l) * sigmoidf_(v[j]); v[j] = fmaxf(__logf(f), -100.0f); }
                        w.x = pkh2(v[0], v[1]); w.y = pkh2(v[2], v[3]); w.z = pkh2(v[4], v[5]); w.w = pkh2(v[6], v[7]);
                    }
                    *(u32x4*)(rowp + bj * HALF) = w; } }
    }
};
}

#define XB_TMO      128
#define XB_XCNT(j)  (256  + 64 * (j))
#define XB_XSUB(j)  (1280 + 64 * (j))
#define XB_XGEN(j)  (2304 + 64 * (j))
#define XB_TOP      3328
#define XB_TOPGEN   3392
#define XCD_BAR_WORDS 3456
#define XB_SPIN_CAP (1u << 18)
__device__ __forceinline__ unsigned xb_ld(unsigned* p)              { return __hip_atomic_load(p, __ATOMIC_RELAXED, __HIP_MEMORY_SCOPE_AGENT); }
__device__ __forceinline__ unsigned xb_add(unsigned* p, unsigned v) { return __hip_atomic_fetch_add(p, v, __ATOMIC_RELAXED, __HIP_MEMORY_SCOPE_AGENT); }
__device__ __forceinline__ unsigned xb_xcc_id() { return (unsigned)__builtin_amdgcn_s_getreg((3 << 11) | 20) & 0xFu; }
#define XB_SPIN(cond, bar) do { unsigned _sp = 0; while (cond) { __builtin_amdgcn_s_sleep(1); \
    if ((++_sp & 255u) == 0u) { if (xb_ld(&(bar)[XB_TMO])) break; if (_sp > XB_SPIN_CAP) { atomicAdd(&(bar)[XB_TMO], 1u); break; } } } } while (0)
struct XcdBarrier { unsigned* bar; unsigned x; volatile LAS unsigned* st; };
__device__ __forceinline__ XcdBarrier xcd_barrier_post(unsigned* bar, volatile LAS unsigned* st) {
    XcdBarrier b; b.bar = bar; b.x = xb_xcc_id(); b.st = st;
    if (threadIdx.x == 0) (void)xb_add(&bar[XB_XCNT(b.x)], 1u);
    return b;
}
__device__ __forceinline__ void xcd_barrier_complete(unsigned* bar, unsigned x, unsigned& nloc, unsigned& nx) {
    const unsigned G = gridDim.x * gridDim.y * gridDim.z;
    unsigned sum, cnt, mine, sp = 0u;
    for (;;) {
        sum = 0u; cnt = 0u; mine = 0u;
#pragma unroll
        for (unsigned j = 0; j < 16; ++j) { const unsigned c = xb_ld(&bar[XB_XCNT(j)]); sum += c; cnt += (c > 0u) ? 1u : 0u; mine = (j == x) ? c : mine; }
        if (sum == G) break;
        __builtin_amdgcn_s_sleep(1);
        if ((++sp & 255u) == 0u) { if (xb_ld(&bar[XB_TMO])) break; if (sp > XB_SPIN_CAP) { atomicAdd(&bar[XB_TMO], 1u); break; } }
    }
    nloc = mine > 0u ? mine : 1u; nx = cnt > 0u ? cnt : 1u;
}
__device__ __forceinline__ void xcd_barrier(const XcdBarrier& b) {
    asm volatile("s_waitcnt vmcnt(0)" ::: "memory");
    __syncthreads();
    if (threadIdx.x == 0) {
        unsigned* bar = b.bar;
        __builtin_amdgcn_s_waitcnt(0);
        unsigned nloc = b.st[0], nx = b.st[1];
        if (nloc == 0u) { xcd_barrier_complete(bar, b.x, nloc, nx); b.st[0] = nloc; b.st[1] = nx; }
        const unsigned old = xb_add(&bar[XB_XSUB(b.x)], 1u);
        const unsigned gen = old / nloc;
        if (old + 1u == (gen + 1u) * nloc) {
            __builtin_amdgcn_fence(__ATOMIC_RELEASE, "agent");
            asm volatile("s_waitcnt vmcnt(0)" ::: "memory");
            const unsigned og = xb_add(&bar[XB_TOP], 1u);
            const unsigned tg = og / nx;
            if (og + 1u == (tg + 1u) * nx) xb_add(&bar[XB_TOPGEN], 1u);
            else XB_SPIN(xb_ld(&bar[XB_TOPGEN]) == tg, bar);
            __builtin_amdgcn_fence(__ATOMIC_ACQUIRE, "agent");
            xb_add(&bar[XB_XGEN(b.x)], 1u);
            asm volatile("s_waitcnt vmcnt(0)" ::: "memory");
        } else {
            XB_SPIN(xb_ld(&bar[XB_XGEN(b.x)]) == gen, bar);
            __builtin_amdgcn_fence(__ATOMIC_ACQUIRE, "agent");
            asm volatile("s_waitcnt vmcnt(0)" ::: "memory");
        }
    }
    __syncthreads();
}

__device__ __forceinline__ void transpose_item(const float* W, int K, int N, u16* WT, LAS float* scr, int item, int lane) {
    const int nblk = N / 32, kb = item / nblk, nb = item % nblk, k0 = 64 * kb, n0 = 32 * nb;
#pragma unroll 8
    for (int i = 0; i < 32; ++i) { const int kk = 2 * i + (lane >> 5); scr[kk * 33 + (lane & 31)] = W[(size_t)(k0 + kk) * N + n0 + (lane & 31)]; }
    LDS_WAIT(); asm volatile("" ::: "memory");
    const int c = lane & 7;
#pragma unroll
    for (int j = 0; j < 4; ++j) { const int n = (lane >> 3) + 8 * j; const LAS float* s = scr + (8 * c) * 33 + n;
        u32x4 o; o.x = pk2(s[0 * 33], s[1 * 33]); o.y = pk2(s[2 * 33], s[3 * 33]); o.z = pk2(s[4 * 33], s[5 * 33]); o.w = pk2(s[6 * 33], s[7 * 33]);
        *(u32x4*)(WT + (size_t)(n0 + n) * K + k0 + 8 * c) = o; }
    LDS_WAIT(); asm volatile("" ::: "memory");
}
__device__ __forceinline__ void convert_weights(const float* w0, int K0, int N0, u16* o0, const float* w1, int K1, int N1, u16* o1, const float* w2, int K2, int N2, u16* o2,
                                                const float* w3, int K3, int N3, u16* o3, LAS float* scr, int gw, int NGW, int lane) {
    const int I0 = (K0 / 64) * (N0 / 32), I1 = (K1 / 64) * (N1 / 32), I2 = (K2 / 64) * (N2 / 32), I3 = (K3 / 64) * (N3 / 32);
    for (int it = gw; it < I0 + I1 + I2 + I3; it += NGW) {
        int r = it;
        if (r < I0) { transpose_item(w0, K0, N0, o0, scr, r, lane); continue; } r -= I0;
        if (r < I1) { transpose_item(w1, K1, N1, o1, scr, r, lane); continue; } r -= I1;
        if (r < I2) { transpose_item(w2, K2, N2, o2, scr, r, lane); continue; } r -= I2;
        transpose_item(w3, K3, N3, o3, scr, r, lane);
    }
}
__device__ __forceinline__ void norm_rows(const float* x, const float* g, const float* ada, u16* hn, int gw, int NGW, int lane) {
    for (int m = gw; m < M; m += NGW) {
        const int b = m >> 13;
        const f32x4* xr = (const f32x4*)(x + (size_t)m * D) + lane;
        f32x4 v[4]; float s = 0.f;
#pragma unroll
        for (int j = 0; j < 4; ++j) { v[j] = xr[64 * j]; s += (v[j].x * v[j].x + v[j].y * v[j].y) + (v[j].z * v[j].z + v[j].w * v[j].w); }
        const float r = 1.0f / sqrtf(wave_sum(s) * (1.0f / D) + NORM_EPS);
        u32x2* o8 = (u32x2*)(hn + (size_t)m * D) + lane;
#pragma unroll
        for (int j = 0; j < 4; ++j) { const int c = 4 * (lane + 64 * j);
            const f32x4 gg = *(const f32x4*)(g + c), sh = *(const f32x4*)(ada + b * 3 * D + c), sc = *(const f32x4*)(ada + b * 3 * D + D + c);
            const f32x4 y = v[j] * r * gg * (sc + 1.0f) + sh;
            u32x2 w; w.x = pk2(y.x, y.y); w.y = pk2(y.z, y.w); o8[64 * j] = w; }
    }
}
__device__ __forceinline__ void final_norm_rows(float* x, const float* g, int gw, int NGW, int lane) {
    for (int m = gw; m < M; m += NGW) {
        f32x4* xr = (f32x4*)(x + (size_t)m * D) + lane;
        f32x4 v[4]; float s = 0.f;
#pragma unroll
        for (int j = 0; j < 4; ++j) { v[j] = xr[64 * j]; s += (v[j].x * v[j].x + v[j].y * v[j].y) + (v[j].z * v[j].z + v[j].w * v[j].w); }
        const float r = 1.0f / sqrtf(wave_sum(s) * (1.0f / D) + NORM_EPS);
#pragma unroll
        for (int j = 0; j < 4; ++j) { const f32x4 gg = *(const f32x4*)(g + 4 * (lane + 64 * j)); xr[64 * j] = v[j] * r * gg; }
    }
}

__device__ __forceinline__ void phase_p0(const float* cin, const float* ada_w, const float* ada_b, float* ADA,
                                         const float* fwin, const float* fwmid, const float* fb, const float* ffreq, float* HDN, const float* fwout, float* WOT,
                                         LAS unsigned char* lds, int tid, int blk, int G) {
    for (int i = blk * 512 + tid; i < 2 * 2 * D * FW; i += G * 512) { const int w = i & 63, col = (i >> 6) & (2 * D - 1), j = i >> 17; WOT[i] = fwout[(size_t)(j * FW + w) * 2 * D + col]; }
    LAS float* sc = (LAS float*)lds;
    LAS float* red = sc + 2048;
    for (int i = tid; i < 2 * D; i += 512) sc[i] = siluf_(cin[i]);
    __syncthreads();
    {
        const int cl = tid & 31, ks = tid >> 5;
        for (int gidx = blk; gidx < 8 * 96; gidx += G) {
            const int mat = gidx / 96, col0 = (gidx % 96) * 32;
            const float* w = ada_w + (size_t)mat * D * 3 * D + col0 + cl;
            float a0 = 0.f, a1 = 0.f;
#pragma unroll 8
            for (int k = ks * 64; k < ks * 64 + 64; ++k) { const float wv = w[(size_t)k * 3 * D]; a0 += sc[k] * wv; a1 += sc[D + k] * wv; }
            red[(ks * 2 + 0) * 32 + cl] = a0; red[(ks * 2 + 1) * 32 + cl] = a1;
            __syncthreads();
            if (tid < 64) { const int b = tid >> 5; float s = ada_b[mat * 3 * D + col0 + cl];
                for (int k2 = 0; k2 < 16; ++k2) s += red[(k2 * 2 + b) * 32 + cl];
                ADA[(size_t)(mat * 2 + b) * 3 * D + col0 + cl] = s; }
            __syncthreads();
        }
    }
    {
        LAS float* emb = (LAS float*)lds + 4096;
        LAS float* hA = emb + 8 * 36;
        LAS float* hB = hA + 512;
        for (int it = blk; it < 2 * (SEQ / 8); it += G) {
            const int j = it / (SEQ / 8), t0 = (it % (SEQ / 8)) * 8;
            if (tid < 8 * EMB) { const int tl = tid / EMB, e = tid % EMB, t = t0 + tl; float val;
                if (e == 0) val = (float)t / (float)(SEQ - 1);
                else { const int bi = (e - 1) & 15; const float band = 1e-4f + (float)bi * ((15.0f - 1e-4f) / 15.0f);
                    float rv = (float)t * band * (1.0f / SEQ); rv = rv - floorf(rv); val = (e <= 16) ? cos_rev(rv) : -sin_rev(rv); }
                emb[tl * 36 + e] = val; }
            __syncthreads();
            const int tl = tid >> 6, w = tid & 63;
            const float fq_ = ffreq[j * FW + w];
            float a = fb[(j * 3 + 0) * FW + w];
            for (int e = 0; e < EMB; ++e) a += emb[tl * 36 + e] * fwin[(size_t)(j * EMB + e) * FW + w];
            hA[tl * 64 + w] = fast_sin(fq_ * a);
            __syncthreads();
            a = fb[(j * 3 + 1) * FW + w];
            for (int v = 0; v < FW; ++v) a += hA[tl * 64 + v] * fwmid[(size_t)((j * 2 + 0) * FW + v) * FW + w];
            hB[tl * 64 + w] = fast_sin(fq_ * a);
            __syncthreads();
            a = fb[(j * 3 + 2) * FW + w];
            for (int v = 0; v < FW; ++v) a += hB[tl * 64 + v] * fwmid[(size_t)((j * 2 + 1) * FW + v) * FW + w];
            HDN[((size_t)j * SEQ + t0 + tl) * FW + w] = fast_sin(fq_ * a);
            __syncthreads();
        }
    }
}
__device__ __forceinline__ void filter_gen(const float* HDNj, const float* WOTj  , float* FT, int tid, int blk, int G) {
    for (int it = blk; it < 256 * 16; it += G) {
        const int cb = it >> 4, tb = it & 15, t = tb * 512 + tid;
        f32x4 hv[16];
        const f32x4* hp = (const f32x4*)(HDNj + (size_t)t * FW);
#pragma unroll
        for (int i = 0; i < 16; ++i) hv[i] = hp[i];
        const float tn = (float)t / (float)(SEQ - 1);
#pragma unroll 2
        for (int c8 = 0; c8 < 8; ++c8) {
            const int col = cb * 8 + c8, ch = col & (D - 1);
            const int wl = __builtin_bit_cast(int, WOTj[(size_t)col * FW + (tid & 63)]);
            float a = 0.f;
#pragma unroll
            for (int i = 0; i < 16; ++i) a += hv[i].x * __builtin_bit_cast(float, __builtin_amdgcn_readlane(wl, 4 * i)) + hv[i].y * __builtin_bit_cast(float, __builtin_amdgcn_readlane(wl, 4 * i + 1))
                                            + hv[i].z * __builtin_bit_cast(float, __builtin_amdgcn_readlane(wl, 4 * i + 2)) + hv[i].w * __builtin_bit_cast(float, __builtin_amdgcn_readlane(wl, 4 * i + 3));
            const float delta = fabsf(HY_MIN_DECAY + (float)ch * ((HY_MAX_DECAY - HY_MIN_DECAY) / (float)(D - 1)));
            FT[(size_t)col * SEQ + t] = a * __expf(-tn * delta);
        }
    }
}

__device__ __forceinline__ void hg_scan1(const u16* GF, const u16* GB, const u16* V, u16* Sbuf, int tid, int blk, int G) {
    const int lane = tid & 63, wv = __builtin_amdgcn_readfirstlane(tid >> 6);
    const int q4 = lane >> 4, r16 = lane & 15;
    for (int wi = blk; wi < 256; wi += G) {
        const int n = wi >> 6, h = (wi >> 3) & 7, ds = wi & 7, dir = n >> 1, b = n & 1;
        const u16* Gp = (dir ? GB : GF) + (size_t)b * SEQ * D + h * DK + ds * 16 + r16;
        const u16* Vp = V + (size_t)b * SEQ * D + h * DV + wv * 16 + r16;
        u16* Sp = Sbuf + (size_t)(n * NH + h) * NCH * (DV * DK) + (size_t)(wv * 16 + r16) * DK + ds * 16 + 4 * q4;
        f32x4 S = (f32x4){0.f, 0.f, 0.f, 0.f};
        unsigned short rgA[8], rgB[8], rvA[8], rvB[8];
        { const size_t trow = (size_t)(dir ? (NCH - 1) : 0) * CH;
#pragma unroll
          for (int j = 0; j < 8; ++j) { const size_t ta = (trow + 8 * q4 + j) * D, tb = (trow + 32 + 8 * q4 + j) * D; rgA[j] = Gp[ta]; rgB[j] = Gp[tb]; rvA[j] = Vp[ta]; rvB[j] = Vp[tb]; } }
        for (int step = 0; step < NCH; ++step) {
            const int c = dir ? (NCH - 1 - step) : step;
            { u32x2 w; w.x = pk2(S[0], S[1]); w.y = pk2(S[2], S[3]); *(u32x2*)(Sp + (size_t)c * (DV * DK)) = w; }
            float gA[8], gB[8]; unsigned vA[8], vB[8];
#pragma unroll
            for (int j = 0; j < 8; ++j) { gA[j] = h2f(rgA[j]); gB[j] = h2f(rgB[j]); vA[j] = rvA[j]; vB[j] = rvB[j]; }
            if (step + 1 < NCH) { const size_t trow = (size_t)(dir ? (c - 1) : (c + 1)) * CH;
#pragma unroll
                for (int j = 0; j < 8; ++j) { const size_t ta = (trow + 8 * q4 + j) * D, tb = (trow + 32 + 8 * q4 + j) * D; rgA[j] = Gp[ta]; rgB[j] = Gp[tb]; rvA[j] = Vp[ta]; rvB[j] = Vp[tb]; } }
            float sA = 0.f, sB = 0.f;
#pragma unroll
            for (int j = 0; j < 8; ++j) { sA += gA[j]; sB += gB[j]; }
            float seg[8];
#pragma unroll
            for (int qq = 0; qq < 4; ++qq) { seg[qq] = __shfl(sA, r16 + 16 * qq); seg[4 + qq] = __shfl(sB, r16 + 16 * qq); }
            float tot = 0.f;
#pragma unroll
            for (int i = 0; i < 8; ++i) tot += seg[i];
            float offA = 0.f, offB = 0.f;
#pragma unroll
            for (int i = 0; i < 8; ++i) {
                const bool afterA = i > q4, beforeA = i < q4, afterB = i > 4 + q4, beforeB = i < 4 + q4;
                offA += (dir ? beforeA : afterA) ? seg[i] : 0.f;
                offB += (dir ? beforeB : afterB) ? seg[i] : 0.f;
            }
            float eA[8], eB[8];
            if (dir == 0) { float ra = offA, rb = offB;
#pragma unroll
                for (int j = 7; j >= 0; --j) { eA[j] = ra; ra += gA[j]; eB[j] = rb; rb += gB[j]; }
            } else { float ra = offA, rb = offB;
#pragma unroll
                for (int j = 0; j < 8; ++j) { eA[j] = ra; ra += gA[j]; eB[j] = rb; rb += gB[j]; }
            }
            bf16x8 fa0, fa1, fb0, fb1;
#pragma unroll
            for (int j = 0; j < 8; ++j) {
                const float ka = (1.0f - __expf(gA[j])) * __expf(eA[j]), kb = (1.0f - __expf(gB[j])) * __expf(eB[j]);
                fa0[j] = (short)f2bf(ka); fa1[j] = (short)f2bf(kb); fb0[j] = (short)vA[j]; fb1[j] = (short)vB[j];
            }
            const float etot = __expf(tot);
#pragma unroll
            for (int r = 0; r < 4; ++r) S[r] *= __shfl(etot, 4 * q4 + r);
            S = __builtin_amdgcn_mfma_f32_16x16x32_bf16(fa0, fb0, S, 0, 0, 0);
            S = __builtin_amdgcn_mfma_f32_16x16x32_bf16(fa1, fb1, S, 0, 0, 0);
        }
    }
}

constexpr int HO_LD = 136;
constexpr int HO_LV = 72;
constexpr int HO_QF = 0, HO_KF = 64 * HO_LD * 2, HO_QB = 2 * HO_KF, HO_KB = 3 * HO_KF, HO_VT = 4 * HO_KF, HO_AT = HO_VT + 128 * HO_LV * 2, HO_SEG = HO_AT + 64 * HO_LV * 2, HO_SSQ = HO_SEG + 2 * 4 * 128 * 4, HO_END = HO_SSQ + 64 * 8 * 4;
static_assert(HO_END <= RING_BYTES, "hg_out LDS");
__device__ __forceinline__ void hg_out(const u16* Qb, const u16* Vb, const u16* GTb, const u16* GF, const u16* GB, const u16* Sbuf, const float* hgn  , u16* ON,
                                       LAS unsigned char* lds, int tid, int blk, int G) {
    const int lane = tid & 63, wv = __builtin_amdgcn_readfirstlane(tid >> 6), q4 = lane >> 4, r16 = lane & 15;
    LAS u16* QF = (LAS u16*)(lds + HO_QF); LAS u16* KF = (LAS u16*)(lds + HO_KF); LAS u16* QBt = (LAS u16*)(lds + HO_QB); LAS u16* KBt = (LAS u16*)(lds + HO_KB);
    LAS u16* VT = (LAS u16*)(lds + HO_VT); LAS u16* AT = (LAS u16*)(lds + HO_AT); LAS float* SEG = (LAS float*)(lds + HO_SEG); LAS float* SSQ = (LAS float*)(lds + HO_SSQ);
    for (int it = blk; it < NB * NH * NCH; it += G) {
        const int b = it / (NH * NCH), h = (it / NCH) % NH, c = it % NCH;
        const size_t m0 = (size_t)b * SEQ + (size_t)c * CH;
        {
            const int d = tid & 127, ts = tid >> 7;
            const size_t gofs = (m0 + 16 * ts) * D + h * DK + d;
            float gf[16], gb[16], qv[16];
#pragma unroll
            for (int j = 0; j < 16; ++j) { gf[j] = h2f(GF[gofs + (size_t)j * D]); gb[j] = h2f(GB[gofs + (size_t)j * D]); qv[j] = bf2f(Qb[gofs + (size_t)j * D]); }
            { unsigned vv[16];
#pragma unroll
              for (int j = 0; j < 16; ++j) vv[j] = Vb[gofs + (size_t)j * D];
              u32x4 w0, w1; w0.x = vv[0] | (vv[1] << 16); w0.y = vv[2] | (vv[3] << 16); w0.z = vv[4] | (vv[5] << 16); w0.w = vv[6] | (vv[7] << 16);
              w1.x = vv[8] | (vv[9] << 16); w1.y = vv[10] | (vv[11] << 16); w1.z = vv[12] | (vv[13] << 16); w1.w = vv[14] | (vv[15] << 16);
              *(LAS u32x4*)(VT + d * HO_LV + 16 * ts) = w0; *(LAS u32x4*)(VT + d * HO_LV + 16 * ts + 8) = w1; }
            float pf[16], sb[16];
            { float r = 0.f;
#pragma unroll
              for (int j = 0; j < 16; ++j) { r += gf[j]; pf[j] = r; }
              SEG[(0 * 4 + ts) * 128 + d] = r; r = 0.f;
#pragma unroll
              for (int j = 15; j >= 0; --j) { r += gb[j]; sb[j] = r; }
              SEG[(1 * 4 + ts) * 128 + d] = r; }
            __syncthreads();
            float offf = 0.f, offb = 0.f;
#pragma unroll
            for (int s2 = 0; s2 < 4; ++s2) { const float a = SEG[(0 * 4 + s2) * 128 + d], bb = SEG[(1 * 4 + s2) * 128 + d]; offf += (s2 < ts) ? a : 0.f; offb += (s2 > ts) ? bb : 0.f; }
#pragma unroll
            for (int j = 0; j < 16; ++j) {
                const float bf_ = offf + pf[j], bb_ = offb + sb[j];
                const float kf = 1.0f - __expf(gf[j]), kb = 1.0f - __expf(gb[j]);
                const int o = (16 * ts + j) * HO_LD + d;
                QF[o] = (u16)f2bf(qv[j] * __expf(bf_)); KF[o] = (u16)f2bf(kf * __expf(fminf(-bf_, 80.f)));
                QBt[o] = (u16)f2bf(qv[j] * __expf(bb_)); KBt[o] = (u16)f2bf(kb * __expf(fminf(-bb_, 80.f)));
            }
        }
        __syncthreads();
#pragma unroll 1
        for (int tt = 0; tt < 2; ++tt) {
            const int tile = 2 * wv + tt, ti = tile >> 2, si = tile & 3;
            f32x4 af = (f32x4){0.f, 0.f, 0.f, 0.f}, ab = (f32x4){0.f, 0.f, 0.f, 0.f};
            if (ti >= si) {
#pragma unroll
                for (int kk = 0; kk < 4; ++kk) { const bf16x8 a = *(const LAS bf16x8*)(QF + (16 * ti + r16) * HO_LD + 32 * kk + 8 * q4), bb = *(const LAS bf16x8*)(KF + (16 * si + r16) * HO_LD + 32 * kk + 8 * q4);
                    af = __builtin_amdgcn_mfma_f32_16x16x32_bf16(a, bb, af, 0, 0, 0); }
            }
            if (ti <= si) {
#pragma unroll
                for (int kk = 0; kk < 4; ++kk) { const bf16x8 a = *(const LAS bf16x8*)(QBt + (16 * ti + r16) * HO_LD + 32 * kk + 8 * q4), bb = *(const LAS bf16x8*)(KBt + (16 * si + r16) * HO_LD + 32 * kk + 8 * q4);
                    ab = __builtin_amdgcn_mfma_f32_16x16x32_bf16(a, bb, ab, 0, 0, 0); }
            }
#pragma unroll
            for (int r = 0; r < 4; ++r) { const int t = 16 * ti + 4 * q4 + r, s = 16 * si + r16;
                const float vsum = (s <= t ? af[r] : 0.f) + (s >= t ? ab[r] : 0.f);
                AT[t * HO_LV + s] = (u16)f2bf(vsum); }
        }
        __syncthreads();
        f32x4 o[4];
#pragma unroll
        for (int ti = 0; ti < 4; ++ti) o[ti] = (f32x4){0.f, 0.f, 0.f, 0.f};
        {
#pragma unroll
            for (int kk = 0; kk < 2; ++kk) { const bf16x8 bv = *(const LAS bf16x8*)(VT + (16 * wv + r16) * HO_LV + 32 * kk + 8 * q4);
#pragma unroll
                for (int ti = 0; ti < 4; ++ti) { const bf16x8 a = *(const LAS bf16x8*)(AT + (16 * ti + r16) * HO_LV + 32 * kk + 8 * q4); o[ti] = __builtin_amdgcn_mfma_f32_16x16x32_bf16(a, bv, o[ti], 0, 0, 0); } }
            const u16* Sf = Sbuf + ((size_t)((0 * 2 + b) * NH + h) * NCH + c) * (DV * DK) + (size_t)(16 * wv + r16) * DK + 8 * q4;
            const u16* Sb = Sbuf + ((size_t)((1 * 2 + b) * NH + h) * NCH + c) * (DV * DK) + (size_t)(16 * wv + r16) * DK + 8 * q4;
#pragma unroll
            for (int kk = 0; kk < 4; ++kk) { const bf16x8 sf = *(const bf16x8*)(Sf + 32 * kk), sbv = *(const bf16x8*)(Sb + 32 * kk);
#pragma unroll
                for (int ti = 0; ti < 4; ++ti) { const bf16x8 a = *(const LAS bf16x8*)(QF + (16 * ti + r16) * HO_LD + 32 * kk + 8 * q4); o[ti] = __builtin_amdgcn_mfma_f32_16x16x32_bf16(a, sf, o[ti], 0, 0, 0);
                    const bf16x8 a2 = *(const LAS bf16x8*)(QBt + (16 * ti + r16) * HO_LD + 32 * kk + 8 * q4); o[ti] = __builtin_amdgcn_mfma_f32_16x16x32_bf16(a2, sbv, o[ti], 0, 0, 0); } }
        }
#pragma unroll
        for (int ti = 0; ti < 4; ++ti)
#pragma unroll
            for (int r = 0; r < 4; ++r) { float s = o[ti][r] * o[ti][r]; s += __shfl_xor(s, 1); s += __shfl_xor(s, 2); s += __shfl_xor(s, 4); s += __shfl_xor(s, 8);
                if (r16 == 0) SSQ[(16 * ti + 4 * q4 + r) * 8 + wv] = s; }
        __syncthreads();
        {
            const int dv = 16 * wv + r16; const float gn = hgn[dv];
#pragma unroll
            for (int ti = 0; ti < 4; ++ti)
#pragma unroll
                for (int r = 0; r < 4; ++r) { const int t = 16 * ti + 4 * q4 + r; const LAS f32x4* sp = (const LAS f32x4*)(SSQ + t * 8); const f32x4 s0 = sp[0], s1 = sp[1];
                    const float ss = (s0.x + s0.y + s0.z + s0.w) + (s1.x + s1.y + s1.z + s1.w);
                    const float rn = 1.0f / sqrtf(ss * (1.0f / DV) + NORM_EPS);
                    const size_t go = (m0 + t) * D + h * DV + dv;
                    ON[go] = (u16)f2bf(o[ti][r] * rn * gn * bf2f(GTb[go])); }
        }
        __syncthreads();
    }
}

__device__ __forceinline__ void hy_zprep(const u16* U, const float* cw  , const float* cbias  , f32x2* ZT, LAS unsigned char* lds, int tid, int blk, int G) {
    LAS float* zt = (LAS float*)lds;
    for (int it = blk; it < (SEQ / 64) * (D / 64); it += G) {
        const int tb = it >> 4, cbk = it & 15, t0 = tb * 64, c0 = cbk * 64;
        const int ch = tid & 63, tq = tid >> 6, c = c0 + ch;
        const float a0 = cw[0 * 3 * D + D + c], a1 = cw[1 * 3 * D + D + c], a2 = cw[2 * 3 * D + D + c], ab = cbias[D + c];
        const float v0 = cw[0 * 3 * D + 2 * D + c], v1 = cw[1 * 3 * D + 2 * D + c], v2 = cw[2 * 3 * D + 2 * D + c], vb = cbias[2 * D + c];
#pragma unroll
        for (int b = 0; b < 2; ++b) {
            float u1[10], uv[10];
#pragma unroll
            for (int i = 0; i < 10; ++i) { const int tt = t0 + tq * 8 - 1 + i; const bool ok = (tt >= 0) && (tt < SEQ);
                const size_t ro = ((size_t)b * SEQ + (ok ? tt : 0)) * (3 * D);
                u1[i] = ok ? bf2f(U[ro + D + c]) : 0.f; uv[i] = ok ? bf2f(U[ro + 2 * D + c]) : 0.f; }
#pragma unroll
            for (int i = 0; i < 8; ++i) { const float x1c = u1[i] * a0 + u1[i + 1] * a1 + u1[i + 2] * a2 + ab, vc = uv[i] * v0 + uv[i + 1] * v1 + uv[i + 2] * v2 + vb;
                zt[(ch * 65 + tq * 8 + i) * 2 + b] = x1c * vc; }
        }
        __syncthreads();
        { const int tt = tid & 63;
#pragma unroll
          for (int r = 0; r < 8; ++r) { const int chh = (tid >> 6) + 8 * r; f32x2 v; v.x = zt[(chh * 65 + tt) * 2]; v.y = zt[(chh * 65 + tt) * 2 + 1]; ZT[(size_t)(c0 + chh) * SEQ + t0 + tt] = v; } }
        __syncthreads();
    }
}
__device__ __forceinline__ void hy_gate(const u16* U, const float* cw, const float* cbias, const f32x2* YT, u16* YG, LAS unsigned char* lds, int tid, int blk, int G) {
    LAS float* zt = (LAS float*)lds;
    for (int it = blk; it < (SEQ / 64) * (D / 64); it += G) {
        const int tb = it >> 4, cbk = it & 15, t0 = tb * 64, c0 = cbk * 64;
        { const int tt = tid & 63;
#pragma unroll
          for (int r = 0; r < 8; ++r) { const int chh = (tid >> 6) + 8 * r; const f32x2 v = YT[(size_t)(c0 + chh) * SEQ + t0 + tt]; zt[(chh * 65 + tt) * 2] = v.x; zt[(chh * 65 + tt) * 2 + 1] = v.y; } }
        __syncthreads();
        const int ch = tid & 63, tq = tid >> 6, c = c0 + ch;
        const float a0 = cw[0 * 3 * D + c], a1 = cw[1 * 3 * D + c], a2 = cw[2 * 3 * D + c], ab = cbias[c];
#pragma unroll
        for (int b = 0; b < 2; ++b) {
            float u0[10];
#pragma unroll
            for (int i = 0; i < 10; ++i) { const int tt = t0 + tq * 8 - 1 + i; const bool ok = (tt >= 0) && (tt < SEQ);
                const size_t ro = ((size_t)b * SEQ + (ok ? tt : 0)) * (3 * D); u0[i] = ok ? bf2f(U[ro + c]) : 0.f; }
#pragma unroll
            for (int i = 0; i < 8; ++i) { const float x0c = u0[i] * a0 + u0[i + 1] * a1 + u0[i + 2] * a2 + ab;
                YG[((size_t)b * SEQ + t0 + tq * 8 + i) * D + c] = (u16)f2bf(x0c * zt[(ch * 65 + tq * 8 + i) * 2 + b]); }
        }
        __syncthreads();
    }
}
__device__ __forceinline__ int fpad(int e) { return e + ((e >> 6) << 2); }
__device__ __forceinline__ f32x2 cmul(f32x2 a, f32x2 b) { f32x2 r; r.x = a.x * b.x - a.y * b.y; r.y = a.x * b.y + a.y * b.x; return r; }
__device__ __forceinline__ f32x2 cmulc(f32x2 a, f32x2 b) { f32x2 r; r.x = a.x * b.x + a.y * b.y; r.y = a.y * b.x - a.x * b.y; return r; }
template <bool INV> __device__ __forceinline__ void radix4(f32x2& a0, f32x2& a1, f32x2& a2, f32x2& a3) {
    const f32x2 t0 = a0 + a2, t1 = a0 - a2, t2 = a1 + a3, t3 = a1 - a3;
    a0 = t0 + t2; a2 = t0 - t2;
    if (!INV) { a1.x = t1.x + t3.y; a1.y = t1.y - t3.x; a3.x = t1.x - t3.y; a3.y = t1.y + t3.x; }
    else      { a1.x = t1.x - t3.y; a1.y = t1.y + t3.x; a3.x = t1.x + t3.y; a3.y = t1.y - t3.x; }
}
template <bool INV> __device__ __forceinline__ void dft16(f32x2 (&x)[16]) {
    constexpr float C1 = 0.92387953251128674f, S1 = 0.38268343236508977f, R2 = 0.70710678118654752f;
#pragma unroll
    for (int b = 0; b < 4; ++b) radix4<INV>(x[b], x[4 + b], x[8 + b], x[12 + b]);
    const f32x2 W1 = {C1, -S1}, W2 = {R2, -R2}, W3 = {S1, -C1}, W4 = {0.f, -1.f}, W6 = {-R2, -R2}, W9 = {-C1, S1};
    if (!INV) { x[5] = cmul(x[5], W1); x[9] = cmul(x[9], W2); x[13] = cmul(x[13], W3); x[6] = cmul(x[6], W2); x[10] = cmul(x[10], W4); x[14] = cmul(x[14], W6); x[7] = cmul(x[7], W3); x[11] = cmul(x[11], W6); x[15] = cmul(x[15], W9); }
    else      { x[5] = cmulc(x[5], W1); x[9] = cmulc(x[9], W2); x[13] = cmulc(x[13], W3); x[6] = cmulc(x[6], W2); x[10] = cmulc(x[10], W4); x[14] = cmulc(x[14], W6); x[7] = cmulc(x[7], W3); x[11] = cmulc(x[11], W6); x[15] = cmulc(x[15], W9); }
#pragma unroll
    for (int c = 0; c < 4; ++c) radix4<INV>(x[4 * c], x[4 * c + 1], x[4 * c + 2], x[4 * c + 3]);
    f32x2 y[16];
#pragma unroll
    for (int c = 0; c < 4; ++c)
#pragma unroll
        for (int d = 0; d < 4; ++d) y[c + 4 * d] = x[4 * c + d];
#pragma unroll
    for (int i = 0; i < 16; ++i) x[i] = y[i];
}
template <bool CONJ> __device__ __forceinline__ void apply_twid(f32x2 (&x)[16], float f) {
    const f32x2 w1 = {cos_rev(f), -sin_rev(f)}, w8 = {cos_rev(8.f * f), -sin_rev(8.f * f)};
    f32x2 wc = w1;
#pragma unroll
    for (int m = 1; m < 16; ++m) { if (m == 8) wc = w8; x[m] = CONJ ? cmulc(x[m], wc) : cmul(x[m], wc); if (m != 7 && m != 15) wc = cmul(wc, w1); }
}
template <bool INV> __device__ __forceinline__ void fft_pass64(LAS f32x2* a, int tid) {
#pragma unroll 1
    for (int k = 0; k < 2; ++k) {
        const int u = tid + 512 * k, j = u & 63;
        LAS f32x2* p = a + (u >> 6) * 1088 + j;
        f32x2 x[16];
#pragma unroll
        for (int q = 0; q < 16; ++q) x[q] = p[68 * q];
        if (!INV) { dft16<false>(x); apply_twid<false>(x, (float)j * (1.0f / 1024.0f)); }
        else { apply_twid<true>(x, (float)j * (1.0f / 1024.0f)); dft16<true>(x); }
#pragma unroll
        for (int q = 0; q < 16; ++q) p[68 * q] = x[q];
    }
}
__device__ __forceinline__ void fft_p1_z(const f32x2* Z, LAS f32x2* a, int tid) {
#pragma unroll 1
    for (int k = 0; k < 2; ++k) {
        const int j = tid + 512 * k;
        LAS f32x2* p = a + j + ((j >> 6) << 2);
        f32x2 x[16];
#pragma unroll
        for (int q = 0; q < 8; ++q) x[q] = Z[j + 1024 * q];
#pragma unroll
        for (int q = 8; q < 16; ++q) x[q] = (f32x2){0.f, 0.f};
        dft16<false>(x); apply_twid<false>(x, (float)j * (1.0f / 16384.0f));
#pragma unroll
        for (int m = 0; m < 16; ++m) p[1088 * m] = x[m];
    }
}
__device__ __forceinline__ void fft_p1_filt(const float* hf, const float* hb, LAS f32x2* a, int tid) {
#pragma unroll 1
    for (int k = 0; k < 2; ++k) {
        const int j = tid + 512 * k;
        LAS f32x2* p = a + j + ((j >> 6) << 2);
        f32x2 x[16];
#pragma unroll
        for (int q = 0; q < 8; ++q) x[q] = (f32x2){hf[j + 1024 * q], 0.f};
#pragma unroll
        for (int q = 8; q < 16; ++q) { const int idx = 2 * SEQ - j - 1024 * q; x[q] = (f32x2){(idx < SEQ) ? hb[idx] : 0.f, 0.f}; }
        dft16<false>(x); apply_twid<false>(x, (float)j * (1.0f / 16384.0f));
#pragma unroll
        for (int m = 0; m < 16; ++m) p[1088 * m] = x[m];
    }
}
__device__ __forceinline__ void fft_last_inv(LAS f32x2* a, f32x2* Z, int tid) {
#pragma unroll 1
    for (int k = 0; k < 2; ++k) {
        const int j = tid + 512 * k;
        const LAS f32x2* p = a + j + ((j >> 6) << 2);
        f32x2 x[16];
#pragma unroll
        for (int m = 0; m < 16; ++m) x[m] = p[1088 * m];
        apply_twid<true>(x, (float)j * (1.0f / 16384.0f)); dft16<true>(x);
#pragma unroll
        for (int q = 0; q < 8; ++q) Z[j + 1024 * q] = x[q];
    }
}
__device__ __forceinline__ float dpp_x2(float v) { return __builtin_bit_cast(float, __builtin_amdgcn_update_dpp(0, __builtin_bit_cast(int, v), 0x4E, 0xF, 0xF, false)); }
__device__ __forceinline__ float dpp_x1(float v) { return __builtin_bit_cast(float, __builtin_amdgcn_update_dpp(0, __builtin_bit_cast(int, v), 0xB1, 0xF, 0xF, false)); }
__device__ __forceinline__ f32x2 quad_fwd(f32x2 z, float s2, float s1, float rc, float rs) {
    f32x2 p; p.x = dpp_x2(z.x) + s2 * z.x; p.y = dpp_x2(z.y) + s2 * z.y;
    f32x2 r; r.x = rc * p.x + rs * p.y; r.y = rc * p.y - rs * p.x;
    f32x2 o; o.x = dpp_x1(r.x) + s1 * r.x; o.y = dpp_x1(r.y) + s1 * r.y;
    return o;
}
__device__ __forceinline__ f32x2 quad_inv(f32x2 o, float s2, float s1, float rc, float rs) {
    f32x2 p; p.x = dpp_x1(o.x) + s1 * o.x; p.y = dpp_x1(o.y) + s1 * o.y;
    f32x2 r; r.x = rc * p.x - rs * p.y; r.y = rc * p.y + rs * p.x;
    f32x2 z; z.x = dpp_x2(r.x) + s2 * r.x; z.y = dpp_x2(r.y) + s2 * r.y;
    return z;
}
__device__ __forceinline__ void fft_mid_filter(LAS f32x2* a, f32x2* Hg  , float skipv, int u) {
    const int j = u & 3;
    const float s2 = (j & 2) ? -1.f : 1.f, s1 = (j & 1) ? -1.f : 1.f, rc = (j == 3) ? 0.f : 1.f, rs = (j == 3) ? 1.f : 0.f;
    const LAS f32x2* p = a + (u >> 2) * 68 + j;
    f32x2 x[16];
#pragma unroll
    for (int q = 0; q < 16; ++q) x[q] = p[4 * q];
    dft16<false>(x); apply_twid<false>(x, (float)j * (1.0f / 64.0f));
#pragma unroll
    for (int m = 0; m < 16; ++m) { f32x2 v = quad_fwd(x[m], s2, s1, rc, rs); v = v * (1.0f / 16384.0f); v.x += skipv * (1.0f / 16384.0f); Hg[512 * m] = v; }
}
__device__ __forceinline__ void fft_mid_z(LAS f32x2* a, const f32x2* Hg, int u) {
    const int j = u & 3;
    const float s2 = (j & 2) ? -1.f : 1.f, s1 = (j & 1) ? -1.f : 1.f, rc = (j == 3) ? 0.f : 1.f, rs = (j == 3) ? 1.f : 0.f;
    LAS f32x2* p = a + (u >> 2) * 68 + j;
    f32x2 x[16], H[16];
#pragma unroll
    for (int m = 0; m < 16; ++m) H[m] = Hg[512 * m];
#pragma unroll
    for (int q = 0; q < 16; ++q) x[q] = p[4 * q];
    dft16<false>(x); apply_twid<false>(x, (float)j * (1.0f / 64.0f));
#pragma unroll
    for (int m = 0; m < 16; ++m) x[m] = quad_inv(cmul(quad_fwd(x[m], s2, s1, rc, rs), H[m]), s2, s1, rc, rs);
    apply_twid<true>(x, (float)j * (1.0f / 64.0f)); dft16<true>(x);
#pragma unroll
    for (int q = 0; q < 16; ++q) p[4 * q] = x[q];
}
constexpr int FFT_LDS_BYTES = (16384 + 1024) * 8;
__device__ __forceinline__ void hy_fftconv(f32x2* ZT, const float* FT, f32x2* HS, const float* skip, LAS unsigned char* lds, int tid0, int blk, int G) {
    LAS f32x2* a = (LAS f32x2*)lds;
#define OPQT() ({ int _t = tid0; asm volatile("" : "+v"(_t)); _t; })
#pragma unroll 1
    for (int ch = blk; ch < D; ch += G) {
        f32x2* z = ZT + (size_t)ch * SEQ;
        { const int tid = OPQT(); fft_p1_filt(FT + (size_t)ch * SEQ, FT + (size_t)(D + ch) * SEQ, a, tid); }
        __syncthreads();
        { const int tid = OPQT(); fft_pass64<false>(a, tid); }
        __syncthreads();
        { const int tid = OPQT(); f32x2* hs = HS + (size_t)blk * 16384 + tid; const float sk = skip[ch]; fft_mid_filter(a, hs, sk, tid); }
        { const int tid = OPQT(); f32x2* hs = HS + (size_t)blk * 16384 + tid; const float sk = skip[ch]; fft_mid_filter(a, hs + 8192, sk, tid + 512); }
        __syncthreads();
        { const int tid = OPQT(); fft_p1_z(z, a, tid); }
        __syncthreads();
        { const int tid = OPQT(); fft_pass64<false>(a, tid); }
        __syncthreads();
        { const int tid = OPQT(); const f32x2* hs = HS + (size_t)blk * 16384 + tid; fft_mid_z(a, hs, tid); }
        { const int tid = OPQT(); const f32x2* hs = HS + (size_t)blk * 16384 + tid; fft_mid_z(a, hs + 8192, tid + 512); }
        __syncthreads();
        { const int tid = OPQT(); fft_pass64<true>(a, tid); }
        __syncthreads();
        { const int tid = OPQT(); fft_last_inv(a, z, tid); }
        __syncthreads();
    }
#undef OPQT
}


#ifndef PROBE_KIND
#define PROBE_KIND 0
#endif
#define PH_BEGIN(kind) const unsigned long long _t0 = (PROBE_KIND == (kind)) ? __builtin_amdgcn_s_memrealtime() : 0ull
#define PH_END(kind) do { if (PROBE_KIND == (kind)) { __syncthreads(); const unsigned long long _dt = __builtin_amdgcn_s_memrealtime() - _t0; \
    while (__builtin_amdgcn_s_memrealtime() - _t0 < 2 * _dt) __builtin_amdgcn_s_sleep(8); } } while (0)
struct Args { const float* in[23]; float* out; unsigned char* ws; int ph_lo, ph_hi, li, pad; };

__global__ void __launch_bounds__(512, 2) mega_fwd(Args args) {
    extern __shared__ __attribute__((aligned(16))) unsigned char lds_raw[];
    LAS unsigned char* lds = (LAS unsigned char*)lds_raw;
    volatile LAS unsigned* MISC = (volatile LAS unsigned*)(lds + MISC_OFF);
    for (int u = threadIdx.x; u < (LDS_BYTES - LDSCTL_OFF) / 4; u += 512) ((LAS unsigned*)(lds + LDSCTL_OFF))[u] = 0u;
    __syncthreads();
    XcdBarrier bar; bar.bar = (unsigned*)(args.ws + WS_CTL) + CW_BAR + args.li * XCD_BAR_WORDS; bar.x = 0; bar.st = nullptr;
#if !MK_PER_PHASE
    bar = xcd_barrier_post((unsigned*)(args.ws + WS_CTL) + CW_BAR + args.li * XCD_BAR_WORDS, MISC + 8);
#endif
    const int lo = args.ph_lo, hi = args.ph_hi;
    int pc = 0;
#define RUN() (pc >= lo && pc < hi)
#if MK_PER_PHASE
#define SEAM() do { ++pc; } while (0)
#else
#define SEAM() do { ++pc; if (pc > lo && pc < hi) xcd_barrier(bar); } while (0)
#endif
#define COORDS() const int tid = opq_tid(), lane = tid & 63, wave = __builtin_amdgcn_readfirstlane(tid >> 6); const int G = opq_s((int)gridDim.x), blk = opq_s((int)blockIdx.x); \
                 const int gw = blk * 8 + wave, NGW = G * 8; unsigned char* ws = arg_ws(); (void)lane; (void)gw; (void)NGW; (void)ws
#define SCR() ((LAS float*)(lds + wave * 16384))

    if (RUN()) { COORDS(); PH_BEGIN(9); phase_p0(arg_in(1), arg_in(2), arg_in(3), (float*)(ws + WS_ADA), arg_in(13), arg_in(14), arg_in(15), arg_in(16), (float*)(ws + WS_HDN), arg_in(17), (float*)(ws + WS_WOT), lds, tid, blk, G);  PH_END(9); }
    SEAM();

#pragma unroll 1
    for (int layer = 0; layer < DEPTH; ++layer) {
        const int jl = layer >> 1;
        if ((layer & 1) == 0) {
            if (RUN()) { COORDS(); PH_BEGIN(5); const unsigned long long _t1 = (PROBE_KIND == 10) ? __builtin_amdgcn_s_memrealtime() : 0ull;
                convert_weights(arg_in(5) + (size_t)jl * D * 5 * D, D, 5 * D, (u16*)(ws + WS_WIN), arg_in(8) + (size_t)jl * D * D, D, D, (u16*)(ws + WS_WOUT),
                                arg_in(20) + (size_t)layer * D * FF, D, FF, (u16*)(ws + WS_W1), arg_in(21) + (size_t)layer * FF * D, FF, D, (u16*)(ws + WS_W2), SCR(), gw, NGW, lane);
                if (PROBE_KIND == 10) { __syncthreads(); const unsigned long long _dt = __builtin_amdgcn_s_memrealtime() - _t1; while (__builtin_amdgcn_s_memrealtime() - _t1 < 2 * _dt) __builtin_amdgcn_s_sleep(8); }
                norm_rows(layer == 0 ? arg_in(0) : arg_out(), arg_in(4) + (size_t)(layer * 2 + 0) * D, (const float*)(ws + WS_ADA) + (size_t)(layer * 2 + 0) * 2 * 3 * D, (u16*)(ws + WS_HN), gw, NGW, lane);
             PH_END(5); }
            SEAM();
            if (RUN()) { COORDS(); PH_BEGIN(1);
                pg8::Gemm g{(const u16*)(ws + WS_HN), (const u16*)(ws + WS_WIN), M, 5 * D, D}; pg8::StaticOrder S; S.init(M, 5 * D, G, blk);
                pg8::EpiHgIn E{(u16*)(ws + WS_Q), (u16*)(ws + WS_V), (u16*)(ws + WS_GT), (u16*)(ws + WS_GF), (u16*)(ws + WS_GB), arg_in(6), jl};
                pg8::gemm_phase<pg8::EpiHgIn, pg8::StaticOrder, true, true>(lds, g, S, E);
             PH_END(1); }
            SEAM();
            if (RUN()) { COORDS(); PH_BEGIN(2); hg_scan1((const u16*)(ws + WS_GF), (const u16*)(ws + WS_GB), (const u16*)(ws + WS_V), (u16*)(ws + WS_S), tid, blk, G);  PH_END(2); }
            SEAM();
            if (RUN()) { COORDS(); PH_BEGIN(3); hg_out((const u16*)(ws + WS_Q), (const u16*)(ws + WS_V), (const u16*)(ws + WS_GT), (const u16*)(ws + WS_GF), (const u16*)(ws + WS_GB), (const u16*)(ws + WS_S),
                              arg_in(7) + (size_t)jl * DV, (u16*)(ws + WS_HN), lds, tid, blk, G);  PH_END(3); }
            SEAM();
        } else {
            if (RUN()) { COORDS(); PH_BEGIN(5); const unsigned long long _t1 = (PROBE_KIND == 10) ? __builtin_amdgcn_s_memrealtime() : 0ull;
                convert_weights(arg_in(9) + (size_t)jl * D * 3 * D, D, 3 * D, (u16*)(ws + WS_WIN), arg_in(19) + (size_t)jl * D * D, D, D, (u16*)(ws + WS_WOUT),
                                arg_in(20) + (size_t)layer * D * FF, D, FF, (u16*)(ws + WS_W1), arg_in(21) + (size_t)layer * FF * D, FF, D, (u16*)(ws + WS_W2), SCR(), gw, NGW, lane);
                if (PROBE_KIND == 10) { __syncthreads(); const unsigned long long _dt = __builtin_amdgcn_s_memrealtime() - _t1; while (__builtin_amdgcn_s_memrealtime() - _t1 < 2 * _dt) __builtin_amdgcn_s_sleep(8); }
                norm_rows(arg_out(), arg_in(4) + (size_t)(layer * 2 + 0) * D, (const float*)(ws + WS_ADA) + (size_t)(layer * 2 + 0) * 2 * 3 * D, (u16*)(ws + WS_HN), gw, NGW, lane);
                const unsigned long long _t2 = (PROBE_KIND == 11) ? __builtin_amdgcn_s_memrealtime() : 0ull;
                filter_gen((const float*)(ws + WS_HDN) + (size_t)jl * SEQ * FW, (const float*)(ws + WS_WOT) + (size_t)jl * 2 * D * FW, (float*)(ws + WS_FT), tid, blk, G);
                if (PROBE_KIND == 11) { __syncthreads(); const unsigned long long _dt = __builtin_amdgcn_s_memrealtime() - _t2; while (__builtin_amdgcn_s_memrealtime() - _t2 < 2 * _dt) __builtin_amdgcn_s_sleep(8); }
             PH_END(5); }
            SEAM();
            if (RUN()) { COORDS(); PH_BEGIN(1);
                pg8::Gemm g{(const u16*)(ws + WS_HN), (const u16*)(ws + WS_WIN), M, 3 * D, D}; pg8::StaticOrder S; S.init(M, 3 * D, G, blk);
                pg8::EpiBias E{(u16*)(ws + WS_U), 3 * D, arg_in(10) + (size_t)jl * 3 * D};
                pg8::gemm_phase<pg8::EpiBias, pg8::StaticOrder, true, true>(lds, g, S, E);
             PH_END(1); }
            SEAM();
            if (RUN()) { COORDS(); PH_BEGIN(6); hy_zprep((const u16*)(ws + WS_U), arg_in(11) + (size_t)jl * 3 * 3 * D, arg_in(12) + (size_t)jl * 3 * D, (f32x2*)(ws + WS_ZT), lds, tid, blk, G);  PH_END(6); }
            SEAM();
            if (RUN()) { COORDS(); PH_BEGIN(4); hy_fftconv((f32x2*)(ws + WS_ZT), (const float*)(ws + WS_FT), (f32x2*)(ws + WS_HS), arg_in(18) + (size_t)jl * D, lds, tid, blk, G);  PH_END(4); }
            SEAM();
            if (RUN()) { COORDS(); PH_BEGIN(6); hy_gate((const u16*)(ws + WS_U), arg_in(11) + (size_t)jl * 3 * 3 * D, arg_in(12) + (size_t)jl * 3 * D, (const f32x2*)(ws + WS_ZT), (u16*)(ws + WS_HN), lds, tid, blk, G);  PH_END(6); }
            SEAM();
        }
        if (RUN()) { COORDS(); PH_BEGIN(7);
            pg8::Gemm g{(const u16*)(ws + WS_HN), (const u16*)(ws + WS_WOUT), M, D, D}; pg8::StaticOrder S; S.init(M, D, G, blk);
            pg8::EpiResid E{layer == 0 ? arg_in(0) : arg_out(), arg_out(), (const float*)(ws + WS_ADA) + (size_t)(layer * 2 + 0) * 2 * 3 * D + 2 * D};
            pg8::gemm_phase<pg8::EpiResid, pg8::StaticOrder, true, true>(lds, g, S, E);
         PH_END(7); }
        SEAM();
        if (RUN()) { COORDS(); PH_BEGIN(5); norm_rows(arg_out(), arg_in(4) + (size_t)(layer * 2 + 1) * D, (const float*)(ws + WS_ADA) + (size_t)(layer * 2 + 1) * 2 * 3 * D, (u16*)(ws + WS_HN), gw, NGW, lane);  PH_END(5); }
        SEAM();
        if (RUN()) { COORDS(); PH_BEGIN(8);
            pg8::Gemm g{(const u16*)(ws + WS_HN), (const u16*)(ws + WS_W1), M, FF, D}; pg8::StaticOrder S; S.init(M, FF, G, blk);
            pg8::EpiRelu2 E{(u16*)(ws + WS_H), FF};
            pg8::gemm_phase<pg8::EpiRelu2, pg8::StaticOrder, true, true>(lds, g, S, E);
         PH_END(8); }
        SEAM();
        if (RUN()) { COORDS(); PH_BEGIN(7);
            pg8::Gemm g{(const u16*)(ws + WS_H), (const u16*)(ws + WS_W2), M, D, FF}; pg8::StaticOrder S; S.init(M, D, G, blk);
            pg8::EpiResid E{arg_out(), arg_out(), (const float*)(ws + WS_ADA) + (size_t)(layer * 2 + 1) * 2 * 3 * D + 2 * D};
            pg8::gemm_phase<pg8::EpiResid, pg8::StaticOrder, true, true>(lds, g, S, E);
         PH_END(7); }
        SEAM();
    }
    if (RUN()) { COORDS(); PH_BEGIN(5); final_norm_rows(arg_out(), arg_in(22), gw, NGW, lane);  PH_END(5); }
#undef RUN
#undef SEAM
#undef COORDS
#undef SCR
}

constexpr int N_PHASES = 1 + 2 * 8 + 2 * 9 + 1;

extern "C" void kernel_launch(void* const* d_in, const int* in_sizes, int n_in, void* d_out, int out_size, void* d_ws, size_t ws_size, hipStream_t stream) {
    static int grid = 0;
    if (grid == 0) {
        if (n_in != 23 || in_sizes[0] != M * D || out_size != M * D || ws_size < WS_END) {
            fprintf(stderr, "kernel_launch: unexpected problem: n_in %d in0 %d out %d ws %zu (need %zu)\n", n_in, n_in > 0 ? in_sizes[0] : -1, out_size, ws_size, (size_t)WS_END); grid = -1; return; }
        int dev = 0, cus = 0;
        if (hipGetDevice(&dev) != hipSuccess || hipDeviceGetAttribute(&cus, hipDeviceAttributeMultiprocessorCount, dev) != hipSuccess) { grid = -1; return; }
        if (hipFuncSetAttribute((const void*)mega_fwd, hipFuncAttributeMaxDynamicSharedMemorySize, LDS_BYTES) != hipSuccess) { fprintf(stderr, "kernel_launch: hipFuncSetAttribute failed\n"); grid = -1; return; }
        int per_cu = 0;
        if (hipOccupancyMaxActiveBlocksPerMultiprocessor(&per_cu, (const void*)mega_fwd, 512, LDS_BYTES) != hipSuccess || per_cu < 1)
            fprintf(stderr, "kernel_launch: occupancy query reports %d per CU\n", per_cu);
        (void)hipGetLastError();
        grid = cus;
    }
    if (grid < 0) return;
    if (hipMemsetAsync((char*)d_ws + WS_CTL, 0, CTL_ZERO_BYTES, stream) != hipSuccess) { fprintf(stderr, "kernel_launch: memset failed\n"); return; }
    Args a{};
    for (int i = 0; i < 23; ++i) a.in[i] = (const float*)d_in[i];
    a.out = (float*)d_out; a.ws = (unsigned char*)d_ws;
#if MK_PER_PHASE
    for (int p = 0; p < N_PHASES; ++p) { a.ph_lo = p; a.ph_hi = p + 1; a.li = 0; hipLaunchKernelGGL(mega_fwd, dim3(grid), dim3(512), LDS_BYTES, stream, a); }
#else
    a.ph_lo = 0; a.ph_hi = N_PHASES; a.li = 0;
    hipLaunchKernelGGL(mega_fwd, dim3(grid), dim3(512), LDS_BYTES, stream, a);
#endif
    const hipError_t le = hipPeekAtLastError();
    if (le != hipSuccess) fprintf(stderr, "kernel_launch: launch failed: %s\n", hipGetErrorName(le));
}
```

```cpp
#include <hip/hip_runtime.h>
#include <cstdio>
#include <cstdint>

#ifndef MK_PER_PHASE
#define MK_PER_PHASE 0
#endif

#define GAS __attribute__((address_space(1)))
#define LAS __attribute__((address_space(3)))
typedef unsigned short u16;
typedef float f32x4 __attribute__((ext_vector_type(4)));
typedef float f32x2 __attribute__((ext_vector_type(2)));
typedef short bf16x8 __attribute__((ext_vector_type(8)));
typedef unsigned u32x4 __attribute__((ext_vector_type(4)));
typedef unsigned u32x2 __attribute__((ext_vector_type(2)));
typedef _Float16 h16x2 __attribute__((ext_vector_type(2)));

constexpr int D = 1024, NB = 2, SEQ = 8192, M = NB * SEQ, DEPTH = 4, NH = 8, DK = 128, DV = 128, CH = 64, NCH = SEQ / CH, FF = 4096;
constexpr int FW = 64, EMB = 33;
constexpr float NORM_EPS = 1e-6f;
constexpr float HY_MAX_DECAY = -15.350567286626973f;
constexpr float HY_MIN_DECAY = -3.0701134573253946f;

constexpr size_t MiB = 1u << 20;
constexpr size_t WS_CTL = 0, CTL_ZERO_BYTES = 1 * MiB;
constexpr size_t WS_ADA = 1 * MiB;
constexpr size_t WS_HDN = 2 * MiB;
constexpr size_t WS_WOT = 6 * MiB;
constexpr size_t WS_W = 8 * MiB;
constexpr size_t WS_WIN = WS_W, WS_WOUT = WS_W + 10 * MiB, WS_W1 = WS_W + 12 * MiB, WS_W2 = WS_W + 20 * MiB;
constexpr size_t WS_HN = 36 * MiB;
constexpr size_t WS_Q = 68 * MiB, WS_V = 100 * MiB, WS_GT = 132 * MiB, WS_GF = 164 * MiB, WS_GB = 196 * MiB, WS_S = 228 * MiB;
constexpr size_t WS_H = 228 * MiB;
constexpr size_t WS_U = 68 * MiB;
constexpr size_t WS_ZT = 164 * MiB;
constexpr size_t WS_FT = 228 * MiB;
constexpr size_t WS_HS = 292 * MiB;
constexpr size_t WS_END = 356 * MiB;
constexpr int CW_BAR = 4096;

constexpr int RING_BYTES = 131072;
constexpr int LDSCTL_OFF = (16384 + 1024) * 8  , MISC_OFF = LDSCTL_OFF + 320;
constexpr int LDS_BYTES = 147456;

__device__ __forceinline__ unsigned f2bf(float f) { unsigned u = __builtin_bit_cast(unsigned, f); return (u + 0x7fffu + ((u >> 16) & 1u)) >> 16; }
__device__ __forceinline__ unsigned pk2(float lo, float hi) { return f2bf(lo) | (f2bf(hi) << 16); }
__device__ __forceinline__ float bf2f(unsigned b) { return __builtin_bit_cast(float, b << 16); }
__device__ __forceinline__ unsigned pkh2(float lo, float hi) { h16x2 v; v.x = (_Float16)lo; v.y = (_Float16)hi; return __builtin_bit_cast(unsigned, v); }
__device__ __forceinline__ float h2f(unsigned short b) { return (float)__builtin_bit_cast(_Float16, b); }
__device__ __forceinline__ float sin_rev(float r) { return __builtin_amdgcn_sinf(r); }
__device__ __forceinline__ float cos_rev(float r) { return __builtin_amdgcn_cosf(r); }
__device__ __forceinline__ float fast_sin(float x) { float r = x * 0.15915494309189535f; r = r - floorf(r); return sin_rev(r); }
__device__ __forceinline__ float sigmoidf_(float x) { return 1.0f / (1.0f + __expf(-x)); }
__device__ __forceinline__ float siluf_(float x) { return x / (1.0f + __expf(-x)); }
__device__ __forceinline__ float wave_sum(float v) {
#pragma unroll
    for (int o = 1; o < 64; o <<= 1) v += __shfl_xor(v, o);
    return v;
}
#define LDS_WAIT() asm volatile("s_waitcnt lgkmcnt(0)" ::: "memory")

#define CAS __attribute__((address_space(4)))
__device__ __forceinline__ int opq_tid() { int t = threadIdx.x; asm volatile("" : "+v"(t)); return t; }
__device__ __forceinline__ int opq_s(int x) { asm volatile("" : "+s"(x)); return x; }
__device__ __forceinline__ const float* arg_in(int i) { const CAS char* p = (const CAS char*)__builtin_amdgcn_kernarg_segment_ptr(); asm volatile("" : "+s"(p)); return *(const float* const CAS*)(p + 8 * i); }
__device__ __forceinline__ float* arg_out() { const CAS char* p = (const CAS char*)__builtin_amdgcn_kernarg_segment_ptr(); asm volatile("" : "+s"(p)); return *(float* const CAS*)(p + 8 * 23); }
__device__ __forceinline__ unsigned char* arg_ws() { const CAS char* p = (const CAS char*)__builtin_amdgcn_kernarg_segment_ptr(); asm volatile("" : "+s"(p)); return *(unsigned char* const CAS*)(p + 8 * 24); }

namespace pg8 {
#define PG8_LAS __attribute__((address_space(3)))
typedef unsigned short bf16_t;
constexpr int BM = 256, BK = 64, HALF = 128, HTB = HALF * BK * 2, STAGE_BYTES = 8 * HTB, NXCD = 8, WGM = 8;
__host__ __device__ __forceinline__ int lds_byte(int r, int c) { const int st = (r >> 4) * 2 + (c >> 5), rr = r & 15, cc = c & 31, ob = rr * 64 + cc * 2; return st * 1024 + (ob ^ (((ob >> 9) & 1) << 5)); }
__host__ __device__ __forceinline__ void stage_rc(int b, int& R, int& C) { const int st = b / 1024, sb = b % 1024, swz = sb ^ (((sb >> 9) & 1) << 5); R = (st >> 1) * 16 + swz / 64; C = (st & 1) * 32 + (swz % 64) / 2; }
__host__ __device__ __forceinline__ int perm32(int rho) { const int n = rho >> 4, i = rho & 15; return 8 * (i >> 2) + 4 * n + (i & 3); }
struct Unit { int pm, pn; };
struct Gemm { const bf16_t* A; const bf16_t* Bt; int M, N, K; };
struct StaticOrder {
    int nM, nN, nwg, G, c;
    __host__ __device__ void init(int M_, int N_, int G_, int c_) { nM = M_ / BM; nN = N_ / BM; nwg = nM * nN; G = G_; c = c_; }
    __host__ __device__ bool next(int i, Unit& u) const {
        const long L = (long)i * G + c; if (L >= nwg) return false;
        int wgid = (int)L; { const int q = nwg / NXCD, r = nwg % NXCD, xcd = wgid % NXCD, off = wgid / NXCD; wgid = (xcd < r ? xcd * (q + 1) : r * (q + 1) + (xcd - r) * q) + off; }
        const int nig = WGM * nN, gid = wgid / nig, fm = gid * WGM, gsz = (nM - fm) < WGM ? (nM - fm) : WGM;
        u.pm = fm + ((wgid % nig) % gsz); u.pn = (wgid % nig) / gsz; return true;
    }
    __device__ __forceinline__ void a_ready(const Unit&) const {}
    __device__ __forceinline__ void done(const Unit&) const {}
};
__device__ __forceinline__ unsigned cvt_pk_bf16(float lo, float hi) { unsigned r; asm volatile("v_cvt_pk_bf16_f32 %0, %1, %2" : "=v"(r) : "v"(lo), "v"(hi)); return r; }

template <class Epi, class Sched, bool ALIGN_EPI = false, bool SP2 = false>
__device__ __forceinline__ void gemm_phase(PG8_LAS unsigned char* lds, const Gemm g, const Sched& S, const Epi& E) {
    const int tid = opq_tid(), wid = __builtin_amdgcn_readfirstlane(tid >> 6), lane = tid & 63, wr = wid >> 2, wc = wid & 3, fr = lane & 15, fq = lane >> 4;
    const int K = g.K, nt = K / BK;
    unsigned voffA[2], voffB[2];
#pragma unroll
    for (int i = 0; i < 2; ++i) { int R, C; stage_rc(tid * 16 + i * 8192, R, C); const int Rb = Epi::PERM ? ((R & ~31) + perm32(R & 31)) : R;
        voffA[i] = (unsigned)(R * K + C) * 2u; voffB[i] = (unsigned)(Rb * K + C) * 2u; }
    const size_t kstep = (size_t)(BK * 2);
    const size_t hstep = (size_t)HALF * K * 2;
    const size_t tstep = 2 * hstep;
    const unsigned ldsw = (unsigned)wid * 1024u;
    const int aoff = lds_byte(wr * 64 + fr, fq * 8), boff = lds_byte(wc * 32 + fr, fq * 8);
#define PG8_SA(b, h) (((b) * 2 + (h)) * HTB)
#define PG8_SB(b, h) ((4 + (b) * 2 + (h)) * HTB)
#define PG8_STAGE(bufoff, gbase, voff) do { _Pragma("unroll") for (int _i = 0; _i < 2; ++_i) \
        __builtin_amdgcn_global_load_lds((const unsigned*)((const char*)(gbase) + (voff)[_i]), (PG8_LAS unsigned*)(lds + (bufoff) + ldsw + _i * 8192), 16, 0, 0); } while (0)
#define PG8_LDA(dst, b, h) do { _Pragma("unroll") for (int m = 0; m < 4; ++m) _Pragma("unroll") for (int k = 0; k < 2; ++k) dst[m][k] = *(const PG8_LAS bf16x8*)(lds + PG8_SA(b, h) + aoff + m * 2048 + k * 1024); } while (0)
#define PG8_LDB(dst, b, h) do { _Pragma("unroll") for (int n = 0; n < 2; ++n) _Pragma("unroll") for (int k = 0; k < 2; ++k) dst[n][k] = *(const PG8_LAS bf16x8*)(lds + PG8_SB(b, h) + boff + n * 2048 + k * 1024); } while (0)
#define PG8_MMA(ai, bj, At, Bt) do { __builtin_amdgcn_s_setprio(1); _Pragma("unroll") for (int m = 0; m < 4; ++m) _Pragma("unroll") for (int n = 0; n < 2; ++n) _Pragma("unroll") for (int k = 0; k < 2; ++k) \
        acc[ai][bj][m][n] = __builtin_amdgcn_mfma_f32_16x16x32_bf16(Bt[n][k], At[m][k], acc[ai][bj][m][n], 0, 0, 0); __builtin_amdgcn_s_setprio(0); } while (0)
#define PG8_WAIT_V(n) asm volatile("s_waitcnt vmcnt(" #n ")" ::: "memory")
#define PG8_WAIT_L(n) asm volatile("s_waitcnt lgkmcnt(" #n ")" ::: "memory")
#define PG8_BAR __builtin_amdgcn_s_barrier()
#define PG8_SCHED __builtin_amdgcn_sched_barrier(0)
    Unit cur, nxt; int ui = 0;
    if (!S.next(0, cur)) return;
    f32x4 acc[2][2][4][2];
#pragma unroll
    for (int a = 0; a < 2; ++a)
#pragma unroll
        for (int b = 0; b < 2; ++b)
#pragma unroll
            for (int m = 0; m < 4; ++m)
#pragma unroll
                for (int n = 0; n < 2; ++n) acc[a][b][m][n] = (f32x4){0.f, 0.f, 0.f, 0.f};
    bf16x8 At[4][2], B0[2][2], B1[2][2];
    const char* cA = (const char*)g.A + (size_t)cur.pm * tstep; const char* cB = (const char*)g.Bt + (size_t)cur.pn * tstep;
    S.a_ready(cur);
    if constexpr (SP2) {
        PG8_STAGE(PG8_SB(0, 0), cB, voffB); PG8_STAGE(PG8_SB(0, 1), cB + hstep, voffB); PG8_STAGE(PG8_SA(0, 0), cA, voffA); PG8_STAGE(PG8_SA(0, 1), cA + hstep, voffA);
        if (wr == 1) PG8_BAR;
        PG8_WAIT_V(2); PG8_BAR;
        PG8_STAGE(PG8_SB(1, 0), cB + kstep, voffB); PG8_STAGE(PG8_SA(1, 0), cA + kstep, voffA); PG8_STAGE(PG8_SB(1, 1), cB + hstep + kstep, voffB);
        PG8_WAIT_V(6); PG8_BAR;
    } else {
        PG8_STAGE(PG8_SB(0, 0), cB, voffB); PG8_STAGE(PG8_SA(0, 0), cA, voffA); PG8_STAGE(PG8_SB(0, 1), cB + hstep, voffB); PG8_STAGE(PG8_SA(0, 1), cA + hstep, voffA);
        if (wr == 1) PG8_BAR;
        PG8_WAIT_V(4); PG8_BAR;
        PG8_STAGE(PG8_SB(1, 0), cB + kstep, voffB); PG8_STAGE(PG8_SA(1, 0), cA + kstep, voffA); PG8_STAGE(PG8_SB(1, 1), cB + hstep + kstep, voffB);
        PG8_WAIT_V(6); PG8_BAR;
    }
    for (;;) {
        const bool has_next = S.next(ui + 1, nxt);
        const char* nA = has_next ? (const char*)g.A + (size_t)nxt.pm * tstep : cA; const char* nB = has_next ? (const char*)g.Bt + (size_t)nxt.pn * tstep : cB;
        for (int t = 0; t < nt; t += 2) {
            const bool last = (t == nt - 2);
            const char* a1 = cA + (size_t)(t + 1) * kstep;
            const char* a2 = last ? nA : cA + (size_t)(t + 2) * kstep; const char* b2 = last ? nB : cB + (size_t)(t + 2) * kstep;
            const char* a3 = a2 + kstep; const char* b3 = b2 + kstep;
            if (last && has_next) S.a_ready(nxt);
            if constexpr (SP2) {
            PG8_LDB(B0, 0, 0); PG8_LDB(B1, 0, 1); PG8_SCHED; PG8_LDA(At, 0, 0); PG8_STAGE(PG8_SA(1, 1), a1 + hstep, voffA);
            PG8_WAIT_V(8); PG8_WAIT_L(0); PG8_BAR; PG8_MMA(0, 0, At, B0); PG8_MMA(0, 1, At, B1); PG8_BAR; PG8_SCHED;
            PG8_LDA(At, 0, 1); PG8_STAGE(PG8_SB(0, 0), b2, voffB); PG8_STAGE(PG8_SB(0, 1), b2 + hstep, voffB); PG8_STAGE(PG8_SA(0, 0), a2, voffA);
            PG8_WAIT_V(8); PG8_WAIT_L(0); PG8_BAR; PG8_MMA(1, 0, At, B0); PG8_MMA(1, 1, At, B1); PG8_BAR; PG8_SCHED;
            PG8_LDB(B0, 1, 0); PG8_LDB(B1, 1, 1); PG8_SCHED; PG8_LDA(At, 1, 0); PG8_STAGE(PG8_SA(0, 1), a2 + hstep, voffA);
            PG8_WAIT_V(8); PG8_WAIT_L(0); PG8_BAR; PG8_MMA(0, 0, At, B0); PG8_MMA(0, 1, At, B1); PG8_BAR; PG8_SCHED;
            PG8_LDA(At, 1, 1); PG8_STAGE(PG8_SB(1, 0), b3, voffB); PG8_STAGE(PG8_SB(1, 1), b3 + hstep, voffB); PG8_STAGE(PG8_SA(1, 0), a3, voffA);
            PG8_WAIT_V(8); PG8_WAIT_L(0); PG8_BAR; PG8_MMA(1, 0, At, B0); PG8_MMA(1, 1, At, B1); PG8_BAR; PG8_SCHED;
            } else {
            PG8_LDB(B0, 0, 0); PG8_SCHED; PG8_LDA(At, 0, 0); PG8_STAGE(PG8_SA(1, 1), a1 + hstep, voffA);
            PG8_WAIT_L(8); PG8_BAR; PG8_WAIT_L(0); PG8_MMA(0, 0, At, B0); PG8_BAR; PG8_SCHED;
            PG8_LDB(B1, 0, 1); PG8_STAGE(PG8_SB(0, 0), b2, voffB);
            PG8_BAR; PG8_WAIT_L(0); PG8_MMA(0, 1, At, B1); PG8_BAR;
            PG8_LDA(At, 0, 1); PG8_STAGE(PG8_SA(0, 0), a2, voffA);
            PG8_BAR; PG8_WAIT_L(0); PG8_MMA(1, 0, At, B0); PG8_BAR; PG8_SCHED;
            PG8_STAGE(PG8_SB(0, 1), b2 + hstep, voffB);
            PG8_WAIT_V(6); PG8_BAR; PG8_MMA(1, 1, At, B1); PG8_BAR;
            PG8_LDB(B0, 1, 0); PG8_SCHED; PG8_LDA(At, 1, 0); PG8_STAGE(PG8_SA(0, 1), a2 + hstep, voffA);
            PG8_WAIT_L(8); PG8_BAR; PG8_WAIT_L(0); PG8_MMA(0, 0, At, B0); PG8_BAR; PG8_SCHED;
            PG8_LDB(B1, 1, 1); PG8_STAGE(PG8_SB(1, 0), b3, voffB);
            PG8_BAR; PG8_WAIT_L(0); PG8_MMA(0, 1, At, B1); PG8_BAR;
            PG8_LDA(At, 1, 1); PG8_STAGE(PG8_SA(1, 0), a3, voffA);
            PG8_BAR; PG8_WAIT_L(0); PG8_MMA(1, 0, At, B0); PG8_BAR; PG8_SCHED;
            PG8_STAGE(PG8_SB(1, 1), b3 + hstep, voffB);
            PG8_WAIT_V(6); PG8_BAR; PG8_MMA(1, 1, At, B1); PG8_BAR;
            }
        }
        if constexpr (ALIGN_EPI) { if (wr == 0) PG8_BAR; }
        E(acc, cur, wr, wc, fr, fq); S.done(cur);
        if (!has_next) break;
#pragma unroll
        for (int a = 0; a < 2; ++a)
#pragma unroll
            for (int b = 0; b < 2; ++b)
#pragma unroll
                for (int m = 0; m < 4; ++m)
#pragma unroll
                    for (int n = 0; n < 2; ++n) acc[a][b][m][n] = (f32x4){0.f, 0.f, 0.f, 0.f};
        cur = nxt; cA = nA; cB = nB; ++ui;
        if constexpr (ALIGN_EPI) { if (wr == 1) PG8_BAR; }
    }
    PG8_WAIT_V(0);
    if constexpr (!ALIGN_EPI) { if (wr == 0) PG8_BAR; }
    PG8_BAR;
#undef PG8_SA
#undef PG8_SB
#undef PG8_STAGE
#undef PG8_LDA
#undef PG8_LDB
#undef PG8_MMA
#undef PG8_WAIT_V
#undef PG8_WAIT_L
#undef PG8_BAR
#undef PG8_SCHED
}

struct EpiResid {
    static constexpr bool PERM = false, AFTER_DRAIN = false;
    const float* xin; float* xout; const float* gate;
    __device__ __forceinline__ void operator()(const f32x4 (&acc)[2][2][4][2], const Unit& u, int wr, int wc, int fr, int fq) const {
        const int row0 = u.pm * BM + wr * 64 + fr, col0 = u.pn * BM + wc * 32 + 4 * fq;
        const float* gp = gate + (u.pm >= (SEQ / BM) ? 3 * D : 0);
        f32x4 gv[2][2];
#pragma unroll
        for (int bj = 0; bj < 2; ++bj)
#pragma unroll
            for (int n = 0; n < 2; ++n) gv[bj][n] = *(const f32x4*)(gp + col0 + bj * HALF + n * 16);
#pragma unroll
        for (int ai = 0; ai < 2; ++ai)
#pragma unroll
            for (int m = 0; m < 4; ++m) { const size_t off = (size_t)(row0 + ai * HALF + m * 16) * D + col0;
#pragma unroll
                for (int bj = 0; bj < 2; ++bj)
#pragma unroll
                    for (int n = 0; n < 2; ++n) { const f32x4 xi = *(const f32x4*)(xin + off + bj * HALF + n * 16);
                        *(f32x4*)(xout + off + bj * HALF + n * 16) = xi + gv[bj][n] * acc[ai][bj][m][n]; } }
    }
};
struct EpiRelu2 {
    static constexpr bool PERM = true, AFTER_DRAIN = false;
    bf16_t* O; int ldc;
    __device__ __forceinline__ void operator()(const f32x4 (&acc)[2][2][4][2], const Unit& u, int wr, int wc, int fr, int fq) const {
        const int row0 = u.pm * BM + wr * 64 + fr, col0 = u.pn * BM + wc * 32 + 8 * fq;
#pragma unroll
        for (int ai = 0; ai < 2; ++ai)
#pragma unroll
            for (int m = 0; m < 4; ++m) { bf16_t* rowp = O + (size_t)(row0 + ai * HALF + m * 16) * ldc + col0;
#pragma unroll
                for (int bj = 0; bj < 2; ++bj) { f32x4 v0 = acc[ai][bj][m][0], v1 = acc[ai][bj][m][1];
#pragma unroll
                    for (int j = 0; j < 4; ++j) { const float a = fmaxf(v0[j], 0.f), b = fmaxf(v1[j], 0.f); v0[j] = a * a; v1[j] = b * b; }
                    u32x4 w; w.x = cvt_pk_bf16(v0[0], v0[1]); w.y = cvt_pk_bf16(v0[2], v0[3]); w.z = cvt_pk_bf16(v1[0], v1[1]); w.w = cvt_pk_bf16(v1[2], v1[3]);
                    *(u32x4*)(rowp + bj * HALF) = w; } }
    }
};
struct EpiBias {
    static constexpr bool PERM = true, AFTER_DRAIN = false;
    bf16_t* O; int ldc; const float* bias;
    __device__ __forceinline__ void operator()(const f32x4 (&acc)[2][2][4][2], const Unit& u, int wr, int wc, int fr, int fq) const {
        const int row0 = u.pm * BM + wr * 64 + fr, col0 = u.pn * BM + wc * 32 + 8 * fq;
        f32x4 bv[2][2];
#pragma unroll
        for (int bj = 0; bj < 2; ++bj)
#pragma unroll
            for (int n = 0; n < 2; ++n) bv[bj][n] = *(const f32x4*)(bias + col0 + bj * HALF + 4 * n);
#pragma unroll
        for (int ai = 0; ai < 2; ++ai)
#pragma unroll
            for (int m = 0; m < 4; ++m) { bf16_t* rowp = O + (size_t)(row0 + ai * HALF + m * 16) * ldc + col0;
#pragma unroll
                for (int bj = 0; bj < 2; ++bj) { const f32x4 v0 = acc[ai][bj][m][0] + bv[bj][0], v1 = acc[ai][bj][m][1] + bv[bj][1];
                    u32x4 w; w.x = cvt_pk_bf16(v0[0], v0[1]); w.y = cvt_pk_bf16(v0[2], v0[3]); w.z = cvt_pk_bf16(v1[0], v1[1]); w.w = cvt_pk_bf16(v1[2], v1[3]);
                    *(u32x4*)(rowp + bj * HALF) = w; } }
    }
};
struct EpiRowBias {
    static constexpr bool PERM = true, AFTER_DRAIN = false;
    bf16_t* O; int ldc; const float* bias;
    __device__ __forceinline__ void operator()(const f32x4 (&acc)[2][2][4][2], const Unit& u, int wr, int wc, int fr, int fq) const {
        const int row0 = u.pm * BM + wr * 64 + fr, col0 = u.pn * BM + wc * 32 + 8 * fq;
#pragma unroll
        for (int ai = 0; ai < 2; ++ai)
#pragma unroll
            for (int m = 0; m < 4; ++m) { const int row = row0 + ai * HALF + m * 16; const float bb = bias[row]; bf16_t* rowp = O + (size_t)row * ldc + col0;
#pragma unroll
                for (int bj = 0; bj < 2; ++bj) { const f32x4 v0 = acc[ai][bj][m][0] + bb, v1 = acc[ai][bj][m][1] + bb;
                    u32x4 w; w.x = cvt_pk_bf16(v0[0], v0[1]); w.y = cvt_pk_bf16(v0[2], v0[3]); w.z = cvt_pk_bf16(v1[0], v1[1]); w.w = cvt_pk_bf16(v1[2], v1[3]);
                    *(u32x4*)(rowp + bj * HALF) = w; } }
    }
};
struct EpiHgIn {
    static constexpr bool PERM = true, AFTER_DRAIN = false;
    bf16_t *Q, *V, *GT, *GF, *GB; const float* lbraw; int jl;
    __device__ __forceinline__ void operator()(const f32x4 (&acc)[2][2][4][2], const Unit& u, int wr, int wc, int fr, int fq) const {
        const int sec = u.pn >> 2;
        const int row0 = u.pm * BM + wr * 64 + fr, col0 = (u.pn & 3) * BM + wc * 32 + 8 * fq;
        bf16_t* base = sec == 0 ? Q : sec == 1 ? V : sec == 2 ? GF : sec == 3 ? GB : GT;
        float lb[2][8];
#pragma unroll
        for (int bj = 0; bj < 2; ++bj)
#pragma unroll
            for (int j = 0; j < 8; ++j) lb[bj][j] = 0.f;
        if ((sec == 2 || sec == 3) && jl == 1) {
            const float* r0 = lbraw + (size_t)(sec - 2) * 2 * D;
#pragma unroll
            for (int bj = 0; bj < 2; ++bj)
#pragma unroll
                for (int j = 0; j < 8; ++j) { const int c = col0 + bj * HALF + j; const float a0 = r0[c], a1 = r0[D + c]; lb[bj][j] = 1.0f / (1.0f + __expf(a0 - a1));   }
        }
#pragma unroll
        for (int ai = 0; ai < 2; ++ai)
#pragma unroll
            for (int m = 0; m < 4; ++m) { bf16_t* rowp = base + (size_t)(row0 + ai * HALF + m * 16) * D + col0;
#pragma unroll
                for (int bj = 0; bj < 2; ++bj) { float v[8];
#pragma unroll
                    for (int j = 0; j < 4; ++j) { v[j] = acc[ai][bj][m][0][j]; v[4 + j] = acc[ai][bj][m][1][j]; }
                    u32x4 w;
                    if (sec == 0 || sec == 4) {
#pragma unroll
                        for (int j = 0; j < 8; ++j) v[j] = siluf_(v[j]);
                        w.x = cvt_pk_bf16(v[0], v[1]); w.y = cvt_pk_bf16(v[2], v[3]); w.z = cvt_pk_bf16(v[4], v[5]); w.w = cvt_pk_bf16(v[6], v[7]);
                    } else if (sec == 1) {
                        w.x = cvt_pk_bf16(v[0], v[1]); w.y = cvt_pk_bf16(v[2], v[3]); w.z = cvt_pk_bf16(v[4], v[5]); w.w = cvt_pk_bf16(v[6], v[7]);
                    } else {
#pragma unroll
                        for (int j = 0; j < 8; ++j) { const float l = lb[bj][j]; const float f = l + (1.0f - l) * sigmoidf_(v[j]); v[j] = fmaxf(__logf(f), -100.0f); }
                        w.x = pkh2(v[0], v[1]); w.y = pkh2(v[2], v[3]); w.z = pkh2(v[4], v[5]); w.w = pkh2(v[6], v[7]);
                    }
                    *(u32x4*)(rowp + bj * HALF) = w; } }
    }
};
}

#define XB_TMO      128
#define XB_XCNT(j)  (256  + 64 * (j))
#define XB_XSUB(j)  (1280 + 64 * (j))
#define XB_XGEN(j)  (2304 + 64 * (j))
#define XB_TOP      3328
#define XB_TOPGEN   3392
#define XCD_BAR_WORDS 3456
#define XB_SPIN_CAP (1u << 18)
__device__ __forceinline__ unsigned xb_ld(unsigned* p)              { return __hip_atomic_load(p, __ATOMIC_RELAXED, __HIP_MEMORY_SCOPE_AGENT); }
__device__ __forceinline__ unsigned xb_add(unsigned* p, unsigned v) { return __hip_atomic_fetch_add(p, v, __ATOMIC_RELAXED, __HIP_MEMORY_SCOPE_AGENT); }
__device__ __forceinline__ unsigned xb_xcc_id() { return (unsigned)__builtin_amdgcn_s_getreg((3 << 11) | 20) & 0xFu; }
#define XB_SPIN(cond, bar) do { unsigned _sp = 0; while (cond) { __builtin_amdgcn_s_sleep(1); \
    if ((++_sp & 255u) == 0u) { if (xb_ld(&(bar)[XB_TMO])) break; if (_sp > XB_SPIN_CAP) { atomicAdd(&(bar)[XB_TMO], 1u); break; } } } } while (0)
struct XcdBarrier { unsigned* bar; unsigned x; volatile LAS unsigned* st; };
__device__ __forceinline__ XcdBarrier xcd_barrier_post(unsigned* bar, volatile LAS unsigned* st) {
    XcdBarrier b; b.bar = bar; b.x = xb_xcc_id(); b.st = st;
    if (threadIdx.x == 0) (void)xb_add(&bar[XB_XCNT(b.x)], 1u);
    return b;
}
__device__ __forceinline__ void xcd_barrier_complete(unsigned* bar, unsigned x, unsigned& nloc, unsigned& nx) {
    const unsigned G = gridDim.x * gridDim.y * gridDim.z;
    unsigned sum, cnt, mine, sp = 0u;
    for (;;) {
        sum = 0u; cnt = 0u; mine = 0u;
#pragma unroll
        for (unsigned j = 0; j < 16; ++j) { const unsigned c = xb_ld(&bar[XB_XCNT(j)]); sum += c; cnt += (c > 0u) ? 1u : 0u; mine = (j == x) ? c : mine; }
        if (sum == G) break;
        __builtin_amdgcn_s_sleep(1);
        if ((++sp & 255u) == 0u) { if (xb_ld(&bar[XB_TMO])) break; if (sp > XB_SPIN_CAP) { atomicAdd(&bar[XB_TMO], 1u); break; } }
    }
    nloc = mine > 0u ? mine : 1u; nx = cnt > 0u ? cnt : 1u;
}
__device__ __forceinline__ void xcd_barrier(const XcdBarrier& b) {
    asm volatile("s_waitcnt vmcnt(0)" ::: "memory");
    __syncthreads();
    if (threadIdx.x == 0) {
        unsigned* bar = b.bar;
        __builtin_amdgcn_s_waitcnt(0);
        unsigned nloc = b.st[0], nx = b.st[1];
        if (nloc == 0u) { xcd_barrier_complete(bar, b.x, nloc, nx); b.st[0] = nloc; b.st[1] = nx; }
        const unsigned old = xb_add(&bar[XB_XSUB(b.x)], 1u);
        const unsigned gen = old / nloc;
        if (old + 1u == (gen + 1u) * nloc) {
            __builtin_amdgcn_fence(__ATOMIC_RELEASE, "agent");
            asm volatile("s_waitcnt vmcnt(0)" ::: "memory");
            const unsigned og = xb_add(&bar[XB_TOP], 1u);
            const unsigned tg = og / nx;
            if (og + 1u == (tg + 1u) * nx) xb_add(&bar[XB_TOPGEN], 1u);
            else XB_SPIN(xb_ld(&bar[XB_TOPGEN]) == tg, bar);
            __builtin_amdgcn_fence(__ATOMIC_ACQUIRE, "agent");
            xb_add(&bar[XB_XGEN(b.x)], 1u);
            asm volatile("s_waitcnt vmcnt(0)" ::: "memory");
        } else {
            XB_SPIN(xb_ld(&bar[XB_XGEN(b.x)]) == gen, bar);
            __builtin_amdgcn_fence(__ATOMIC_ACQUIRE, "agent");
            asm volatile("s_waitcnt vmcnt(0)" ::: "memory");
        }
    }
    __syncthreads();
}

__device__ __forceinline__ void transpose_item(const float* W, int K, int N, u16* WT, LAS float* scr, int item, int lane) {
    const int nblk = N / 32, kb = item / nblk, nb = item % nblk, k0 = 64 * kb, n0 = 32 * nb;
#pragma unroll 8
    for (int i = 0; i < 32; ++i) { const int kk = 2 * i + (lane >> 5); scr[kk * 33 + (lane & 31)] = W[(size_t)(k0 + kk) * N + n0 + (lane & 31)]; }
    LDS_WAIT(); asm volatile("" ::: "memory");
    const int c = lane & 7;
#pragma unroll
    for (int j = 0; j < 4; ++j) { const int n = (lane >> 3) + 8 * j; const LAS float* s = scr + (8 * c) * 33 + n;
        u32x4 o; o.x = pk2(s[0 * 33], s[1 * 33]); o.y = pk2(s[2 * 33], s[3 * 33]); o.z = pk2(s[4 * 33], s[5 * 33]); o.w = pk2(s[6 * 33], s[7 * 33]);
        *(u32x4*)(WT + (size_t)(n0 + n) * K + k0 + 8 * c) = o; }
    LDS_WAIT(); asm volatile("" ::: "memory");
}
__device__ __forceinline__ void convert_weights(const float* w0, int K0, int N0, u16* o0, const float* w1, int K1, int N1, u16* o1, const float* w2, int K2, int N2, u16* o2,
                                                const float* w3, int K3, int N3, u16* o3, LAS float* scr, int gw, int NGW, int lane) {
    const int I0 = (K0 / 64) * (N0 / 32), I1 = (K1 / 64) * (N1 / 32), I2 = (K2 / 64) * (N2 / 32), I3 = (K3 / 64) * (N3 / 32);
    for (int it = gw; it < I0 + I1 + I2 + I3; it += NGW) {
        int r = it;
        if (r < I0) { transpose_item(w0, K0, N0, o0, scr, r, lane); continue; } r -= I0;
        if (r < I1) { transpose_item(w1, K1, N1, o1, scr, r, lane); continue; } r -= I1;
        if (r < I2) { transpose_item(w2, K2, N2, o2, scr, r, lane); continue; } r -= I2;
        transpose_item(w3, K3, N3, o3, scr, r, lane);
    }
}
__device__ __forceinline__ void norm_rows(const float* x, const float* g, const float* ada, u16* hn, int gw, int NGW, int lane) {
    for (int m = gw; m < M; m += NGW) {
        const int b = m >> 13;
        const f32x4* xr = (const f32x4*)(x + (size_t)m * D) + lane;
        f32x4 v[4]; float s = 0.f;
#pragma unroll
        for (int j = 0; j < 4; ++j) { v[j] = xr[64 * j]; s += (v[j].x * v[j].x + v[j].y * v[j].y) + (v[j].z * v[j].z + v[j].w * v[j].w); }
        const float r = 1.0f / sqrtf(wave_sum(s) * (1.0f / D) + NORM_EPS);
        u32x2* o8 = (u32x2*)(hn + (size_t)m * D) + lane;
#pragma unroll
        for (int j = 0; j < 4; ++j) { const int c = 4 * (lane + 64 * j);
            const f32x4 gg = *(const f32x4*)(g + c), sh = *(const f32x4*)(ada + b * 3 * D + c), sc = *(const f32x4*)(ada + b * 3 * D + D + c);
            const f32x4 y = v[j] * r * gg * (sc + 1.0f) + sh;
            u32x2 w; w.x = pk2(y.x, y.y); w.y = pk2(y.z, y.w); o8[64 * j] = w; }
    }
}
__device__ __forceinline__ void final_norm_rows(float* x, const float* g, int gw, int NGW, int lane) {
    for (int m = gw; m < M; m += NGW) {
        f32x4* xr = (f32x4*)(x + (size_t)m * D) + lane;
        f32x4 v[4]; float s = 0.f;
#pragma unroll
        for (int j = 0; j < 4; ++j) { v[j] = xr[64 * j]; s += (v[j].x * v[j].x + v[j].y * v[j].y) + (v[j].z * v[j].z + v[j].w * v[j].w); }
        const float r = 1.0f / sqrtf(wave_sum(s) * (1.0f / D) + NORM_EPS);
#pragma unroll
        for (int j = 0; j < 4; ++j) { const f32x4 gg = *(const f32x4*)(g + 4 * (lane + 64 * j)); xr[64 * j] = v[j] * r * gg; }
    }
}

__device__ __forceinline__ void phase_p0(const float* cin, const float* ada_w, const float* ada_b, float* ADA,
                                         const float* fwin, const float* fwmid, const float* fb, const float* ffreq, float* HDN, const float* fwout, float* WOT,
                                         LAS unsigned char* lds, int tid, int blk, int G) {
    for (int i = blk * 512 + tid; i < 2 * 2 * D * FW; i += G * 512) { const int w = i & 63, col = (i >> 6) & (2 * D - 1), j = i >> 17; WOT[i] = fwout[(size_t)(j * FW + w) * 2 * D + col]; }
    LAS float* sc = (LAS float*)lds;
    LAS float* red = sc + 2048;
    for (int i = tid; i < 2 * D; i += 512) sc[i] = siluf_(cin[i]);
    __syncthreads();
    {
        const int cl = tid & 31, ks = tid >> 5;
        for (int gidx = blk; gidx < 8 * 96; gidx += G) {
            const int mat = gidx / 96, col0 = (gidx % 96) * 32;
            const float* w = ada_w + (size_t)mat * D * 3 * D + col0 + cl;
            float a0 = 0.f, a1 = 0.f;
#pragma unroll 8
            for (int k = ks * 64; k < ks * 64 + 64; ++k) { const float wv = w[(size_t)k * 3 * D]; a0 += sc[k] * wv; a1 += sc[D + k] * wv; }
            red[(ks * 2 + 0) * 32 + cl] = a0; red[(ks * 2 + 1) * 32 + cl] = a1;
            __syncthreads();
            if (tid < 64) { const int b = tid >> 5; float s = ada_b[mat * 3 * D + col0 + cl];
                for (int k2 = 0; k2 < 16; ++k2) s += red[(k2 * 2 + b) * 32 + cl];
                ADA[(size_t)(mat * 2 + b) * 3 * D + col0 + cl] = s; }
            __syncthreads();
        }
    }
    {
        LAS float* emb = (LAS float*)lds + 4096;
        LAS float* hA = emb + 8 * 36;
        LAS float* hB = hA + 512;
        for (int it = blk; it < 2 * (SEQ / 8); it += G) {
            const int j = it / (SEQ / 8), t0 = (it % (SEQ / 8)) * 8;
            if (tid < 8 * EMB) { const int tl = tid / EMB, e = tid % EMB, t = t0 + tl; float val;
                if (e == 0) val = (float)t / (float)(SEQ - 1);
                else { const int bi = (e - 1) & 15; const float band = 1e-4f + (float)bi * ((15.0f - 1e-4f) / 15.0f);
                    float rv = (float)t * band * (1.0f / SEQ); rv = rv - floorf(rv); val = (e <= 16) ? cos_rev(rv) : -sin_rev(rv); }
                emb[tl * 36 + e] = val; }
            __syncthreads();
            const int tl = tid >> 6, w = tid & 63;
            const float fq_ = ffreq[j * FW + w];
            float a = fb[(j * 3 + 0) * FW + w];
            for (int e = 0; e < EMB; ++e) a += emb[tl * 36 + e] * fwin[(size_t)(j * EMB + e) * FW + w];
            hA[tl * 64 + w] = fast_sin(fq_ * a);
            __syncthreads();
            a = fb[(j * 3 + 1) * FW + w];
            for (int v = 0; v < FW; ++v) a += hA[tl * 64 + v] * fwmid[(size_t)((j * 2 + 0) * FW + v) * FW + w];
            hB[tl * 64 + w] = fast_sin(fq_ * a);
            __syncthreads();
            a = fb[(j * 3 + 2) * FW + w];
            for (int v = 0; v < FW; ++v) a += hB[tl * 64 + v] * fwmid[(size_t)((j * 2 + 1) * FW + v) * FW + w];
            HDN[((size_t)j * FW + w) * SEQ + t0 + tl] = fast_sin(fq_ * a);
            __syncthreads();
        }
    }
}
__device__ __forceinline__ void filter_gen(const float* HDNj  , const float* WOTj  , float* FT, int tid, int blk, int G) {
    for (int it = blk; it < 64 * 16; it += G) {
        const int cb = it >> 4, tb = it & 15, t = tb * 512 + tid;
        float hv[64]; int wl[32];
#pragma unroll
        for (int c = 0; c < 32; ++c) wl[c] = __builtin_bit_cast(int, WOTj[(size_t)(cb * 32 + c) * FW + (tid & 63)]);
#pragma unroll
        for (int i = 0; i < 64; ++i) hv[i] = HDNj[(size_t)i * SEQ + t];
        const float tn = (float)t / (float)(SEQ - 1);
#pragma unroll
        for (int c = 0; c < 32; ++c) {
            const int col = cb * 32 + c, ch = col & (D - 1);
            float a = 0.f;
#pragma unroll
            for (int i = 0; i < 64; ++i) a += hv[i] * __builtin_bit_cast(float, __builtin_amdgcn_readlane(wl[c], i));
            const float delta = fabsf(HY_MIN_DECAY + (float)ch * ((HY_MAX_DECAY - HY_MIN_DECAY) / (float)(D - 1)));
            FT[(size_t)col * SEQ + t] = a * __expf(-tn * delta);
        }
    }
}

constexpr int S1_PV = 272, S1_PG = 48;
constexpr int S1_VL = 0, S1_GL = 2 * 64 * S1_PV, S1_KA = S1_GL + 2 * 64 * S1_PG, S1_SEG = S1_KA + 2 * 64 * 16, S1_ET = S1_SEG + 8 * 16 * 4, S1_END = S1_ET + 64;
typedef unsigned short u16x4v __attribute__((ext_vector_type(4)));
__device__ __forceinline__ void hg_scan1(const u16* GF, const u16* GB, const u16* V, u16* Sbuf, LAS unsigned char* lds, int tid, int blk, int G) {
    const int lane = tid & 63, wv = __builtin_amdgcn_readfirstlane(tid >> 6);
    const int q4 = lane >> 4, r16 = lane & 15;
    LAS float* SEGS = (LAS float*)(lds + S1_SEG); LAS float* ET = (LAS float*)(lds + S1_ET);
    for (int wi = blk; wi < 256; wi += G) {
        const int n = wi >> 6, h = (wi >> 3) & 7, ds = wi & 7, dir = n >> 1, b = n & 1;
        const int vrow = tid >> 3, vch = (tid & 7) * 2, grow = (tid >> 1) & 63, gch = tid & 1;
        const u16* Vg = V + ((size_t)b * SEQ + vrow) * D + h * DV + vch * 8;
        const u16* Gg = (dir ? GB : GF) + ((size_t)b * SEQ + grow) * D + h * DK + ds * 16 + gch * 8;
        u16* Sp = Sbuf + (size_t)(n * NH + h) * NCH * (DV * DK) + (size_t)(wv * 16 + r16) * DK + ds * 16 + 4 * q4;
        const unsigned vl_w = S1_VL + vrow * S1_PV + vch * 16, gl_w = S1_GL + grow * S1_PG + gch * 16;
        const int tp = tid >> 4, dkp = tid & 15;
        const unsigned gl_r = S1_GL + (2 * tp) * S1_PG + dkp * 2;
        const int t0 = 2 * tp, ka_w = S1_KA + (((t0 >> 5) * 64 + ((t0 & 31) >> 3) * 16 + dkp) * 8 + (t0 & 7)) * 2;
        const unsigned tr_a = S1_VL + (8 * q4 + (r16 >> 2)) * S1_PV + (16 * wv + 4 * (r16 & 3)) * 2;
        f32x4 S = (f32x4){0.f, 0.f, 0.f, 0.f};
        u32x4 sv0, sv1, sg;
        { const size_t co = (size_t)(dir ? (NCH - 1) : 0) * CH * D;
          sv0 = *(const u32x4*)(Vg + co); sv1 = *(const u32x4*)(Vg + co + 8); sg = *(const u32x4*)(Gg + co);
          *(LAS u32x4*)(lds + vl_w) = sv0; *(LAS u32x4*)(lds + vl_w + 16) = sv1; if (tid < 128) *(LAS u32x4*)(lds + gl_w) = sg;
          const size_t c1 = (size_t)(dir ? (NCH - 2) : 1) * CH * D;
          sv0 = *(const u32x4*)(Vg + c1); sv1 = *(const u32x4*)(Vg + c1 + 8); sg = *(const u32x4*)(Gg + c1); }
        __syncthreads();
#pragma unroll 1
        for (int step = 0; step < NCH; ++step) {
            const int c = dir ? (NCH - 1 - step) : step, p = step & 1;
            const float g0 = h2f(*(const LAS u16*)(lds + gl_r + p * (64 * S1_PG))), g1 = h2f(*(const LAS u16*)(lds + gl_r + p * (64 * S1_PG) + S1_PG));
            const float ps = g0 + g1;
            const float p0 = __shfl(ps, r16), p1 = __shfl(ps, r16 + 16), p2 = __shfl(ps, r16 + 32), p3 = __shfl(ps, r16 + 48);
            if (q4 == 0) SEGS[wv * 16 + dkp] = (p0 + p1) + (p2 + p3);
            float w0, w1;
            if (dir == 0) { const float aft = (q4 < 1 ? p1 : 0.f) + (q4 < 2 ? p2 : 0.f) + (q4 < 3 ? p3 : 0.f); w1 = aft; w0 = aft + g1; }
            else          { const float bef = (q4 > 0 ? p0 : 0.f) + (q4 > 1 ? p1 : 0.f) + (q4 > 2 ? p2 : 0.f); w0 = bef; w1 = bef + g0; }
            __syncthreads();
            if (step + 1 < NCH) { const unsigned po = (p ^ 1);
                *(LAS u32x4*)(lds + vl_w + po * (64 * S1_PV)) = sv0; *(LAS u32x4*)(lds + vl_w + po * (64 * S1_PV) + 16) = sv1; if (tid < 128) *(LAS u32x4*)(lds + gl_w + po * (64 * S1_PG)) = sg; }
            if (step + 2 < NCH) { const size_t c2 = (size_t)(dir ? (c - 2) : (c + 2)) * CH * D;
                sv0 = *(const u32x4*)(Vg + c2); sv1 = *(const u32x4*)(Vg + c2 + 8); sg = *(const u32x4*)(Gg + c2); }
            { float tot = 0.f, off = 0.f;
#pragma unroll
              for (int s2 = 0; s2 < 8; ++s2) { const float sg2 = SEGS[s2 * 16 + dkp]; tot += sg2; off += (dir ? (s2 < wv) : (s2 > wv)) ? sg2 : 0.f; }
              const float k0 = (1.0f - __expf(g0)) * __expf(w0 + off), k1 = (1.0f - __expf(g1)) * __expf(w1 + off);
              *(LAS unsigned*)(lds + ka_w) = pk2(k0, k1);
              if (tid < 16) ET[dkp] = __expf(tot); }
            __syncthreads();
            { u32x2 w; w.x = pk2(S[0], S[1]); w.y = pk2(S[2], S[3]); *(u32x2*)(Sp + (size_t)c * (DV * DK)) = w; }
            const bf16x8 fa0 = *(const LAS bf16x8*)(lds + S1_KA + lane * 16), fa1 = *(const LAS bf16x8*)(lds + S1_KA + 1024 + lane * 16);
            const f32x4 et = *(const LAS f32x4*)(ET + 4 * q4);
            u16x4v r0, r1, r2, r3;
            asm volatile("ds_read_b64_tr_b16 %0, %4\n\tds_read_b64_tr_b16 %1, %4 offset:1088\n\tds_read_b64_tr_b16 %2, %4 offset:8704\n\tds_read_b64_tr_b16 %3, %4 offset:9792\n\ts_waitcnt lgkmcnt(0)"
                         : "=&v"(r0), "=&v"(r1), "=&v"(r2), "=&v"(r3) : "v"(tr_a + p * (64 * S1_PV)) : "memory");
            bf16x8 fb0, fb1;
#pragma unroll
            for (int j = 0; j < 4; ++j) { fb0[j] = (short)r0[j]; fb0[4 + j] = (short)r1[j]; fb1[j] = (short)r2[j]; fb1[4 + j] = (short)r3[j]; }
            S = S * et;
            S = __builtin_amdgcn_mfma_f32_16x16x32_bf16(fa0, fb0, S, 0, 0, 0);
            S = __builtin_amdgcn_mfma_f32_16x16x32_bf16(fa1, fb1, S, 0, 0, 0);
        }
        __syncthreads();
    }
}

constexpr int HO_LD = 136;
constexpr int HO_LV = 72;
constexpr int HO_QF = 0, HO_KF = 64 * HO_LD * 2, HO_QB = 2 * HO_KF, HO_KB = 3 * HO_KF, HO_VT = 4 * HO_KF, HO_AT = HO_VT + 128 * HO_LV * 2, HO_SEG = HO_AT + 64 * HO_LV * 2, HO_SSQ = HO_SEG + 2 * 4 * 128 * 4, HO_END = HO_SSQ + 64 * 8 * 4;
static_assert(HO_END <= RING_BYTES, "hg_out LDS");
__device__ __forceinline__ void hg_out(const u16* Qb, const u16* Vb, const u16* GTb, const u16* GF, const u16* GB, const u16* Sbuf, const float* hgn  , u16* ON,
                                       LAS unsigned char* lds, int tid, int blk, int G) {
    const int lane = tid & 63, wv = __builtin_amdgcn_readfirstlane(tid >> 6), q4 = lane >> 4, r16 = lane & 15;
    LAS u16* QF = (LAS u16*)(lds + HO_QF); LAS u16* KF = (LAS u16*)(lds + HO_KF); LAS u16* QBt = (LAS u16*)(lds + HO_QB); LAS u16* KBt = (LAS u16*)(lds + HO_KB);
    LAS u16* VT = (LAS u16*)(lds + HO_VT); LAS u16* AT = (LAS u16*)(lds + HO_AT); LAS float* SEG = (LAS float*)(lds + HO_SEG); LAS float* SSQ = (LAS float*)(lds + HO_SSQ);
    for (int it = blk; it < NB * NH * NCH; it += G) {
        const int b = it / (NH * NCH), h = (it / NCH) % NH, c = it % NCH;
        const size_t m0 = (size_t)b * SEQ + (size_t)c * CH;
        {
            const int d = tid & 127, ts = tid >> 7;
            const size_t gofs = (m0 + 16 * ts) * D + h * DK + d;
            float gf[16], gb[16], qv[16];
#pragma unroll
            for (int j = 0; j < 16; ++j) { gf[j] = h2f(GF[gofs + (size_t)j * D]); gb[j] = h2f(GB[gofs + (size_t)j * D]); qv[j] = bf2f(Qb[gofs + (size_t)j * D]); }
            { unsigned vv[16];
#pragma unroll
              for (int j = 0; j < 16; ++j) vv[j] = Vb[gofs + (size_t)j * D];
              u32x4 w0, w1; w0.x = vv[0] | (vv[1] << 16); w0.y = vv[2] | (vv[3] << 16); w0.z = vv[4] | (vv[5] << 16); w0.w = vv[6] | (vv[7] << 16);
              w1.x = vv[8] | (vv[9] << 16); w1.y = vv[10] | (vv[11] << 16); w1.z = vv[12] | (vv[13] << 16); w1.w = vv[14] | (vv[15] << 16);
              *(LAS u32x4*)(VT + d * HO_LV + 16 * ts) = w0; *(LAS u32x4*)(VT + d * HO_LV + 16 * ts + 8) = w1; }
            float pf[16], sb[16];
            { float r = 0.f;
#pragma unroll
              for (int j = 0; j < 16; ++j) { r += gf[j]; pf[j] = r; }
              SEG[(0 * 4 + ts) * 128 + d] = r; r = 0.f;
#pragma unroll
              for (int j = 15; j >= 0; --j) { r += gb[j]; sb[j] = r; }
              SEG[(1 * 4 + ts) * 128 + d] = r; }
            __syncthreads();
            float offf = 0.f, offb = 0.f;
#pragma unroll
            for (int s2 = 0; s2 < 4; ++s2) { const float a = SEG[(0 * 4 + s2) * 128 + d], bb = SEG[(1 * 4 + s2) * 128 + d]; offf += (s2 < ts) ? a : 0.f; offb += (s2 > ts) ? bb : 0.f; }
#pragma unroll
            for (int j = 0; j < 16; ++j) {
                const float bf_ = offf + pf[j], bb_ = offb + sb[j];
                const float kf = 1.0f - __expf(gf[j]), kb = 1.0f - __expf(gb[j]);
                const int o = (16 * ts + j) * HO_LD + d;
                QF[o] = (u16)f2bf(qv[j] * __expf(bf_)); KF[o] = (u16)f2bf(kf * __expf(fminf(-bf_, 80.f)));
                QBt[o] = (u16)f2bf(qv[j] * __expf(bb_)); KBt[o] = (u16)f2bf(kb * __expf(fminf(-bb_, 80.f)));
            }
        }
        __syncthreads();
#pragma unroll 1
        for (int tt = 0; tt < 2; ++tt) {
            const int tile = 2 * wv + tt, ti = tile >> 2, si = tile & 3;
            f32x4 af = (f32x4){0.f, 0.f, 0.f, 0.f}, ab = (f32x4){0.f, 0.f, 0.f, 0.f};
            if (ti >= si) {
#pragma unroll
                for (int kk = 0; kk < 4; ++kk) { const bf16x8 a = *(const LAS bf16x8*)(QF + (16 * ti + r16) * HO_LD + 32 * kk + 8 * q4), bb = *(const LAS bf16x8*)(KF + (16 * si + r16) * HO_LD + 32 * kk + 8 * q4);
                    af = __builtin_amdgcn_mfma_f32_16x16x32_bf16(a, bb, af, 0, 0, 0); }
            }
            if (ti <= si) {
#pragma unroll
                for (int kk = 0; kk < 4; ++kk) { const bf16x8 a = *(const LAS bf16x8*)(QBt + (16 * ti + r16) * HO_LD + 32 * kk + 8 * q4), bb = *(const LAS bf16x8*)(KBt + (16 * si + r16) * HO_LD + 32 * kk + 8 * q4);
                    ab = __builtin_amdgcn_mfma_f32_16x16x32_bf16(a, bb, ab, 0, 0, 0); }
            }
#pragma unroll
            for (int r = 0; r < 4; ++r) { const int t = 16 * ti + 4 * q4 + r, s = 16 * si + r16;
                const float vsum = (s <= t ? af[r] : 0.f) + (s >= t ? ab[r] : 0.f);
                AT[t * HO_LV + s] = (u16)f2bf(vsum); }
        }
        __syncthreads();
        f32x4 o[4];
#pragma unroll
        for (int ti = 0; ti < 4; ++ti) o[ti] = (f32x4){0.f, 0.f, 0.f, 0.f};
        {
#pragma unroll
            for (int kk = 0; kk < 2; ++kk) { const bf16x8 bv = *(const LAS bf16x8*)(VT + (16 * wv + r16) * HO_LV + 32 * kk + 8 * q4);
#pragma unroll
                for (int ti = 0; ti < 4; ++ti) { const bf16x8 a = *(const LAS bf16x8*)(AT + (16 * ti + r16) * HO_LV + 32 * kk + 8 * q4); o[ti] = __builtin_amdgcn_mfma_f32_16x16x32_bf16(a, bv, o[ti], 0, 0, 0); } }
            const u16* Sf = Sbuf + ((size_t)((0 * 2 + b) * NH + h) * NCH + c) * (DV * DK) + (size_t)(16 * wv + r16) * DK + 8 * q4;
            const u16* Sb = Sbuf + ((size_t)((1 * 2 + b) * NH + h) * NCH + c) * (DV * DK) + (size_t)(16 * wv + r16) * DK + 8 * q4;
#pragma unroll
            for (int kk = 0; kk < 4; ++kk) { const bf16x8 sf = *(const bf16x8*)(Sf + 32 * kk), sbv = *(const bf16x8*)(Sb + 32 * kk);
#pragma unroll
                for (int ti = 0; ti < 4; ++ti) { const bf16x8 a = *(const LAS bf16x8*)(QF + (16 * ti + r16) * HO_LD + 32 * kk + 8 * q4); o[ti] = __builtin_amdgcn_mfma_f32_16x16x32_bf16(a, sf, o[ti], 0, 0, 0);
                    const bf16x8 a2 = *(const LAS bf16x8*)(QBt + (16 * ti + r16) * HO_LD + 32 * kk + 8 * q4); o[ti] = __builtin_amdgcn_mfma_f32_16x16x32_bf16(a2, sbv, o[ti], 0, 0, 0); } }
        }
#pragma unroll
        for (int ti = 0; ti < 4; ++ti)
#pragma unroll
            for (int r = 0; r < 4; ++r) { float s = o[ti][r] * o[ti][r]; s += __shfl_xor(s, 1); s += __shfl_xor(s, 2); s += __shfl_xor(s, 4); s += __shfl_xor(s, 8);
                if (r16 == 0) SSQ[(16 * ti + 4 * q4 + r) * 8 + wv] = s; }
        __syncthreads();
        {
            const int dv = 16 * wv + r16; const float gn = hgn[dv];
#pragma unroll
            for (int ti = 0; ti < 4; ++ti)
#pragma unroll
                for (int r = 0; r < 4; ++r) { const int t = 16 * ti + 4 * q4 + r; const LAS f32x4* sp = (const LAS f32x4*)(SSQ + t * 8); const f32x4 s0 = sp[0], s1 = sp[1];
                    const float ss = (s0.x + s0.y + s0.z + s0.w) + (s1.x + s1.y + s1.z + s1.w);
                    const float rn = 1.0f / sqrtf(ss * (1.0f / DV) + NORM_EPS);
                    const size_t go = (m0 + t) * D + h * DV + dv;
                    ON[go] = (u16)f2bf(o[ti][r] * rn * gn * bf2f(GTb[go])); }
        }
        __syncthreads();
    }
}

__device__ __forceinline__ void hy_zprep(const u16* U, const float* cw  , const float* cbias  , f32x2* ZT, LAS unsigned char* lds, int tid, int blk, int G) {
    LAS float* zt = (LAS float*)lds;
    for (int it = blk; it < (SEQ / 64) * (D / 64); it += G) {
        const int tb = it >> 4, cbk = it & 15, t0 = tb * 64, c0 = cbk * 64;
        const int ch = tid & 63, tq = tid >> 6, c = c0 + ch;
        const float a0 = cw[0 * 3 * D + D + c], a1 = cw[1 * 3 * D + D + c], a2 = cw[2 * 3 * D + D + c], ab = cbias[D + c];
        const float v0 = cw[0 * 3 * D + 2 * D + c], v1 = cw[1 * 3 * D + 2 * D + c], v2 = cw[2 * 3 * D + 2 * D + c], vb = cbias[2 * D + c];
#pragma unroll
        for (int b = 0; b < 2; ++b) {
            float u1[10], uv[10];
#pragma unroll
            for (int i = 0; i < 10; ++i) { const int tt = t0 + tq * 8 - 1 + i; const bool ok = (tt >= 0) && (tt < SEQ);
                const size_t ro = ((size_t)b * SEQ + (ok ? tt : 0)) * (3 * D);
                u1[i] = ok ? bf2f(U[ro + D + c]) : 0.f; uv[i] = ok ? bf2f(U[ro + 2 * D + c]) : 0.f; }
#pragma unroll
            for (int i = 0; i < 8; ++i) { const float x1c = u1[i] * a0 + u1[i + 1] * a1 + u1[i + 2] * a2 + ab, vc = uv[i] * v0 + uv[i + 1] * v1 + uv[i + 2] * v2 + vb;
                zt[(ch * 65 + tq * 8 + i) * 2 + b] = x1c * vc; }
        }
        __syncthreads();
        { const int tt = tid & 63;
#pragma unroll
          for (int r = 0; r < 8; ++r) { const int chh = (tid >> 6) + 8 * r; f32x2 v; v.x = zt[(chh * 65 + tt) * 2]; v.y = zt[(chh * 65 + tt) * 2 + 1]; ZT[(size_t)(c0 + chh) * SEQ + t0 + tt] = v; } }
        __syncthreads();
    }
}
__device__ __forceinline__ void hy_gate(const u16* U, const float* cw, const float* cbias, const f32x2* YT, u16* YG, LAS unsigned char* lds, int tid, int blk, int G) {
    LAS float* zt = (LAS float*)lds;
    for (int it = blk; it < (SEQ / 64) * (D / 64); it += G) {
        const int tb = it >> 4, cbk = it & 15, t0 = tb * 64, c0 = cbk * 64;
        { const int tt = tid & 63;
#pragma unroll
          for (int r = 0; r < 8; ++r) { const int chh = (tid >> 6) + 8 * r; const f32x2 v = YT[(size_t)(c0 + chh) * SEQ + t0 + tt]; zt[(chh * 65 + tt) * 2] = v.x; zt[(chh * 65 + tt) * 2 + 1] = v.y; } }
        __syncthreads();
        const int ch = tid & 63, tq = tid >> 6, c = c0 + ch;
        const float a0 = cw[0 * 3 * D + c], a1 = cw[1 * 3 * D + c], a2 = cw[2 * 3 * D + c], ab = cbias[c];
#pragma unroll
        for (int b = 0; b < 2; ++b) {
            float u0[10];
#pragma unroll
            for (int i = 0; i < 10; ++i) { const int tt = t0 + tq * 8 - 1 + i; const bool ok = (tt >= 0) && (tt < SEQ);
                const size_t ro = ((size_t)b * SEQ + (ok ? tt : 0)) * (3 * D); u0[i] = ok ? bf2f(U[ro + c]) : 0.f; }
#pragma unroll
            for (int i = 0; i < 8; ++i) { const float x0c = u0[i] * a0 + u0[i + 1] * a1 + u0[i + 2] * a2 + ab;
                YG[((size_t)b * SEQ + t0 + tq * 8 + i) * D + c] = (u16)f2bf(x0c * zt[(ch * 65 + tq * 8 + i) * 2 + b]); }
        }
        __syncthreads();
    }
}
__device__ __forceinline__ int fpad(int e) { return e + ((e >> 6) << 2); }
__device__ __forceinline__ f32x2 cmul(f32x2 a, f32x2 b) { f32x2 r; r.x = a.x * b.x - a.y * b.y; r.y = a.x * b.y + a.y * b.x; return r; }
__device__ __forceinline__ f32x2 cmulc(f32x2 a, f32x2 b) { f32x2 r; r.x = a.x * b.x + a.y * b.y; r.y = a.y * b.x - a.x * b.y; return r; }
template <bool INV> __device__ __forceinline__ void radix4(f32x2& a0, f32x2& a1, f32x2& a2, f32x2& a3) {
    const f32x2 t0 = a0 + a2, t1 = a0 - a2, t2 = a1 + a3, t3 = a1 - a3;
    a0 = t0 + t2; a2 = t0 - t2;
    if (!INV) { a1.x = t1.x + t3.y; a1.y = t1.y - t3.x; a3.x = t1.x - t3.y; a3.y = t1.y + t3.x; }
    else      { a1.x = t1.x - t3.y; a1.y = t1.y + t3.x; a3.x = t1.x + t3.y; a3.y = t1.y - t3.x; }
}
template <bool INV> __device__ __forceinline__ void dft16(f32x2 (&x)[16]) {
    constexpr float C1 = 0.92387953251128674f, S1 = 0.38268343236508977f, R2 = 0.70710678118654752f;
#pragma unroll
    for (int b = 0; b < 4; ++b) radix4<INV>(x[b], x[4 + b], x[8 + b], x[12 + b]);
    const f32x2 W1 = {C1, -S1}, W2 = {R2, -R2}, W3 = {S1, -C1}, W4 = {0.f, -1.f}, W6 = {-R2, -R2}, W9 = {-C1, S1};
    if (!INV) { x[5] = cmul(x[5], W1); x[9] = cmul(x[9], W2); x[13] = cmul(x[13], W3); x[6] = cmul(x[6], W2); x[10] = cmul(x[10], W4); x[14] = cmul(x[14], W6); x[7] = cmul(x[7], W3); x[11] = cmul(x[11], W6); x[15] = cmul(x[15], W9); }
    else      { x[5] = cmulc(x[5], W1); x[9] = cmulc(x[9], W2); x[13] = cmulc(x[13], W3); x[6] = cmulc(x[6], W2); x[10] = cmulc(x[10], W4); x[14] = cmulc(x[14], W6); x[7] = cmulc(x[7], W3); x[11] = cmulc(x[11], W6); x[15] = cmulc(x[15], W9); }
#pragma unroll
    for (int c = 0; c < 4; ++c) radix4<INV>(x[4 * c], x[4 * c + 1], x[4 * c + 2], x[4 * c + 3]);
    f32x2 y[16];
#pragma unroll
    for (int c = 0; c < 4; ++c)
#pragma unroll
        for (int d = 0; d < 4; ++d) y[c + 4 * d] = x[4 * c + d];
#pragma unroll
    for (int i = 0; i < 16; ++i) x[i] = y[i];
}
template <bool CONJ> __device__ __forceinline__ void apply_twid(f32x2 (&x)[16], float f) {
    const f32x2 w1 = {cos_rev(f), -sin_rev(f)}, w8 = {cos_rev(8.f * f), -sin_rev(8.f * f)};
    f32x2 wc = w1;
#pragma unroll
    for (int m = 1; m < 16; ++m) { if (m == 8) wc = w8; x[m] = CONJ ? cmulc(x[m], wc) : cmul(x[m], wc); if (m != 7 && m != 15) wc = cmul(wc, w1); }
}
template <bool INV> __device__ __forceinline__ void fft_pass64(LAS f32x2* a, int tid) {
#pragma unroll 1
    for (int k = 0; k < 2; ++k) {
        const int u = tid + 512 * k, j = u & 63;
        LAS f32x2* p = a + (u >> 6) * 1088 + j;
        f32x2 x[16];
#pragma unroll
        for (int q = 0; q < 16; ++q) x[q] = p[68 * q];
        if (!INV) { dft16<false>(x); apply_twid<false>(x, (float)j * (1.0f / 1024.0f)); }
        else { apply_twid<true>(x, (float)j * (1.0f / 1024.0f)); dft16<true>(x); }
#pragma unroll
        for (int q = 0; q < 16; ++q) p[68 * q] = x[q];
    }
}
__device__ __forceinline__ float conv3_at(const u16* urow, int t, const float (&w)[4]) {
    const int tm = (t > 0) ? t - 1 : 0, tp = (t < SEQ - 1) ? t + 1 : SEQ - 1;
    const float um = bf2f(urow[tm]), u0 = bf2f(urow[t]), up = bf2f(urow[tp]);
    return ((t > 0) ? um : 0.f) * w[0] + u0 * w[1] + ((t < SEQ - 1) ? up : 0.f) * w[2] + w[3];
}
__device__ __forceinline__ void fft_p1_z(const u16* u1  , const u16* uv, const float (&w1)[4], const float (&wv)[4], LAS f32x2* a, int tid) {
#pragma unroll 1
    for (int k = 0; k < 2; ++k) {
        const int j = tid + 512 * k;
        LAS f32x2* p = a + j + ((j >> 6) << 2);
        f32x2 x[16];
#pragma unroll
        for (int q = 0; q < 8; ++q) { const int t = j + 1024 * q;
            x[q].x = conv3_at(u1, t, w1) * conv3_at(uv, t, wv); x[q].y = conv3_at(u1 + SEQ, t, w1) * conv3_at(uv + SEQ, t, wv); }
#pragma unroll
        for (int q = 8; q < 16; ++q) x[q] = (f32x2){0.f, 0.f};
        dft16<false>(x); apply_twid<false>(x, (float)j * (1.0f / 16384.0f));
#pragma unroll
        for (int m = 0; m < 16; ++m) p[1088 * m] = x[m];
    }
}
__device__ __forceinline__ void fft_p1_filt(const float* hf, const float* hb, LAS f32x2* a, int tid) {
#pragma unroll 1
    for (int k = 0; k < 2; ++k) {
        const int j = tid + 512 * k;
        LAS f32x2* p = a + j + ((j >> 6) << 2);
        f32x2 x[16];
#pragma unroll
        for (int q = 0; q < 8; ++q) x[q] = (f32x2){hf[j + 1024 * q], 0.f};
#pragma unroll
        for (int q = 8; q < 16; ++q) { const int idx = 2 * SEQ - j - 1024 * q; x[q] = (f32x2){(idx < SEQ) ? hb[idx] : 0.f, 0.f}; }
        dft16<false>(x); apply_twid<false>(x, (float)j * (1.0f / 16384.0f));
#pragma unroll
        for (int m = 0; m < 16; ++m) p[1088 * m] = x[m];
    }
}
__device__ __forceinline__ void fft_last_inv(LAS f32x2* a, const u16* u0, const float (&w0)[4], u16* yg, int tid) {
#pragma unroll 1
    for (int k = 0; k < 2; ++k) {
        const int j = tid + 512 * k;
        const LAS f32x2* p = a + j + ((j >> 6) << 2);
        f32x2 x[16];
#pragma unroll
        for (int m = 0; m < 16; ++m) x[m] = p[1088 * m];
        apply_twid<true>(x, (float)j * (1.0f / 16384.0f)); dft16<true>(x);
#pragma unroll
        for (int q = 0; q < 8; ++q) { const int t = j + 1024 * q;
            yg[t] = (u16)f2bf(x[q].x * conv3_at(u0, t, w0)); yg[SEQ + t] = (u16)f2bf(x[q].y * conv3_at(u0 + SEQ, t, w0)); }
    }
}
__device__ __forceinline__ float dpp_x2(float v) { return __builtin_bit_cast(float, __builtin_amdgcn_update_dpp(0, __builtin_bit_cast(int, v), 0x4E, 0xF, 0xF, false)); }
__device__ __forceinline__ float dpp_x1(float v) { return __builtin_bit_cast(float, __builtin_amdgcn_update_dpp(0, __builtin_bit_cast(int, v), 0xB1, 0xF, 0xF, false)); }
__device__ __forceinline__ f32x2 quad_fwd(f32x2 z, float s2, float s1, float rc, float rs) {
    f32x2 p; p.x = dpp_x2(z.x) + s2 * z.x; p.y = dpp_x2(z.y) + s2 * z.y;
    f32x2 r; r.x = rc * p.x + rs * p.y; r.y = rc * p.y - rs * p.x;
    f32x2 o; o.x = dpp_x1(r.x) + s1 * r.x; o.y = dpp_x1(r.y) + s1 * r.y;
    return o;
}
__device__ __forceinline__ f32x2 quad_inv(f32x2 o, float s2, float s1, float rc, float rs) {
    f32x2 p; p.x = dpp_x1(o.x) + s1 * o.x; p.y = dpp_x1(o.y) + s1 * o.y;
    f32x2 r; r.x = rc * p.x - rs * p.y; r.y = rc * p.y + rs * p.x;
    f32x2 z; z.x = dpp_x2(r.x) + s2 * r.x; z.y = dpp_x2(r.y) + s2 * r.y;
    return z;
}
__device__ __forceinline__ void fft_mid_filter(LAS f32x2* a, f32x2* Hg  , float skipv, int u) {
    const int j = u & 3;
    const float s2 = (j & 2) ? -1.f : 1.f, s1 = (j & 1) ? -1.f : 1.f, rc = (j == 3) ? 0.f : 1.f, rs = (j == 3) ? 1.f : 0.f;
    const LAS f32x2* p = a + (u >> 2) * 68 + j;
    f32x2 x[16];
#pragma unroll
    for (int q = 0; q < 16; ++q) x[q] = p[4 * q];
    dft16<false>(x); apply_twid<false>(x, (float)j * (1.0f / 64.0f));
#pragma unroll
    for (int m = 0; m < 16; ++m) { f32x2 v = quad_fwd(x[m], s2, s1, rc, rs); v = v * (1.0f / 16384.0f); v.x += skipv * (1.0f / 16384.0f); Hg[512 * m] = v; }
}
__device__ __forceinline__ void fft_mid_z(LAS f32x2* a, const f32x2* Hg, int u) {
    const int j = u & 3;
    const float s2 = (j & 2) ? -1.f : 1.f, s1 = (j & 1) ? -1.f : 1.f, rc = (j == 3) ? 0.f : 1.f, rs = (j == 3) ? 1.f : 0.f;
    LAS f32x2* p = a + (u >> 2) * 68 + j;
    f32x2 x[16], H[16];
#pragma unroll
    for (int m = 0; m < 16; ++m) H[m] = Hg[512 * m];
#pragma unroll
    for (int q = 0; q < 16; ++q) x[q] = p[4 * q];
    dft16<false>(x); apply_twid<false>(x, (float)j * (1.0f / 64.0f));
#pragma unroll
    for (int m = 0; m < 16; ++m) x[m] = quad_inv(cmul(quad_fwd(x[m], s2, s1, rc, rs), H[m]), s2, s1, rc, rs);
    apply_twid<true>(x, (float)j * (1.0f / 64.0f)); dft16<true>(x);
#pragma unroll
    for (int q = 0; q < 16; ++q) p[4 * q] = x[q];
}
constexpr int FFT_LDS_BYTES = (16384 + 1024) * 8;
__device__ __forceinline__ void hy_fftconv(const u16* UT  , const float* cw  , const float* cbias  , const float* FT, f32x2* HS, const float* skip, u16* YGT  ,
                                           LAS unsigned char* lds, int tid0, int blk, int G) {
    LAS f32x2* a = (LAS f32x2*)lds;
#define OPQT() ({ int _t = tid0; asm volatile("" : "+v"(_t)); _t; })
#pragma unroll 1
    for (int ch = blk; ch < D; ch += G) {
        { const int tid = OPQT(); fft_p1_filt(FT + (size_t)ch * SEQ, FT + (size_t)(D + ch) * SEQ, a, tid); }
        __syncthreads();
        { const int tid = OPQT(); fft_pass64<false>(a, tid); }
        __syncthreads();
        { const int tid = OPQT(); f32x2* hs = HS + (size_t)blk * 16384 + tid; const float sk = skip[ch]; fft_mid_filter(a, hs, sk, tid); }
        { const int tid = OPQT(); f32x2* hs = HS + (size_t)blk * 16384 + tid; const float sk = skip[ch]; fft_mid_filter(a, hs + 8192, sk, tid + 512); }
        __syncthreads();
        { const int tid = OPQT();
          const float w1[4] = {cw[0 * 3 * D + D + ch], cw[1 * 3 * D + D + ch], cw[2 * 3 * D + D + ch], cbias[D + ch]};
          const float wv[4] = {cw[0 * 3 * D + 2 * D + ch], cw[1 * 3 * D + 2 * D + ch], cw[2 * 3 * D + 2 * D + ch], cbias[2 * D + ch]};
          fft_p1_z(UT + (size_t)(D + ch) * M, UT + (size_t)(2 * D + ch) * M, w1, wv, a, tid); }
        __syncthreads();
        { const int tid = OPQT(); fft_pass64<false>(a, tid); }
        __syncthreads();
        { const int tid = OPQT(); const f32x2* hs = HS + (size_t)blk * 16384 + tid; fft_mid_z(a, hs, tid); }
        { const int tid = OPQT(); const f32x2* hs = HS + (size_t)blk * 16384 + tid; fft_mid_z(a, hs + 8192, tid + 512); }
        __syncthreads();
        { const int tid = OPQT(); fft_pass64<true>(a, tid); }
        __syncthreads();
        { const int tid = OPQT();
          const float w0[4] = {cw[0 * 3 * D + ch], cw[1 * 3 * D + ch], cw[2 * 3 * D + ch], cbias[ch]};
          fft_last_inv(a, UT + (size_t)ch * M, w0, YGT + (size_t)ch * M, tid); }
        __syncthreads();
    }
#undef OPQT
}
__device__ __forceinline__ void transpose_cm(const u16* src, u16* dst, LAS unsigned char* lds, int tid, int blk, int G) {
    LAS u16* tile = (LAS u16*)lds;
    for (int it = blk; it < (D / 64) * (M / 64); it += G) {
        const int c0 = (it & 15) * 64, m0 = (it >> 4) * 64;
        { const int chl = tid >> 3, seg = tid & 7; const u32x4 v = *(const u32x4*)(src + (size_t)(c0 + chl) * M + m0 + seg * 8); *(LAS u32x4*)(tile + chl * 72 + seg * 8) = v; }
        __syncthreads();
        { const int ml = tid >> 3, cs = tid & 7; unsigned e[8];
#pragma unroll
          for (int i = 0; i < 8; ++i) e[i] = tile[(cs * 8 + i) * 72 + ml];
          u32x4 w; w.x = e[0] | (e[1] << 16); w.y = e[2] | (e[3] << 16); w.z = e[4] | (e[5] << 16); w.w = e[6] | (e[7] << 16);
          *(u32x4*)(dst + (size_t)(m0 + ml) * D + c0 + cs * 8) = w; }
        __syncthreads();
    }
}


#ifndef PROBE_KIND
#define PROBE_KIND 0
#endif
#define PH_BEGIN(kind) const unsigned long long _t0 = (PROBE_KIND == (kind)) ? __builtin_amdgcn_s_memrealtime() : 0ull
#define PH_END(kind) do { if (PROBE_KIND == (kind)) { __syncthreads(); const unsigned long long _dt = __builtin_amdgcn_s_memrealtime() - _t0; \
    while (__builtin_amdgcn_s_memrealtime() - _t0 < 2 * _dt) __builtin_amdgcn_s_sleep(8); } } while (0)
struct Args { const float* in[23]; float* out; unsigned char* ws; int ph_lo, ph_hi, li, pad; };

__global__ void __launch_bounds__(512, 2) mega_fwd(Args args) {
    extern __shared__ __attribute__((aligned(16))) unsigned char lds_raw[];
    LAS unsigned char* lds = (LAS unsigned char*)lds_raw;
    volatile LAS unsigned* MISC = (volatile LAS unsigned*)(lds + MISC_OFF);
    for (int u = threadIdx.x; u < (LDS_BYTES - LDSCTL_OFF) / 4; u += 512) ((LAS unsigned*)(lds + LDSCTL_OFF))[u] = 0u;
    __syncthreads();
    XcdBarrier bar; bar.bar = (unsigned*)(args.ws + WS_CTL) + CW_BAR + args.li * XCD_BAR_WORDS; bar.x = 0; bar.st = nullptr;
#if !MK_PER_PHASE
    bar = xcd_barrier_post((unsigned*)(args.ws + WS_CTL) + CW_BAR + args.li * XCD_BAR_WORDS, MISC + 8);
#endif
    const int lo = args.ph_lo, hi = args.ph_hi;
    int pc = 0;
#define RUN() (pc >= lo && pc < hi)
#if MK_PER_PHASE
#define SEAM() do { ++pc; } while (0)
#else
#define SEAM() do { ++pc; if (pc > lo && pc < hi) xcd_barrier(bar); } while (0)
#endif
#define COORDS() const int tid = opq_tid(), lane = tid & 63, wave = __builtin_amdgcn_readfirstlane(tid >> 6); const int G = opq_s((int)gridDim.x), blk = opq_s((int)blockIdx.x); \
                 const int gw = blk * 8 + wave, NGW = G * 8; unsigned char* ws = arg_ws(); (void)lane; (void)gw; (void)NGW; (void)ws
#define SCR() ((LAS float*)(lds + wave * 16384))

    if (RUN()) { COORDS(); PH_BEGIN(9); phase_p0(arg_in(1), arg_in(2), arg_in(3), (float*)(ws + WS_ADA), arg_in(13), arg_in(14), arg_in(15), arg_in(16), (float*)(ws + WS_HDN), arg_in(17), (float*)(ws + WS_WOT), lds, tid, blk, G);  PH_END(9); }
    SEAM();

#pragma unroll 1
    for (int layer = 0; layer < DEPTH; ++layer) {
        const int jl = layer >> 1;
        if ((layer & 1) == 0) {
            if (RUN()) { COORDS(); PH_BEGIN(5); const unsigned long long _t1 = (PROBE_KIND == 10) ? __builtin_amdgcn_s_memrealtime() : 0ull;
                convert_weights(arg_in(5) + (size_t)jl * D * 5 * D, D, 5 * D, (u16*)(ws + WS_WIN), arg_in(8) + (size_t)jl * D * D, D, D, (u16*)(ws + WS_WOUT),
                                arg_in(20) + (size_t)layer * D * FF, D, FF, (u16*)(ws + WS_W1), arg_in(21) + (size_t)layer * FF * D, FF, D, (u16*)(ws + WS_W2), SCR(), gw, NGW, lane);
                if (PROBE_KIND == 10) { __syncthreads(); const unsigned long long _dt = __builtin_amdgcn_s_memrealtime() - _t1; while (__builtin_amdgcn_s_memrealtime() - _t1 < 2 * _dt) __builtin_amdgcn_s_sleep(8); }
                norm_rows(layer == 0 ? arg_in(0) : arg_out(), arg_in(4) + (size_t)(layer * 2 + 0) * D, (const float*)(ws + WS_ADA) + (size_t)(layer * 2 + 0) * 2 * 3 * D, (u16*)(ws + WS_HN), gw, NGW, lane);
             PH_END(5); }
            SEAM();
            if (RUN()) { COORDS(); PH_BEGIN(1);
                pg8::Gemm g{(const u16*)(ws + WS_HN), (const u16*)(ws + WS_WIN), M, 5 * D, D}; pg8::StaticOrder S; S.init(M, 5 * D, G, blk);
                pg8::EpiHgIn E{(u16*)(ws + WS_Q), (u16*)(ws + WS_V), (u16*)(ws + WS_GT), (u16*)(ws + WS_GF), (u16*)(ws + WS_GB), arg_in(6), jl};
                pg8::gemm_phase<pg8::EpiHgIn, pg8::StaticOrder, true, true>(lds, g, S, E);
             PH_END(1); }
            SEAM();
            if (RUN()) { COORDS(); PH_BEGIN(2); hg_scan1((const u16*)(ws + WS_GF), (const u16*)(ws + WS_GB), (const u16*)(ws + WS_V), (u16*)(ws + WS_S), lds, tid, blk, G);  PH_END(2); }
            SEAM();
            if (RUN()) { COORDS(); PH_BEGIN(3); hg_out((const u16*)(ws + WS_Q), (const u16*)(ws + WS_V), (const u16*)(ws + WS_GT), (const u16*)(ws + WS_GF), (const u16*)(ws + WS_GB), (const u16*)(ws + WS_S),
                              arg_in(7) + (size_t)jl * DV, (u16*)(ws + WS_HN), lds, tid, blk, G);  PH_END(3); }
            SEAM();
        } else {
            if (RUN()) { COORDS(); PH_BEGIN(5); const unsigned long long _t1 = (PROBE_KIND == 10) ? __builtin_amdgcn_s_memrealtime() : 0ull;
                convert_weights(arg_in(9) + (size_t)jl * D * 3 * D, D, 3 * D, (u16*)(ws + WS_WIN), arg_in(19) + (size_t)jl * D * D, D, D, (u16*)(ws + WS_WOUT),
                                arg_in(20) + (size_t)layer * D * FF, D, FF, (u16*)(ws + WS_W1), arg_in(21) + (size_t)layer * FF * D, FF, D, (u16*)(ws + WS_W2), SCR(), gw, NGW, lane);
                if (PROBE_KIND == 10) { __syncthreads(); const unsigned long long _dt = __builtin_amdgcn_s_memrealtime() - _t1; while (__builtin_amdgcn_s_memrealtime() - _t1 < 2 * _dt) __builtin_amdgcn_s_sleep(8); }
                norm_rows(arg_out(), arg_in(4) + (size_t)(layer * 2 + 0) * D, (const float*)(ws + WS_ADA) + (size_t)(layer * 2 + 0) * 2 * 3 * D, (u16*)(ws + WS_HN), gw, NGW, lane);
                const unsigned long long _t2 = (PROBE_KIND == 11) ? __builtin_amdgcn_s_memrealtime() : 0ull;
                filter_gen((const float*)(ws + WS_HDN) + (size_t)jl * SEQ * FW, (const float*)(ws + WS_WOT) + (size_t)jl * 2 * D * FW, (float*)(ws + WS_FT), tid, blk, G);
                if (PROBE_KIND == 11) { __syncthreads(); const unsigned long long _dt = __builtin_amdgcn_s_memrealtime() - _t2; while (__builtin_amdgcn_s_memrealtime() - _t2 < 2 * _dt) __builtin_amdgcn_s_sleep(8); }
             PH_END(5); }
            SEAM();
            if (RUN()) { COORDS(); PH_BEGIN(1);
                pg8::Gemm g{(const u16*)(ws + WS_WIN), (const u16*)(ws + WS_HN), 3 * D, M, D}; pg8::StaticOrder S; S.init(3 * D, M, G, blk);
                pg8::EpiRowBias E{(u16*)(ws + WS_U), M, arg_in(10) + (size_t)jl * 3 * D};
                pg8::gemm_phase<pg8::EpiRowBias, pg8::StaticOrder, true, true>(lds, g, S, E);
                 PH_END(1); }
            SEAM();
            if (RUN()) { COORDS(); PH_BEGIN(4); hy_fftconv((const u16*)(ws + WS_U), arg_in(11) + (size_t)jl * 3 * 3 * D, arg_in(12) + (size_t)jl * 3 * D, (const float*)(ws + WS_FT), (f32x2*)(ws + WS_HS),
                                                       arg_in(18) + (size_t)jl * D, (u16*)(ws + WS_ZT), lds, tid, blk, G);  PH_END(4); }
            SEAM();
            if (RUN()) { COORDS(); PH_BEGIN(6); transpose_cm((const u16*)(ws + WS_ZT), (u16*)(ws + WS_HN), lds, tid, blk, G);  PH_END(6); }
            SEAM();
        }
        if (RUN()) { COORDS(); PH_BEGIN(7);
            pg8::Gemm g{(const u16*)(ws + WS_HN), (const u16*)(ws + WS_WOUT), M, D, D}; pg8::StaticOrder S; S.init(M, D, G, blk);
            pg8::EpiResid E{layer == 0 ? arg_in(0) : arg_out(), arg_out(), (const float*)(ws + WS_ADA) + (size_t)(layer * 2 + 0) * 2 * 3 * D + 2 * D};
            pg8::gemm_phase<pg8::EpiResid, pg8::StaticOrder, true, true>(lds, g, S, E);
         PH_END(7); }
        SEAM();
        if (RUN()) { COORDS(); PH_BEGIN(5); norm_rows(arg_out(), arg_in(4) + (size_t)(layer * 2 + 1) * D, (const float*)(ws + WS_ADA) + (size_t)(layer * 2 + 1) * 2 * 3 * D, (u16*)(ws + WS_HN), gw, NGW, lane);  PH_END(5); }
        SEAM();
        if (RUN()) { COORDS(); PH_BEGIN(8);
            pg8::Gemm g{(const u16*)(ws + WS_HN), (const u16*)(ws + WS_W1), M, FF, D}; pg8::StaticOrder S; S.init(M, FF, G, blk);
            pg8::EpiRelu2 E{(u16*)(ws + WS_H), FF};
            pg8::gemm_phase<pg8::EpiRelu2, pg8::StaticOrder, true, true>(lds, g, S, E);
         PH_END(8); }
        SEAM();
        if (RUN()) { COORDS(); PH_BEGIN(7);
            pg8::Gemm g{(const u16*)(ws + WS_H), (const u16*)(ws + WS_W2), M, D, FF}; pg8::StaticOrder S; S.init(M, D, G, blk);
            pg8::EpiResid E{arg_out(), arg_out(), (const float*)(ws + WS_ADA) + (size_t)(layer * 2 + 1) * 2 * 3 * D + 2 * D};
            pg8::gemm_phase<pg8::EpiResid, pg8::StaticOrder, true, true>(lds, g, S, E);
         PH_END(7); }
        SEAM();
    }
    if (RUN()) { COORDS(); PH_BEGIN(5); final_norm_rows(arg_out(), arg_in(22), gw, NGW, lane);  PH_END(5); }
#undef RUN
#undef SEAM
#undef COORDS
#undef SCR
}

constexpr int N_PHASES = 1 + 2 * 8 + 2 * 8 + 1;

extern "C" void kernel_launch(void* const* d_in, const int* in_sizes, int n_in, void* d_out, int out_size, void* d_ws, size_t ws_size, hipStream_t stream) {
    static int grid = 0;
    if (grid == 0) {
        if (n_in != 23 || in_sizes[0] != M * D || out_size != M * D || ws_size < WS_END) {
            fprintf(stderr, "kernel_launch: unexpected problem: n_in %d in0 %d out %d ws %zu (need %zu)\n", n_in, n_in > 0 ? in_sizes[0] : -1, out_size, ws_size, (size_t)WS_END); grid = -1; return; }
        int dev = 0, cus = 0;
        if (hipGetDevice(&dev) != hipSuccess || hipDeviceGetAttribute(&cus, hipDeviceAttributeMultiprocessorCount, dev) != hipSuccess) { grid = -1; return; }
        if (hipFuncSetAttribute((const void*)mega_fwd, hipFuncAttributeMaxDynamicSharedMemorySize, LDS_BYTES) != hipSuccess) { fprintf(stderr, "kernel_launch: hipFuncSetAttribute failed\n"); grid = -1; return; }
        int per_cu = 0;
        if (hipOccupancyMaxActiveBlocksPerMultiprocessor(&per_cu, (const void*)mega_fwd, 512, LDS_BYTES) != hipSuccess || per_cu < 1)
            fprintf(stderr, "kernel_launch: occupancy query reports %d per CU\n", per_cu);
        (void)hipGetLastError();
        grid = cus;
    }
    if (grid < 0) return;
    if (hipMemsetAsync((char*)d_ws + WS_CTL, 0, CTL_ZERO_BYTES, stream) != hipSuccess) { fprintf(stderr, "kernel_launch: memset failed\n"); return; }
    Args a{};
    for (int i = 0; i < 23; ++i) a.in[i] = (const float*)d_in[i];
    a.out = (float*)d_out; a.ws = (unsigned char*)d_ws;
#if MK_PER_PHASE
    for (int p = 0; p < N_PHASES; ++p) { a.ph_lo = p; a.ph_hi = p + 1; a.li = 0; hipLaunchKernelGGL(mega_fwd, dim3(grid), dim3(512), LDS_BYTES, stream, a); }
#else
    a.ph_lo = 0; a.ph_hi = N_PHASES; a.li = 0;
    hipLaunchKernelGGL(mega_fwd, dim3(grid), dim3(512), LDS_BYTES, stream, a);
#endif
    const hipError_t le = hipPeekAtLastError();
    if (le != hipSuccess) fprintf(stderr, "kernel_launch: launch failed: %s\n", hipGetErrorName(le));
}
```

```cpp
#include <hip/hip_runtime.h>
#include <cstdio>
#include <cstdint>

#ifndef MK_PER_PHASE
#define MK_PER_PHASE 0
#endif

#define GAS __attribute__((address_space(1)))
#define LAS __attribute__((address_space(3)))
typedef unsigned short u16;
typedef float f32x4 __attribute__((ext_vector_type(4)));
typedef float f32x2 __attribute__((ext_vector_type(2)));
typedef short bf16x8 __attribute__((ext_vector_type(8)));
typedef unsigned u32x4 __attribute__((ext_vector_type(4)));
typedef unsigned u32x2 __attribute__((ext_vector_type(2)));
typedef _Float16 h16x2 __attribute__((ext_vector_type(2)));

constexpr int D = 1024, NB = 2, SEQ = 8192, M = NB * SEQ, DEPTH = 4, NH = 8, DK = 128, DV = 128, CH = 64, NCH = SEQ / CH, FF = 4096;
constexpr int FW = 64, EMB = 33;
constexpr float NORM_EPS = 1e-6f;
constexpr float HY_MAX_DECAY = -15.350567286626973f;
constexpr float HY_MIN_DECAY = -3.0701134573253946f;

constexpr size_t MiB = 1u << 20;
constexpr size_t WS_CTL = 0, CTL_ZERO_BYTES = 1 * MiB;
constexpr size_t WS_ADA = 1 * MiB;
constexpr size_t WS_HDN = 2 * MiB;
constexpr size_t WS_WOT = 6 * MiB;
constexpr size_t WS_W = 8 * MiB;
constexpr size_t WS_WIN = WS_W, WS_WOUT = WS_W + 10 * MiB, WS_W1 = WS_W + 12 * MiB, WS_W2 = WS_W + 20 * MiB;
constexpr size_t WS_HN = 36 * MiB;
constexpr size_t WS_Q = 68 * MiB, WS_V = 100 * MiB, WS_GT = 132 * MiB, WS_GF = 164 * MiB, WS_GB = 196 * MiB, WS_S = 228 * MiB;
constexpr size_t WS_H = 228 * MiB;
constexpr size_t WS_U = 68 * MiB;
constexpr size_t WS_ZT = 164 * MiB;
constexpr size_t WS_FT = 228 * MiB;
constexpr size_t WS_HS = 292 * MiB;
constexpr size_t WS_END = 356 * MiB;
constexpr int CW_BAR = 4096;

constexpr int RING_BYTES = 131072;
constexpr int LDSCTL_OFF = (16384 + 1024) * 8  , MISC_OFF = LDSCTL_OFF + 320;
constexpr int LDS_BYTES = 147456;

__device__ __forceinline__ unsigned f2bf(float f) { unsigned u = __builtin_bit_cast(unsigned, f); return (u + 0x7fffu + ((u >> 16) & 1u)) >> 16; }
__device__ __forceinline__ unsigned pk2(float lo, float hi) { return f2bf(lo) | (f2bf(hi) << 16); }
__device__ __forceinline__ float bf2f(unsigned b) { return __builtin_bit_cast(float, b << 16); }
__device__ __forceinline__ unsigned pkh2(float lo, float hi) { h16x2 v; v.x = (_Float16)lo; v.y = (_Float16)hi; return __builtin_bit_cast(unsigned, v); }
__device__ __forceinline__ float h2f(unsigned short b) { return (float)__builtin_bit_cast(_Float16, b); }
__device__ __forceinline__ float sin_rev(float r) { return __builtin_amdgcn_sinf(r); }
__device__ __forceinline__ float cos_rev(float r) { return __builtin_amdgcn_cosf(r); }
__device__ __forceinline__ float fast_sin(float x) { float r = x * 0.15915494309189535f; r = r - floorf(r); return sin_rev(r); }
__device__ __forceinline__ float sigmoidf_(float x) { return 1.0f / (1.0f + __expf(-x)); }
__device__ __forceinline__ float siluf_(float x) { return x / (1.0f + __expf(-x)); }
__device__ __forceinline__ float wave_sum(float v) {
#pragma unroll
    for (int o = 1; o < 64; o <<= 1) v += __shfl_xor(v, o);
    return v;
}
#define LDS_WAIT() asm volatile("s_waitcnt lgkmcnt(0)" ::: "memory")

#define CAS __attribute__((address_space(4)))
__device__ __forceinline__ int opq_tid() { int t = threadIdx.x; asm volatile("" : "+v"(t)); return t; }
__device__ __forceinline__ int opq_s(int x) { asm volatile("" : "+s"(x)); return x; }
__device__ __forceinline__ const float* arg_in(int i) { const CAS char* p = (const CAS char*)__builtin_amdgcn_kernarg_segment_ptr(); asm volatile("" : "+s"(p)); return *(const float* const CAS*)(p + 8 * i); }
__device__ __forceinline__ float* arg_out() { const CAS char* p = (const CAS char*)__builtin_amdgcn_kernarg_segment_ptr(); asm volatile("" : "+s"(p)); return *(float* const CAS*)(p + 8 * 23); }
__device__ __forceinline__ unsigned char* arg_ws() { const CAS char* p = (const CAS char*)__builtin_amdgcn_kernarg_segment_ptr(); asm volatile("" : "+s"(p)); return *(unsigned char* const CAS*)(p + 8 * 24); }

namespace pg8 {
#define PG8_LAS __attribute__((address_space(3)))
typedef unsigned short bf16_t;
constexpr int BM = 256, BK = 64, HALF = 128, HTB = HALF * BK * 2, STAGE_BYTES = 8 * HTB, NXCD = 8, WGM = 8;
__host__ __device__ __forceinline__ int lds_byte(int r, int c) { const int st = (r >> 4) * 2 + (c >> 5), rr = r & 15, cc = c & 31, ob = rr * 64 + cc * 2; return st * 1024 + (ob ^ (((ob >> 9) & 1) << 5)); }
__host__ __device__ __forceinline__ void stage_rc(int b, int& R, int& C) { const int st = b / 1024, sb = b % 1024, swz = sb ^ (((sb >> 9) & 1) << 5); R = (st >> 1) * 16 + swz / 64; C = (st & 1) * 32 + (swz % 64) / 2; }
__host__ __device__ __forceinline__ int perm32(int rho) { const int n = rho >> 4, i = rho & 15; return 8 * (i >> 2) + 4 * n + (i & 3); }
struct Unit { int pm, pn; };
struct Gemm { const bf16_t* A; const bf16_t* Bt; int M, N, K; };
struct StaticOrder {
    int nM, nN, nwg, G, c;
    __host__ __device__ void init(int M_, int N_, int G_, int c_) { nM = M_ / BM; nN = N_ / BM; nwg = nM * nN; G = G_; c = c_; }
    __host__ __device__ bool next(int i, Unit& u) const {
        const long L = (long)i * G + c; if (L >= nwg) return false;
        int wgid = (int)L; { const int q = nwg / NXCD, r = nwg % NXCD, xcd = wgid % NXCD, off = wgid / NXCD; wgid = (xcd < r ? xcd * (q + 1) : r * (q + 1) + (xcd - r) * q) + off; }
        const int nig = WGM * nN, gid = wgid / nig, fm = gid * WGM, gsz = (nM - fm) < WGM ? (nM - fm) : WGM;
        u.pm = fm + ((wgid % nig) % gsz); u.pn = (wgid % nig) / gsz; return true;
    }
    __device__ __forceinline__ void a_ready(const Unit&) const {}
    __device__ __forceinline__ void done(const Unit&) const {}
};
__device__ __forceinline__ unsigned cvt_pk_bf16(float lo, float hi) { unsigned r; asm volatile("v_cvt_pk_bf16_f32 %0, %1, %2" : "=v"(r) : "v"(lo), "v"(hi)); return r; }

template <class Epi, class Sched, bool ALIGN_EPI = false, bool SP2 = false>
__device__ __forceinline__ void gemm_phase(PG8_LAS unsigned char* lds, const Gemm g, const Sched& S, const Epi& E) {
    const int tid = opq_tid(), wid = __builtin_amdgcn_readfirstlane(tid >> 6), lane = tid & 63, wr = wid >> 2, wc = wid & 3, fr = lane & 15, fq = lane >> 4;
    const int K = g.K, nt = K / BK;
    unsigned voffA[2], voffB[2];
#pragma unroll
    for (int i = 0; i < 2; ++i) { int R, C; stage_rc(tid * 16 + i * 8192, R, C); const int Rb = Epi::PERM ? ((R & ~31) + perm32(R & 31)) : R;
        voffA[i] = (unsigned)(R * K + C) * 2u; voffB[i] = (unsigned)(Rb * K + C) * 2u; }
    const size_t kstep = (size_t)(BK * 2);
    const size_t hstep = (size_t)HALF * K * 2;
    const size_t tstep = 2 * hstep;
    const unsigned ldsw = (unsigned)wid * 1024u;
    const int aoff = lds_byte(wr * 64 + fr, fq * 8), boff = lds_byte(wc * 32 + fr, fq * 8);
#define PG8_SA(b, h) (((b) * 2 + (h)) * HTB)
#define PG8_SB(b, h) ((4 + (b) * 2 + (h)) * HTB)
#define PG8_STAGE(bufoff, gbase, voff) do { _Pragma("unroll") for (int _i = 0; _i < 2; ++_i) \
        __builtin_amdgcn_global_load_lds((const unsigned*)((const char*)(gbase) + (voff)[_i]), (PG8_LAS unsigned*)(lds + (bufoff) + ldsw + _i * 8192), 16, 0, 0); } while (0)
#define PG8_LDA(dst, b, h) do { _Pragma("unroll") for (int m = 0; m < 4; ++m) _Pragma("unroll") for (int k = 0; k < 2; ++k) dst[m][k] = *(const PG8_LAS bf16x8*)(lds + PG8_SA(b, h) + aoff + m * 2048 + k * 1024); } while (0)
#define PG8_LDB(dst, b, h) do { _Pragma("unroll") for (int n = 0; n < 2; ++n) _Pragma("unroll") for (int k = 0; k < 2; ++k) dst[n][k] = *(const PG8_LAS bf16x8*)(lds + PG8_SB(b, h) + boff + n * 2048 + k * 1024); } while (0)
#define PG8_MMA(ai, bj, At, Bt) do { __builtin_amdgcn_s_setprio(1); _Pragma("unroll") for (int m = 0; m < 4; ++m) _Pragma("unroll") for (int n = 0; n < 2; ++n) _Pragma("unroll") for (int k = 0; k < 2; ++k) \
        acc[ai][bj][m][n] = __builtin_amdgcn_mfma_f32_16x16x32_bf16(Bt[n][k], At[m][k], acc[ai][bj][m][n], 0, 0, 0); __builtin_amdgcn_s_setprio(0); } while (0)
#define PG8_WAIT_V(n) asm volatile("s_waitcnt vmcnt(" #n ")" ::: "memory")
#define PG8_WAIT_L(n) asm volatile("s_waitcnt lgkmcnt(" #n ")" ::: "memory")
#define PG8_BAR __builtin_amdgcn_s_barrier()
#define PG8_SCHED __builtin_amdgcn_sched_barrier(0)
    Unit cur, nxt; int ui = 0;
    if (!S.next(0, cur)) return;
    f32x4 acc[2][2][4][2];
#pragma unroll
    for (int a = 0; a < 2; ++a)
#pragma unroll
        for (int b = 0; b < 2; ++b)
#pragma unroll
            for (int m = 0; m < 4; ++m)
#pragma unroll
                for (int n = 0; n < 2; ++n) acc[a][b][m][n] = (f32x4){0.f, 0.f, 0.f, 0.f};
    bf16x8 At[4][2], B0[2][2], B1[2][2];
    const char* cA = (const char*)g.A + (size_t)cur.pm * tstep; const char* cB = (const char*)g.Bt + (size_t)cur.pn * tstep;
    S.a_ready(cur);
    if constexpr (SP2) {
        PG8_STAGE(PG8_SB(0, 0), cB, voffB); PG8_STAGE(PG8_SB(0, 1), cB + hstep, voffB); PG8_STAGE(PG8_SA(0, 0), cA, voffA); PG8_STAGE(PG8_SA(0, 1), cA + hstep, voffA);
        if (wr == 1) PG8_BAR;
        PG8_WAIT_V(2); PG8_BAR;
        PG8_STAGE(PG8_SB(1, 0), cB + kstep, voffB); PG8_STAGE(PG8_SA(1, 0), cA + kstep, voffA); PG8_STAGE(PG8_SB(1, 1), cB + hstep + kstep, voffB);
        PG8_WAIT_V(6); PG8_BAR;
    } else {
        PG8_STAGE(PG8_SB(0, 0), cB, voffB); PG8_STAGE(PG8_SA(0, 0), cA, voffA); PG8_STAGE(PG8_SB(0, 1), cB + hstep, voffB); PG8_STAGE(PG8_SA(0, 1), cA + hstep, voffA);
        if (wr == 1) PG8_BAR;
        PG8_WAIT_V(4); PG8_BAR;
        PG8_STAGE(PG8_SB(1, 0), cB + kstep, voffB); PG8_STAGE(PG8_SA(1, 0), cA + kstep, voffA); PG8_STAGE(PG8_SB(1, 1), cB + hstep + kstep, voffB);
        PG8_WAIT_V(6); PG8_BAR;
    }
    for (;;) {
        const bool has_next = S.next(ui + 1, nxt);
        const char* nA = has_next ? (const char*)g.A + (size_t)nxt.pm * tstep : cA; const char* nB = has_next ? (const char*)g.Bt + (size_t)nxt.pn * tstep : cB;
        for (int t = 0; t < nt; t += 2) {
            const bool last = (t == nt - 2);
            const char* a1 = cA + (size_t)(t + 1) * kstep;
            const char* a2 = last ? nA : cA + (size_t)(t + 2) * kstep; const char* b2 = last ? nB : cB + (size_t)(t + 2) * kstep;
            const char* a3 = a2 + kstep; const char* b3 = b2 + kstep;
            if (last && has_next) S.a_ready(nxt);
            if constexpr (SP2) {
            PG8_LDB(B0, 0, 0); PG8_LDB(B1, 0, 1); PG8_SCHED; PG8_LDA(At, 0, 0); PG8_STAGE(PG8_SA(1, 1), a1 + hstep, voffA);
            PG8_WAIT_V(8); PG8_WAIT_L(0); PG8_BAR; PG8_MMA(0, 0, At, B0); PG8_MMA(0, 1, At, B1); PG8_BAR; PG8_SCHED;
            PG8_LDA(At, 0, 1); PG8_STAGE(PG8_SB(0, 0), b2, voffB); PG8_STAGE(PG8_SB(0, 1), b2 + hstep, voffB); PG8_STAGE(PG8_SA(0, 0), a2, voffA);
            PG8_WAIT_V(8); PG8_WAIT_L(0); PG8_BAR; PG8_MMA(1, 0, At, B0); PG8_MMA(1, 1, At, B1); PG8_BAR; PG8_SCHED;
            PG8_LDB(B0, 1, 0); PG8_LDB(B1, 1, 1); PG8_SCHED; PG8_LDA(At, 1, 0); PG8_STAGE(PG8_SA(0, 1), a2 + hstep, voffA);
            PG8_WAIT_V(8); PG8_WAIT_L(0); PG8_BAR; PG8_MMA(0, 0, At, B0); PG8_MMA(0, 1, At, B1); PG8_BAR; PG8_SCHED;
            PG8_LDA(At, 1, 1); PG8_STAGE(PG8_SB(1, 0), b3, voffB); PG8_STAGE(PG8_SB(1, 1), b3 + hstep, voffB); PG8_STAGE(PG8_SA(1, 0), a3, voffA);
            PG8_WAIT_V(8); PG8_WAIT_L(0); PG8_BAR; PG8_MMA(1, 0, At, B0); PG8_MMA(1, 1, At, B1); PG8_BAR; PG8_SCHED;
            } else {
            PG8_LDB(B0, 0, 0); PG8_SCHED; PG8_LDA(At, 0, 0); PG8_STAGE(PG8_SA(1, 1), a1 + hstep, voffA);
            PG8_WAIT_L(8); PG8_BAR; PG8_WAIT_L(0); PG8_MMA(0, 0, At, B0); PG8_BAR; PG8_SCHED;
            PG8_LDB(B1, 0, 1); PG8_STAGE(PG8_SB(0, 0), b2, voffB);
            PG8_BAR; PG8_WAIT_L(0); PG8_MMA(0, 1, At, B1); PG8_BAR;
            PG8_LDA(At, 0, 1); PG8_STAGE(PG8_SA(0, 0), a2, voffA);
            PG8_BAR; PG8_WAIT_L(0); PG8_MMA(1, 0, At, B0); PG8_BAR; PG8_SCHED;
            PG8_STAGE(PG8_SB(0, 1), b2 + hstep, voffB);
            PG8_WAIT_V(6); PG8_BAR; PG8_MMA(1, 1, At, B1); PG8_BAR;
            PG8_LDB(B0, 1, 0); PG8_SCHED; PG8_LDA(At, 1, 0); PG8_STAGE(PG8_SA(0, 1), a2 + hstep, voffA);
            PG8_WAIT_L(8); PG8_BAR; PG8_WAIT_L(0); PG8_MMA(0, 0, At, B0); PG8_BAR; PG8_SCHED;
            PG8_LDB(B1, 1, 1); PG8_STAGE(PG8_SB(1, 0), b3, voffB);
            PG8_BAR; PG8_WAIT_L(0); PG8_MMA(0, 1, At, B1); PG8_BAR;
            PG8_LDA(At, 1, 1); PG8_STAGE(PG8_SA(1, 0), a3, voffA);
            PG8_BAR; PG8_WAIT_L(0); PG8_MMA(1, 0, At, B0); PG8_BAR; PG8_SCHED;
            PG8_STAGE(PG8_SB(1, 1), b3 + hstep, voffB);
            PG8_WAIT_V(6); PG8_BAR; PG8_MMA(1, 1, At, B1); PG8_BAR;
            }
        }
        if constexpr (ALIGN_EPI) { if (wr == 0) PG8_BAR; }
        E(acc, cur, wr, wc, fr, fq); S.done(cur);
        if (!has_next) break;
#pragma unroll
        for (int a = 0; a < 2; ++a)
#pragma unroll
            for (int b = 0; b < 2; ++b)
#pragma unroll
                for (int m = 0; m < 4; ++m)
#pragma unroll
                    for (int n = 0; n < 2; ++n) acc[a][b][m][n] = (f32x4){0.f, 0.f, 0.f, 0.f};
        cur = nxt; cA = nA; cB = nB; ++ui;
        if constexpr (ALIGN_EPI) { if (wr == 1) PG8_BAR; }
    }
    PG8_WAIT_V(0);
    if constexpr (!ALIGN_EPI) { if (wr == 0) PG8_BAR; }
    PG8_BAR;
#undef PG8_SA
#undef PG8_SB
#undef PG8_STAGE
#undef PG8_LDA
#undef PG8_LDB
#undef PG8_MMA
#undef PG8_WAIT_V
#undef PG8_WAIT_L
#undef PG8_BAR
#undef PG8_SCHED
}

struct EpiResid {
    static constexpr bool PERM = false, AFTER_DRAIN = false;
    const float* xin; float* xout; const float* gate;
    __device__ __forceinline__ void operator()(const f32x4 (&acc)[2][2][4][2], const Unit& u, int wr, int wc, int fr, int fq) const {
        const int row0 = u.pm * BM + wr * 64 + fr, col0 = u.pn * BM + wc * 32 + 4 * fq;
        const float* gp = gate + (u.pm >= (SEQ / BM) ? 3 * D : 0);
        f32x4 gv[2][2];
#pragma unroll
        for (int bj = 0; bj < 2; ++bj)
#pragma unroll
            for (int n = 0; n < 2; ++n) gv[bj][n] = *(const f32x4*)(gp + col0 + bj * HALF + n * 16);
#pragma unroll
        for (int ai = 0; ai < 2; ++ai)
#pragma unroll
            for (int m = 0; m < 4; ++m) { const size_t off = (size_t)(row0 + ai * HALF + m * 16) * D + col0;
#pragma unroll
                for (int bj = 0; bj < 2; ++bj)
#pragma unroll
                    for (int n = 0; n < 2; ++n) { const f32x4 xi = *(const f32x4*)(xin + off + bj * HALF + n * 16);
                        *(f32x4*)(xout + off + bj * HALF + n * 16) = xi + gv[bj][n] * acc[ai][bj][m][n]; } }
    }
};
struct EpiRelu2 {
    static constexpr bool PERM = true, AFTER_DRAIN = false;
    bf16_t* O; int ldc;
    __device__ __forceinline__ void operator()(const f32x4 (&acc)[2][2][4][2], const Unit& u, int wr, int wc, int fr, int fq) const {
        const int row0 = u.pm * BM + wr * 64 + fr, col0 = u.pn * BM + wc * 32 + 8 * fq;
#pragma unroll
        for (int ai = 0; ai < 2; ++ai)
#pragma unroll
            for (int m = 0; m < 4; ++m) { bf16_t* rowp = O + (size_t)(row0 + ai * HALF + m * 16) * ldc + col0;
#pragma unroll
                for (int bj = 0; bj < 2; ++bj) { f32x4 v0 = acc[ai][bj][m][0], v1 = acc[ai][bj][m][1];
#pragma unroll
                    for (int j = 0; j < 4; ++j) { const float a = fmaxf(v0[j], 0.f), b = fmaxf(v1[j], 0.f); v0[j] = a * a; v1[j] = b * b; }
                    u32x4 w; w.x = cvt_pk_bf16(v0[0], v0[1]); w.y = cvt_pk_bf16(v0[2], v0[3]); w.z = cvt_pk_bf16(v1[0], v1[1]); w.w = cvt_pk_bf16(v1[2], v1[3]);
                    *(u32x4*)(rowp + bj * HALF) = w; } }
    }
};
struct EpiBias {
    static constexpr bool PERM = true, AFTER_DRAIN = false;
    bf16_t* O; int ldc; const float* bias;
    __device__ __forceinline__ void operator()(const f32x4 (&acc)[2][2][4][2], const Unit& u, int wr, int wc, int fr, int fq) const {
        const int row0 = u.pm * BM + wr * 64 + fr, col0 = u.pn * BM + wc * 32 + 8 * fq;
        f32x4 bv[2][2];
#pragma unroll
        for (int bj = 0; bj < 2; ++bj)
#pragma unroll
            for (int n = 0; n < 2; ++n) bv[bj][n] = *(const f32x4*)(bias + col0 + bj * HALF + 4 * n);
#pragma unroll
        for (int ai = 0; ai < 2; ++ai)
#pragma unroll
            for (int m = 0; m < 4; ++m) { bf16_t* rowp = O + (size_t)(row0 + ai * HALF + m * 16) * ldc + col0;
#pragma unroll
                for (int bj = 0; bj < 2; ++bj) { const f32x4 v0 = acc[ai][bj][m][0] + bv[bj][0], v1 = acc[ai][bj][m][1] + bv[bj][1];
                    u32x4 w; w.x = cvt_pk_bf16(v0[0], v0[1]); w.y = cvt_pk_bf16(v0[2], v0[3]); w.z = cvt_pk_bf16(v1[0], v1[1]); w.w = cvt_pk_bf16(v1[2], v1[3]);
                    *(u32x4*)(rowp + bj * HALF) = w; } }
    }
};
struct EpiRowBias {
    static constexpr bool PERM = true, AFTER_DRAIN = false;
    bf16_t* O; int ldc; const float* bias;
    __device__ __forceinline__ void operator()(const f32x4 (&acc)[2][2][4][2], const Unit& u, int wr, int wc, int fr, int fq) const {
        const int row0 = u.pm * BM + wr * 64 + fr, col0 = u.pn * BM + wc * 32 + 8 * fq;
#pragma unroll
        for (int ai = 0; ai < 2; ++ai)
#pragma unroll
            for (int m = 0; m < 4; ++m) { const int row = row0 + ai * HALF + m * 16; const float bb = bias[row]; bf16_t* rowp = O + (size_t)row * ldc + col0;
#pragma unroll
                for (int bj = 0; bj < 2; ++bj) { const f32x4 v0 = acc[ai][bj][m][0] + bb, v1 = acc[ai][bj][m][1] + bb;
                    u32x4 w; w.x = cvt_pk_bf16(v0[0], v0[1]); w.y = cvt_pk_bf16(v0[2], v0[3]); w.z = cvt_pk_bf16(v1[0], v1[1]); w.w = cvt_pk_bf16(v1[2], v1[3]);
                    *(u32x4*)(rowp + bj * HALF) = w; } }
    }
};
struct EpiHgIn {
    static constexpr bool PERM = true, AFTER_DRAIN = false;
    bf16_t *Q, *V, *GT, *GF, *GB; const float* lbraw; int jl;
    __device__ __forceinline__ void operator()(const f32x4 (&acc)[2][2][4][2], const Unit& u, int wr, int wc, int fr, int fq) const {
        const int sec = u.pn >> 2;
        const int row0 = u.pm * BM + wr * 64 + fr, col0 = (u.pn & 3) * BM + wc * 32 + 8 * fq;
        bf16_t* base = sec == 0 ? Q : sec == 1 ? V : sec == 2 ? GF : sec == 3 ? GB : GT;
        float lb[2][8];
#pragma unroll
        for (int bj = 0; bj < 2; ++bj)
#pragma unroll
            for (int j = 0; j < 8; ++j) lb[bj][j] = 0.f;
        if ((sec == 2 || sec == 3) && jl == 1) {
            const float* r0 = lbraw + (size_t)(sec - 2) * 2 * D;
#pragma unroll
            for (int bj = 0; bj < 2; ++bj)
#pragma unroll
                for (int j = 0; j < 8; ++j) { const int c = col0 + bj * HALF + j; const float a0 = r0[c], a1 = r0[D + c]; lb[bj][j] = 1.0f / (1.0f + __expf(a0 - a1));   }
        }
#pragma unroll
        for (int ai = 0; ai < 2; ++ai)
#pragma unroll
            for (int m = 0; m < 4; ++m) { bf16_t* rowp = base + (size_t)(row0 + ai * HALF + m * 16) * D + col0;
#pragma unroll
                for (int bj = 0; bj < 2; ++bj) { float v[8];
#pragma unroll
                    for (int j = 0; j < 4; ++j) { v[j] = acc[ai][bj][m][0][j]; v[4 + j] = acc[ai][bj][m][1][j]; }
                    u32x4 w;
                    if (sec == 0 || sec == 4) {
#pragma unroll
                        for (int j = 0; j < 8; ++j) v[j] = siluf_(v[j]);
                        w.x = cvt_pk_bf16(v[0], v[1]); w.y = cvt_pk_bf16(v[2], v[3]); w.z = cvt_pk_bf16(v[4], v[5]); w.w = cvt_pk_bf16(v[6], v[7]);
                    } else if (sec == 1) {
                        w.x = cvt_pk_bf16(v[0], v[1]); w.y = cvt_pk_bf16(v[2], v[3]); w.z = cvt_pk_bf16(v[4], v[5]); w.w = cvt_pk_bf16(v[6], v[7]);
                    } else {
#pragma unroll
                        for (int j = 0; j < 8; ++j) { const float l = lb[bj][j]; const float f = l + (1.0f - l) * sigmoidf_(v[j]); v[j] = fmaxf(__logf(f), -100.0f); }
                        w.x = pkh2(v[0], v[1]); w.y = pkh2(v[2], v[3]); w.z = pkh2(v[4], v[5]); w.w = pkh2(v[6], v[7]);
                    }
                    *(u32x4*)(rowp + bj * HALF) = w; } }
    }
};
}

#define XB_TMO      128
#define XB_XCNT(j)  (256  + 64 * (j))
#define XB_XSUB(j)  (1280 + 64 * (j))
#define XB_XGEN(j)  (2304 + 64 * (j))
#define XB_TOP      3328
#define XB_TOPGEN   3392
#define XCD_BAR_WORDS 3456
#define XB_SPIN_CAP (1u << 18)
__device__ __forceinline__ unsigned xb_ld(unsigned* p)              { return __hip_atomic_load(p, __ATOMIC_RELAXED, __HIP_MEMORY_SCOPE_AGENT); }
__device__ __forceinline__ unsigned xb_add(unsigned* p, unsigned v) { return __hip_atomic_fetch_add(p, v, __ATOMIC_RELAXED, __HIP_MEMORY_SCOPE_AGENT); }
__device__ __forceinline__ unsigned xb_xcc_id() { return (unsigned)__builtin_amdgcn_s_getreg((3 << 11) | 20) & 0xFu; }
#define XB_SPIN(cond, bar) do { unsigned _sp = 0; while (cond) { __builtin_amdgcn_s_sleep(1); \
    if ((++_sp & 255u) == 0u) { if (xb_ld(&(bar)[XB_TMO])) break; if (_sp > XB_SPIN_CAP) { atomicAdd(&(bar)[XB_TMO], 1u); break; } } } } while (0)
struct XcdBarrier { unsigned* bar; unsigned x; volatile LAS unsigned* st; };
__device__ __forceinline__ XcdBarrier xcd_barrier_post(unsigned* bar, volatile LAS unsigned* st) {
    XcdBarrier b; b.bar = bar; b.x = xb_xcc_id(); b.st = st;
    if (threadIdx.x == 0) (void)xb_add(&bar[XB_XCNT(b.x)], 1u);
    return b;
}
__device__ __forceinline__ void xcd_barrier_complete(unsigned* bar, unsigned x, unsigned& nloc, unsigned& nx) {
    const unsigned G = gridDim.x * gridDim.y * gridDim.z;
    unsigned sum, cnt, mine, sp = 0u;
    for (;;) {
        sum = 0u; cnt = 0u; mine = 0u;
#pragma unroll
        for (unsigned j = 0; j < 16; ++j) { const unsigned c = xb_ld(&bar[XB_XCNT(j)]); sum += c; cnt += (c > 0u) ? 1u : 0u; mine = (j == x) ? c : mine; }
        if (sum == G) break;
        __builtin_amdgcn_s_sleep(1);
        if ((++sp & 255u) == 0u) { if (xb_ld(&bar[XB_TMO])) break; if (sp > XB_SPIN_CAP) { atomicAdd(&bar[XB_TMO], 1u); break; } }
    }
    nloc = mine > 0u ? mine : 1u; nx = cnt > 0u ? cnt : 1u;
}
__device__ __forceinline__ void xcd_barrier(const XcdBarrier& b) {
    asm volatile("s_waitcnt vmcnt(0)" ::: "memory");
    __syncthreads();
    if (threadIdx.x == 0) {
        unsigned* bar = b.bar;
        __builtin_amdgcn_s_waitcnt(0);
        unsigned nloc = b.st[0], nx = b.st[1];
        if (nloc == 0u) { xcd_barrier_complete(bar, b.x, nloc, nx); b.st[0] = nloc; b.st[1] = nx; }
        const unsigned old = xb_add(&bar[XB_XSUB(b.x)], 1u);
        const unsigned gen = old / nloc;
        if (old + 1u == (gen + 1u) * nloc) {
            __builtin_amdgcn_fence(__ATOMIC_RELEASE, "agent");
            asm volatile("s_waitcnt vmcnt(0)" ::: "memory");
            const unsigned og = xb_add(&bar[XB_TOP], 1u);
            const unsigned tg = og / nx;
            if (og + 1u == (tg + 1u) * nx) xb_add(&bar[XB_TOPGEN], 1u);
            else XB_SPIN(xb_ld(&bar[XB_TOPGEN]) == tg, bar);
            __builtin_amdgcn_fence(__ATOMIC_ACQUIRE, "agent");
            xb_add(&bar[XB_XGEN(b.x)], 1u);
            asm volatile("s_waitcnt vmcnt(0)" ::: "memory");
        } else {
            XB_SPIN(xb_ld(&bar[XB_XGEN(b.x)]) == gen, bar);
            __builtin_amdgcn_fence(__ATOMIC_ACQUIRE, "agent");
            asm volatile("s_waitcnt vmcnt(0)" ::: "memory");
        }
    }
    __syncthreads();
}

__device__ __forceinline__ void transpose_item(const float* W, int K, int N, u16* WT, LAS float* scr, int item, int lane) {
    const int nblk = N / 32, kb = item / nblk, nb = item % nblk, k0 = 64 * kb, n0 = 32 * nb;
#pragma unroll 8
    for (int i = 0; i < 32; ++i) { const int kk = 2 * i + (lane >> 5); scr[kk * 33 + (lane & 31)] = W[(size_t)(k0 + kk) * N + n0 + (lane & 31)]; }
    LDS_WAIT(); asm volatile("" ::: "memory");
    const int c = lane & 7;
#pragma unroll
    for (int j = 0; j < 4; ++j) { const int n = (lane >> 3) + 8 * j; const LAS float* s = scr + (8 * c) * 33 + n;
        u32x4 o; o.x = pk2(s[0 * 33], s[1 * 33]); o.y = pk2(s[2 * 33], s[3 * 33]); o.z = pk2(s[4 * 33], s[5 * 33]); o.w = pk2(s[6 * 33], s[7 * 33]);
        *(u32x4*)(WT + (size_t)(n0 + n) * K + k0 + 8 * c) = o; }
    LDS_WAIT(); asm volatile("" ::: "memory");
}
__device__ __forceinline__ void convert_weights(const float* w0, int K0, int N0, u16* o0, const float* w1, int K1, int N1, u16* o1, const float* w2, int K2, int N2, u16* o2,
                                                const float* w3, int K3, int N3, u16* o3, LAS float* scr, int gw, int NGW, int lane) {
    const int I0 = (K0 / 64) * (N0 / 32), I1 = (K1 / 64) * (N1 / 32), I2 = (K2 / 64) * (N2 / 32), I3 = (K3 / 64) * (N3 / 32);
    for (int it = gw; it < I0 + I1 + I2 + I3; it += NGW) {
        int r = it;
        if (r < I0) { transpose_item(w0, K0, N0, o0, scr, r, lane); continue; } r -= I0;
        if (r < I1) { transpose_item(w1, K1, N1, o1, scr, r, lane); continue; } r -= I1;
        if (r < I2) { transpose_item(w2, K2, N2, o2, scr, r, lane); continue; } r -= I2;
        transpose_item(w3, K3, N3, o3, scr, r, lane);
    }
}
__device__ __forceinline__ void norm_rows(const float* x, const float* g, const float* ada, u16* hn, int gw, int NGW, int lane) {
    for (int m = gw; m < M; m += NGW) {
        const int b = m >> 13;
        const f32x4* xr = (const f32x4*)(x + (size_t)m * D) + lane;
        f32x4 v[4]; float s = 0.f;
#pragma unroll
        for (int j = 0; j < 4; ++j) { v[j] = xr[64 * j]; s += (v[j].x * v[j].x + v[j].y * v[j].y) + (v[j].z * v[j].z + v[j].w * v[j].w); }
        const float r = 1.0f / sqrtf(wave_sum(s) * (1.0f / D) + NORM_EPS);
        u32x2* o8 = (u32x2*)(hn + (size_t)m * D) + lane;
#pragma unroll
        for (int j = 0; j < 4; ++j) { const int c = 4 * (lane + 64 * j);
            const f32x4 gg = *(const f32x4*)(g + c), sh = *(const f32x4*)(ada + b * 3 * D + c), sc = *(const f32x4*)(ada + b * 3 * D + D + c);
            const f32x4 y = v[j] * r * gg * (sc + 1.0f) + sh;
            u32x2 w; w.x = pk2(y.x, y.y); w.y = pk2(y.z, y.w); o8[64 * j] = w; }
    }
}
__device__ __forceinline__ void final_norm_rows(float* x, const float* g, int gw, int NGW, int lane) {
    for (int m = gw; m < M; m += NGW) {
        f32x4* xr = (f32x4*)(x + (size_t)m * D) + lane;
        f32x4 v[4]; float s = 0.f;
#pragma unroll
        for (int j = 0; j < 4; ++j) { v[j] = xr[64 * j]; s += (v[j].x * v[j].x + v[j].y * v[j].y) + (v[j].z * v[j].z + v[j].w * v[j].w); }
        const float r = 1.0f / sqrtf(wave_sum(s) * (1.0f / D) + NORM_EPS);
#pragma unroll
        for (int j = 0; j < 4; ++j) { const f32x4 gg = *(const f32x4*)(g + 4 * (lane + 64 * j)); xr[64 * j] = v[j] * r * gg; }
    }
}

__device__ __forceinline__ void phase_p0(const float* cin, const float* ada_w, const float* ada_b, float* ADA,
                                         const float* fwin, const float* fwmid, const float* fb, const float* ffreq, float* HDN, const float* fwout, float* WOT,
                                         LAS unsigned char* lds, int tid, int blk, int G) {
    for (int i = blk * 512 + tid; i < 2 * 2 * D * FW; i += G * 512) { const int w = i & 63, col = (i >> 6) & (2 * D - 1), j = i >> 17; WOT[i] = fwout[(size_t)(j * FW + w) * 2 * D + col]; }
    LAS float* sc = (LAS float*)lds;
    LAS float* red = sc + 2048;
    for (int i = tid; i < 2 * D; i += 512) sc[i] = siluf_(cin[i]);
    __syncthreads();
    {
        const int cl = tid & 31, ks = tid >> 5;
        for (int gidx = blk; gidx < 8 * 96; gidx += G) {
            const int mat = gidx / 96, col0 = (gidx % 96) * 32;
            const float* w = ada_w + (size_t)mat * D * 3 * D + col0 + cl;
            float a0 = 0.f, a1 = 0.f;
#pragma unroll 8
            for (int k = ks * 64; k < ks * 64 + 64; ++k) { const float wv = w[(size_t)k * 3 * D]; a0 += sc[k] * wv; a1 += sc[D + k] * wv; }
            red[(ks * 2 + 0) * 32 + cl] = a0; red[(ks * 2 + 1) * 32 + cl] = a1;
            __syncthreads();
            if (tid < 64) { const int b = tid >> 5; float s = ada_b[mat * 3 * D + col0 + cl];
                for (int k2 = 0; k2 < 16; ++k2) s += red[(k2 * 2 + b) * 32 + cl];
                ADA[(size_t)(mat * 2 + b) * 3 * D + col0 + cl] = s; }
            __syncthreads();
        }
    }
    {
        LAS float* emb = (LAS float*)lds + 4096;
        LAS float* hA = emb + 8 * 36;
        LAS float* hB = hA + 512;
        for (int it = blk; it < 2 * (SEQ / 8); it += G) {
            const int j = it / (SEQ / 8), t0 = (it % (SEQ / 8)) * 8;
            if (tid < 8 * EMB) { const int tl = tid / EMB, e = tid % EMB, t = t0 + tl; float val;
                if (e == 0) val = (float)t / (float)(SEQ - 1);
                else { const int bi = (e - 1) & 15; const float band = 1e-4f + (float)bi * ((15.0f - 1e-4f) / 15.0f);
                    float rv = (float)t * band * (1.0f / SEQ); rv = rv - floorf(rv); val = (e <= 16) ? cos_rev(rv) : -sin_rev(rv); }
                emb[tl * 36 + e] = val; }
            __syncthreads();
            const int tl = tid >> 6, w = tid & 63;
            const float fq_ = ffreq[j * FW + w];
            float a = fb[(j * 3 + 0) * FW + w];
            for (int e = 0; e < EMB; ++e) a += emb[tl * 36 + e] * fwin[(size_t)(j * EMB + e) * FW + w];
            hA[tl * 64 + w] = fast_sin(fq_ * a);
            __syncthreads();
            a = fb[(j * 3 + 1) * FW + w];
            for (int v = 0; v < FW; ++v) a += hA[tl * 64 + v] * fwmid[(size_t)((j * 2 + 0) * FW + v) * FW + w];
            hB[tl * 64 + w] = fast_sin(fq_ * a);
            __syncthreads();
            a = fb[(j * 3 + 2) * FW + w];
            for (int v = 0; v < FW; ++v) a += hB[tl * 64 + v] * fwmid[(size_t)((j * 2 + 1) * FW + v) * FW + w];
            HDN[((size_t)j * FW + w) * SEQ + t0 + tl] = fast_sin(fq_ * a);
            __syncthreads();
        }
    }
}
__device__ __forceinline__ void filter_gen(const float* HDNj  , const float* WOTj  , float* FT, int tid, int blk, int G) {
    for (int it = blk; it < 64 * 16; it += G) {
        const int cb = it >> 4, tb = it & 15, t = tb * 512 + tid;
        float hv[64]; int wl[32];
#pragma unroll
        for (int c = 0; c < 32; ++c) wl[c] = __builtin_bit_cast(int, WOTj[(size_t)(cb * 32 + c) * FW + (tid & 63)]);
#pragma unroll
        for (int i = 0; i < 64; ++i) hv[i] = HDNj[(size_t)i * SEQ + t];
        const float tn = (float)t / (float)(SEQ - 1);
#pragma unroll
        for (int c = 0; c < 32; ++c) {
            const int col = cb * 32 + c, ch = col & (D - 1);
            float a = 0.f;
#pragma unroll
            for (int i = 0; i < 64; ++i) a += hv[i] * __builtin_bit_cast(float, __builtin_amdgcn_readlane(wl[c], i));
            const float delta = fabsf(HY_MIN_DECAY + (float)ch * ((HY_MAX_DECAY - HY_MIN_DECAY) / (float)(D - 1)));
            FT[(size_t)col * SEQ + t] = a * __expf(-tn * delta);
        }
    }
}

constexpr int S1_PV = 272, S1_PG = 48;
constexpr int S1_VL = 0, S1_GL = 2 * 64 * S1_PV, S1_KA = S1_GL + 2 * 64 * S1_PG, S1_SEG = S1_KA + 2 * 64 * 16, S1_ET = S1_SEG + 8 * 16 * 4, S1_END = S1_ET + 64;
typedef unsigned short u16x4v __attribute__((ext_vector_type(4)));
__device__ __forceinline__ void hg_scan1(const u16* GF, const u16* GB, const u16* V, u16* Sbuf, LAS unsigned char* lds, int tid, int blk, int G) {
    const int lane = tid & 63, wv = __builtin_amdgcn_readfirstlane(tid >> 6);
    const int q4 = lane >> 4, r16 = lane & 15;
    LAS float* SEGS = (LAS float*)(lds + S1_SEG); LAS float* ET = (LAS float*)(lds + S1_ET);
    for (int wi = blk; wi < 256; wi += G) {
        const int n = wi >> 6, h = (wi >> 3) & 7, ds = wi & 7, dir = n >> 1, b = n & 1;
        const int vrow = tid >> 3, vch = (tid & 7) * 2, grow = (tid >> 1) & 63, gch = tid & 1;
        const u16* Vg = V + ((size_t)b * SEQ + vrow) * D + h * DV + vch * 8;
        const u16* Gg = (dir ? GB : GF) + ((size_t)b * SEQ + grow) * D + h * DK + ds * 16 + gch * 8;
        u16* Sp = Sbuf + (size_t)(n * NH + h) * NCH * (DV * DK) + (size_t)(wv * 16 + r16) * DK + ds * 16 + 4 * q4;
        const unsigned vl_w = S1_VL + vrow * S1_PV + vch * 16, gl_w = S1_GL + grow * S1_PG + gch * 16;
        const int tp = tid >> 4, dkp = tid & 15;
        const unsigned gl_r = S1_GL + (2 * tp) * S1_PG + dkp * 2;
        const int t0 = 2 * tp, ka_w = S1_KA + (((t0 >> 5) * 64 + ((t0 & 31) >> 3) * 16 + dkp) * 8 + (t0 & 7)) * 2;
        const unsigned tr_a = S1_VL + (8 * q4 + (r16 >> 2)) * S1_PV + (16 * wv + 4 * (r16 & 3)) * 2;
        f32x4 S = (f32x4){0.f, 0.f, 0.f, 0.f};
        u32x4 av0, av1, ag, bv0, bv1, bg;
#define S1_LOAD(v0, v1, g, stp) do { const size_t co_ = (size_t)(dir ? (NCH - 1 - (stp)) : (stp)) * CH * D; v0 = *(const u32x4*)(Vg + co_); v1 = *(const u32x4*)(Vg + co_ + 8); g = *(const u32x4*)(Gg + co_); } while (0)
#define S1_STAGE(v0, v1, g, po) do { *(LAS u32x4*)(lds + vl_w + (po) * (64 * S1_PV)) = v0; *(LAS u32x4*)(lds + vl_w + (po) * (64 * S1_PV) + 16) = v1; if (tid < 128) *(LAS u32x4*)(lds + gl_w + (po) * (64 * S1_PG)) = g; } while (0)
        S1_LOAD(bv0, bv1, bg, 0); S1_STAGE(bv0, bv1, bg, 0);
        S1_LOAD(av0, av1, ag, 1); S1_LOAD(bv0, bv1, bg, 2);
        __syncthreads();
#define S1_STEP(step, p, v0, v1, g) do { \
            const int c = dir ? (NCH - 1 - (step)) : (step); \
            const float g0 = h2f(*(const LAS u16*)(lds + gl_r + (p) * (64 * S1_PG))), g1 = h2f(*(const LAS u16*)(lds + gl_r + (p) * (64 * S1_PG) + S1_PG)); \
            const float ps = g0 + g1; \
            const float p0 = __shfl(ps, r16), p1 = __shfl(ps, r16 + 16), p2 = __shfl(ps, r16 + 32), p3 = __shfl(ps, r16 + 48); \
            if (q4 == 0) SEGS[wv * 16 + dkp] = (p0 + p1) + (p2 + p3); \
            float w0, w1; \
            if (dir == 0) { const float aft = (q4 < 1 ? p1 : 0.f) + (q4 < 2 ? p2 : 0.f) + (q4 < 3 ? p3 : 0.f); w1 = aft; w0 = aft + g1; } \
            else          { const float bef = (q4 > 0 ? p0 : 0.f) + (q4 > 1 ? p1 : 0.f) + (q4 > 2 ? p2 : 0.f); w0 = bef; w1 = bef + g0; } \
            __syncthreads(); \
            if ((step) + 1 < NCH) S1_STAGE(v0, v1, g, (p) ^ 1);              \
            if ((step) + 3 < NCH) S1_LOAD(v0, v1, g, (step) + 3);            \
            { float tot = 0.f, off = 0.f; \
              _Pragma("unroll") for (int s2 = 0; s2 < 8; ++s2) { const float sg2 = SEGS[s2 * 16 + dkp]; tot += sg2; off += (dir ? (s2 < wv) : (s2 > wv)) ? sg2 : 0.f; } \
              const float k0 = (1.0f - __expf(g0)) * __expf(w0 + off), k1 = (1.0f - __expf(g1)) * __expf(w1 + off); \
              *(LAS unsigned*)(lds + ka_w) = pk2(k0, k1); \
              if (tid < 16) ET[dkp] = __expf(tot); } \
            __syncthreads(); \
            { u32x2 w; w.x = pk2(S[0], S[1]); w.y = pk2(S[2], S[3]); *(u32x2*)(Sp + (size_t)c * (DV * DK)) = w; } \
            const bf16x8 fa0 = *(const LAS bf16x8*)(lds + S1_KA + lane * 16), fa1 = *(const LAS bf16x8*)(lds + S1_KA + 1024 + lane * 16); \
            const f32x4 et = *(const LAS f32x4*)(ET + 4 * q4); \
            u16x4v r0, r1, r2, r3; \
            asm volatile("ds_read_b64_tr_b16 %0, %4\n\tds_read_b64_tr_b16 %1, %4 offset:1088\n\tds_read_b64_tr_b16 %2, %4 offset:8704\n\tds_read_b64_tr_b16 %3, %4 offset:9792\n\ts_waitcnt lgkmcnt(0)" \
                         : "=&v"(r0), "=&v"(r1), "=&v"(r2), "=&v"(r3) : "v"(tr_a + (p) * (64 * S1_PV)) : "memory"); \
            bf16x8 fb0, fb1; \
            _Pragma("unroll") for (int j = 0; j < 4; ++j) { fb0[j] = (short)r0[j]; fb0[4 + j] = (short)r1[j]; fb1[j] = (short)r2[j]; fb1[4 + j] = (short)r3[j]; } \
            S = S * et; \
            S = __builtin_amdgcn_mfma_f32_16x16x32_bf16(fa0, fb0, S, 0, 0, 0); \
            S = __builtin_amdgcn_mfma_f32_16x16x32_bf16(fa1, fb1, S, 0, 0, 0); } while (0)
#pragma unroll 1
        for (int step = 0; step < NCH; step += 2) {
            S1_STEP(step, 0, av0, av1, ag);
            S1_STEP(step + 1, 1, bv0, bv1, bg);
        }
#undef S1_STEP
#undef S1_LOAD
#undef S1_STAGE
        __syncthreads();
    }
}

constexpr int HO_LD = 136;
constexpr int HO_LV = 72;
constexpr int HO_QF = 0, HO_KF = 64 * HO_LD * 2, HO_KB = 2 * HO_KF, HO_QB = 3 * HO_KF, HO_VT = 4 * HO_KF, HO_AT = HO_VT + 128 * HO_LV * 2, HO_SEG = HO_AT + 64 * HO_LV * 2, HO_SSQ = HO_SEG + 2 * 4 * 128 * 4, HO_END = HO_SSQ + 64 * 8 * 4;
static_assert(HO_END <= RING_BYTES, "hg_out LDS");
__device__ __forceinline__ void hg_out(const u16* Qb, const u16* Vb, const u16* GTb, const u16* GF, const u16* GB, const u16* Sbuf, const float* hgn  , u16* ON,
                                       LAS unsigned char* lds, int tid, int blk, int G) {
    const int lane = tid & 63, wv = __builtin_amdgcn_readfirstlane(tid >> 6), q4 = lane >> 4, r16 = lane & 15;
    LAS u16* QF = (LAS u16*)(lds + HO_QF); LAS u16* KF = (LAS u16*)(lds + HO_KF); LAS u16* KBt = (LAS u16*)(lds + HO_KB); LAS u16* QBt = (LAS u16*)(lds + HO_QB);
    LAS u16* VT = (LAS u16*)(lds + HO_VT); LAS u16* AT = (LAS u16*)(lds + HO_AT); LAS float* SEG = (LAS float*)(lds + HO_SEG); LAS float* SSQ = (LAS float*)(lds + HO_SSQ);
    const int lrow = tid >> 3, lch = (tid & 7) * 16;
    const unsigned l_off = lrow * (HO_LD * 2) + lch * 2;
    const int NIT = NB * NH * NCH;
    u32x4 pq0, pq1, pf0, pf1, pb0, pb1, pv0, pv1;
#define HO_ITEM(it_, b_, h_, c_) const int b_ = (it_) / (NH * NCH), h_ = ((it_) / NCH) % NH, c_ = (it_) % NCH
#define HO_PREFETCH(it_) do { HO_ITEM(it_, b_, h_, c_); const size_t go_ = ((size_t)b_ * SEQ + (size_t)c_ * CH + lrow) * D + h_ * DK + lch; \
        pq0 = *(const u32x4*)(Qb + go_); pq1 = *(const u32x4*)(Qb + go_ + 8); pf0 = *(const u32x4*)(GF + go_); pf1 = *(const u32x4*)(GF + go_ + 8); \
        pb0 = *(const u32x4*)(GB + go_); pb1 = *(const u32x4*)(GB + go_ + 8); pv0 = *(const u32x4*)(Vb + go_); pv1 = *(const u32x4*)(Vb + go_ + 8); } while (0)
    if (blk < NIT) HO_PREFETCH(blk);
    for (int it = blk; it < NIT; it += G) {
        HO_ITEM(it, b, h, c);
        const size_t m0 = (size_t)b * SEQ + (size_t)c * CH;
        *(LAS u32x4*)(lds + HO_QF + l_off) = pq0; *(LAS u32x4*)(lds + HO_QF + l_off + 16) = pq1; *(LAS u32x4*)(lds + HO_KF + l_off) = pf0; *(LAS u32x4*)(lds + HO_KF + l_off + 16) = pf1;
        *(LAS u32x4*)(lds + HO_KB + l_off) = pb0; *(LAS u32x4*)(lds + HO_KB + l_off + 16) = pb1; *(LAS u32x4*)(lds + HO_QB + l_off) = pv0; *(LAS u32x4*)(lds + HO_QB + l_off + 16) = pv1;
        const size_t go = (m0 + lrow) * D + h * DV + lch;
        const u32x4 gt0 = *(const u32x4*)(GTb + go), gt1 = *(const u32x4*)(GTb + go + 8);
        bf16x8 sfr[4], sbr[4];
        { const u16* Sf = Sbuf + ((size_t)((0 * 2 + b) * NH + h) * NCH + c) * (DV * DK) + (size_t)(16 * wv + r16) * DK + 8 * q4;
          const u16* Sb = Sbuf + ((size_t)((1 * 2 + b) * NH + h) * NCH + c) * (DV * DK) + (size_t)(16 * wv + r16) * DK + 8 * q4;
#pragma unroll
          for (int kk = 0; kk < 4; ++kk) { sfr[kk] = *(const bf16x8*)(Sf + 32 * kk); sbr[kk] = *(const bf16x8*)(Sb + 32 * kk); } }
        if (it + G < NIT) HO_PREFETCH(it + G);
        __syncthreads();
        {
            const int d = tid & 127, ts = tid >> 7;
            float gf[16], gb[16], qv[16]; unsigned vv[16];
#pragma unroll
            for (int j = 0; j < 16; ++j) { const int o = (16 * ts + j) * HO_LD + d; qv[j] = bf2f(QF[o]); gf[j] = h2f(KF[o]); gb[j] = h2f(KBt[o]); vv[j] = QBt[o]; }
            { u32x4 w0, w1; w0.x = vv[0] | (vv[1] << 16); w0.y = vv[2] | (vv[3] << 16); w0.z = vv[4] | (vv[5] << 16); w0.w = vv[6] | (vv[7] << 16);
              w1.x = vv[8] | (vv[9] << 16); w1.y = vv[10] | (vv[11] << 16); w1.z = vv[12] | (vv[13] << 16); w1.w = vv[14] | (vv[15] << 16);
              *(LAS u32x4*)(VT + d * HO_LV + 16 * ts) = w0; *(LAS u32x4*)(VT + d * HO_LV + 16 * ts + 8) = w1; }
            float pf[16], sb[16];
            { float r = 0.f;
#pragma unroll
              for (int j = 0; j < 16; ++j) { r += gf[j]; pf[j] = r; }
              SEG[(0 * 4 + ts) * 128 + d] = r; r = 0.f;
#pragma unroll
              for (int j = 15; j >= 0; --j) { r += gb[j]; sb[j] = r; }
              SEG[(1 * 4 + ts) * 128 + d] = r; }
            __syncthreads();
            float offf = 0.f, offb = 0.f;
#pragma unroll
            for (int s2 = 0; s2 < 4; ++s2) { const float a = SEG[(0 * 4 + s2) * 128 + d], bb = SEG[(1 * 4 + s2) * 128 + d]; offf += (s2 < ts) ? a : 0.f; offb += (s2 > ts) ? bb : 0.f; }
#pragma unroll
            for (int j = 0; j < 16; ++j) {
                const float bf_ = offf + pf[j], bb_ = offb + sb[j];
                const float kf = 1.0f - __expf(gf[j]), kb = 1.0f - __expf(gb[j]);
                const int o = (16 * ts + j) * HO_LD + d;
                QF[o] = (u16)f2bf(qv[j] * __expf(bf_)); KF[o] = (u16)f2bf(kf * __expf(fminf(-bf_, 80.f)));
                QBt[o] = (u16)f2bf(qv[j] * __expf(bb_)); KBt[o] = (u16)f2bf(kb * __expf(fminf(-bb_, 80.f)));
            }
        }
        __syncthreads();
#pragma unroll 1
        for (int tt = 0; tt < 2; ++tt) {
            const int tile = 2 * wv + tt, ti = tile >> 2, si = tile & 3;
            f32x4 af = (f32x4){0.f, 0.f, 0.f, 0.f}, ab = (f32x4){0.f, 0.f, 0.f, 0.f};
            if (ti >= si) {
#pragma unroll
                for (int kk = 0; kk < 4; ++kk) { const bf16x8 a = *(const LAS bf16x8*)(QF + (16 * ti + r16) * HO_LD + 32 * kk + 8 * q4), bb = *(const LAS bf16x8*)(KF + (16 * si + r16) * HO_LD + 32 * kk + 8 * q4);
                    af = __builtin_amdgcn_mfma_f32_16x16x32_bf16(a, bb, af, 0, 0, 0); }
            }
            if (ti <= si) {
#pragma unroll
                for (int kk = 0; kk < 4; ++kk) { const bf16x8 a = *(const LAS bf16x8*)(QBt + (16 * ti + r16) * HO_LD + 32 * kk + 8 * q4), bb = *(const LAS bf16x8*)(KBt + (16 * si + r16) * HO_LD + 32 * kk + 8 * q4);
                    ab = __builtin_amdgcn_mfma_f32_16x16x32_bf16(a, bb, ab, 0, 0, 0); }
            }
#pragma unroll
            for (int r = 0; r < 4; ++r) { const int t = 16 * ti + 4 * q4 + r, s = 16 * si + r16;
                const float vsum = (s <= t ? af[r] : 0.f) + (s >= t ? ab[r] : 0.f);
                AT[t * HO_LV + s] = (u16)f2bf(vsum); }
        }
        __syncthreads();
        f32x4 o[4];
#pragma unroll
        for (int ti = 0; ti < 4; ++ti) o[ti] = (f32x4){0.f, 0.f, 0.f, 0.f};
        {
#pragma unroll
            for (int kk = 0; kk < 2; ++kk) { const bf16x8 bv = *(const LAS bf16x8*)(VT + (16 * wv + r16) * HO_LV + 32 * kk + 8 * q4);
#pragma unroll
                for (int ti = 0; ti < 4; ++ti) { const bf16x8 a = *(const LAS bf16x8*)(AT + (16 * ti + r16) * HO_LV + 32 * kk + 8 * q4); o[ti] = __builtin_amdgcn_mfma_f32_16x16x32_bf16(a, bv, o[ti], 0, 0, 0); } }
#pragma unroll
            for (int kk = 0; kk < 4; ++kk) {
#pragma unroll
                for (int ti = 0; ti < 4; ++ti) { const bf16x8 a = *(const LAS bf16x8*)(QF + (16 * ti + r16) * HO_LD + 32 * kk + 8 * q4); o[ti] = __builtin_amdgcn_mfma_f32_16x16x32_bf16(a, sfr[kk], o[ti], 0, 0, 0);
                    const bf16x8 a2 = *(const LAS bf16x8*)(QBt + (16 * ti + r16) * HO_LD + 32 * kk + 8 * q4); o[ti] = __builtin_amdgcn_mfma_f32_16x16x32_bf16(a2, sbr[kk], o[ti], 0, 0, 0); } }
        }
#pragma unroll
        for (int ti = 0; ti < 4; ++ti)
#pragma unroll
            for (int r = 0; r < 4; ++r) { float s = o[ti][r] * o[ti][r]; s += __shfl_xor(s, 1); s += __shfl_xor(s, 2); s += __shfl_xor(s, 4); s += __shfl_xor(s, 8);
                if (r16 == 0) SSQ[(16 * ti + 4 * q4 + r) * 8 + wv] = s; }
        __syncthreads();
        {
            const int dv = 16 * wv + r16; const float gn = hgn[dv];
#pragma unroll
            for (int ti = 0; ti < 4; ++ti)
#pragma unroll
                for (int r = 0; r < 4; ++r) { const int t = 16 * ti + 4 * q4 + r; const LAS f32x4* sp = (const LAS f32x4*)(SSQ + t * 8); const f32x4 s0 = sp[0], s1 = sp[1];
                    const float ss = (s0.x + s0.y + s0.z + s0.w) + (s1.x + s1.y + s1.z + s1.w);
                    const float rn = 1.0f / sqrtf(ss * (1.0f / DV) + NORM_EPS);
                    QF[t * HO_LD + dv] = (u16)f2bf(o[ti][r] * rn * gn); }
        }
        __syncthreads();
        {
            const u32x4 o0 = *(const LAS u32x4*)(lds + HO_QF + l_off), o1 = *(const LAS u32x4*)(lds + HO_QF + l_off + 16);
            u32x4 w0, w1;
#pragma unroll
            for (int i = 0; i < 4; ++i) { w0[i] = pk2(bf2f(o0[i] & 0xffffu) * bf2f(gt0[i] & 0xffffu), bf2f(o0[i] >> 16) * bf2f(gt0[i] >> 16));
                                          w1[i] = pk2(bf2f(o1[i] & 0xffffu) * bf2f(gt1[i] & 0xffffu), bf2f(o1[i] >> 16) * bf2f(gt1[i] >> 16)); }
            *(u32x4*)(ON + go) = w0; *(u32x4*)(ON + go + 8) = w1;
        }
        __syncthreads();
    }
#undef HO_ITEM
#undef HO_PREFETCH
}

__device__ __forceinline__ void hy_zprep(const u16* U, const float* cw  , const float* cbias  , f32x2* ZT, LAS unsigned char* lds, int tid, int blk, int G) {
    LAS float* zt = (LAS float*)lds;
    for (int it = blk; it < (SEQ / 64) * (D / 64); it += G) {
        const int tb = it >> 4, cbk = it & 15, t0 = tb * 64, c0 = cbk * 64;
        const int ch = tid & 63, tq = tid >> 6, c = c0 + ch;
        const float a0 = cw[0 * 3 * D + D + c], a1 = cw[1 * 3 * D + D + c], a2 = cw[2 * 3 * D + D + c], ab = cbias[D + c];
        const float v0 = cw[0 * 3 * D + 2 * D + c], v1 = cw[1 * 3 * D + 2 * D + c], v2 = cw[2 * 3 * D + 2 * D + c], vb = cbias[2 * D + c];
#pragma unroll
        for (int b = 0; b < 2; ++b) {
            float u1[10], uv[10];
#pragma unroll
            for (int i = 0; i < 10; ++i) { const int tt = t0 + tq * 8 - 1 + i; const bool ok = (tt >= 0) && (tt < SEQ);
                const size_t ro = ((size_t)b * SEQ + (ok ? tt : 0)) * (3 * D);
                u1[i] = ok ? bf2f(U[ro + D + c]) : 0.f; uv[i] = ok ? bf2f(U[ro + 2 * D + c]) : 0.f; }
#pragma unroll
            for (int i = 0; i < 8; ++i) { const float x1c = u1[i] * a0 + u1[i + 1] * a1 + u1[i + 2] * a2 + ab, vc = uv[i] * v0 + uv[i + 1] * v1 + uv[i + 2] * v2 + vb;
                zt[(ch * 65 + tq * 8 + i) * 2 + b] = x1c * vc; }
        }
        __syncthreads();
        { const int tt = tid & 63;
#pragma unroll
          for (int r = 0; r < 8; ++r) { const int chh = (tid >> 6) + 8 * r; f32x2 v; v.x = zt[(chh * 65 + tt) * 2]; v.y = zt[(chh * 65 + tt) * 2 + 1]; ZT[(size_t)(c0 + chh) * SEQ + t0 + tt] = v; } }
        __syncthreads();
    }
}
__device__ __forceinline__ void hy_gate(const u16* U, const float* cw, const float* cbias, const f32x2* YT, u16* YG, LAS unsigned char* lds, int tid, int blk, int G) {
    LAS float* zt = (LAS float*)lds;
    for (int it = blk; it < (SEQ / 64) * (D / 64); it += G) {
        const int tb = it >> 4, cbk = it & 15, t0 = tb * 64, c0 = cbk * 64;
        { const int tt = tid & 63;
#pragma unroll
          for (int r = 0; r < 8; ++r) { const int chh = (tid >> 6) + 8 * r; const f32x2 v = YT[(size_t)(c0 + chh) * SEQ + t0 + tt]; zt[(chh * 65 + tt) * 2] = v.x; zt[(chh * 65 + tt) * 2 + 1] = v.y; } }
        __syncthreads();
        const int ch = tid & 63, tq = tid >> 6, c = c0 + ch;
        const float a0 = cw[0 * 3 * D + c], a1 = cw[1 * 3 * D + c], a2 = cw[2 * 3 * D + c], ab = cbias[c];
#pragma unroll
        for (int b = 0; b < 2; ++b) {
            float u0[10];
#pragma unroll
            for (int i = 0; i < 10; ++i) { const int tt = t0 + tq * 8 - 1 + i; const bool ok = (tt >= 0) && (tt < SEQ);
                const size_t ro = ((size_t)b * SEQ + (ok ? tt : 0)) * (3 * D); u0[i] = ok ? bf2f(U[ro + c]) : 0.f; }
#pragma unroll
            for (int i = 0; i < 8; ++i) { const float x0c = u0[i] * a0 + u0[i + 1] * a1 + u0[i + 2] * a2 + ab;
                YG[((size_t)b * SEQ + t0 + tq * 8 + i) * D + c] = (u16)f2bf(x0c * zt[(ch * 65 + tq * 8 + i) * 2 + b]); }
        }
        __syncthreads();
    }
}
__device__ __forceinline__ int fpad(int e) { return e + ((e >> 6) << 2); }
__device__ __forceinline__ f32x2 cmul(f32x2 a, f32x2 b) { f32x2 r; r.x = a.x * b.x - a.y * b.y; r.y = a.x * b.y + a.y * b.x; return r; }
__device__ __forceinline__ f32x2 cmulc(f32x2 a, f32x2 b) { f32x2 r; r.x = a.x * b.x + a.y * b.y; r.y = a.y * b.x - a.x * b.y; return r; }
template <bool INV> __device__ __forceinline__ void radix4(f32x2& a0, f32x2& a1, f32x2& a2, f32x2& a3) {
    const f32x2 t0 = a0 + a2, t1 = a0 - a2, t2 = a1 + a3, t3 = a1 - a3;
    a0 = t0 + t2; a2 = t0 - t2;
    if (!INV) { a1.x = t1.x + t3.y; a1.y = t1.y - t3.x; a3.x = t1.x - t3.y; a3.y = t1.y + t3.x; }
    else      { a1.x = t1.x - t3.y; a1.y = t1.y + t3.x; a3.x = t1.x + t3.y; a3.y = t1.y - t3.x; }
}
template <bool INV> __device__ __forceinline__ void dft16(f32x2 (&x)[16]) {
    constexpr float C1 = 0.92387953251128674f, S1 = 0.38268343236508977f, R2 = 0.70710678118654752f;
#pragma unroll
    for (int b = 0; b < 4; ++b) radix4<INV>(x[b], x[4 + b], x[8 + b], x[12 + b]);
    const f32x2 W1 = {C1, -S1}, W2 = {R2, -R2}, W3 = {S1, -C1}, W4 = {0.f, -1.f}, W6 = {-R2, -R2}, W9 = {-C1, S1};
    if (!INV) { x[5] = cmul(x[5], W1); x[9] = cmul(x[9], W2); x[13] = cmul(x[13], W3); x[6] = cmul(x[6], W2); x[10] = cmul(x[10], W4); x[14] = cmul(x[14], W6); x[7] = cmul(x[7], W3); x[11] = cmul(x[11], W6); x[15] = cmul(x[15], W9); }
    else      { x[5] = cmulc(x[5], W1); x[9] = cmulc(x[9], W2); x[13] = cmulc(x[13], W3); x[6] = cmulc(x[6], W2); x[10] = cmulc(x[10], W4); x[14] = cmulc(x[14], W6); x[7] = cmulc(x[7], W3); x[11] = cmulc(x[11], W6); x[15] = cmulc(x[15], W9); }
#pragma unroll
    for (int c = 0; c < 4; ++c) radix4<INV>(x[4 * c], x[4 * c + 1], x[4 * c + 2], x[4 * c + 3]);
    f32x2 y[16];
#pragma unroll
    for (int c = 0; c < 4; ++c)
#pragma unroll
        for (int d = 0; d < 4; ++d) y[c + 4 * d] = x[4 * c + d];
#pragma unroll
    for (int i = 0; i < 16; ++i) x[i] = y[i];
}
template <bool CONJ> __device__ __forceinline__ void apply_twid(f32x2 (&x)[16], float f) {
    const f32x2 w1 = {cos_rev(f), -sin_rev(f)}, w8 = {cos_rev(8.f * f), -sin_rev(8.f * f)};
    f32x2 wc = w1;
#pragma unroll
    for (int m = 1; m < 16; ++m) { if (m == 8) wc = w8; x[m] = CONJ ? cmulc(x[m], wc) : cmul(x[m], wc); if (m != 7 && m != 15) wc = cmul(wc, w1); }
}
template <bool INV> __device__ __forceinline__ void fft_pass64(LAS f32x2* a, int tid) {
#pragma unroll 1
    for (int k = 0; k < 2; ++k) {
        const int u = tid + 512 * k, j = u & 63;
        LAS f32x2* p = a + (u >> 6) * 1088 + j;
        f32x2 x[16];
#pragma unroll
        for (int q = 0; q < 16; ++q) x[q] = p[68 * q];
        if (!INV) { dft16<false>(x); apply_twid<false>(x, (float)j * (1.0f / 1024.0f)); }
        else { apply_twid<true>(x, (float)j * (1.0f / 1024.0f)); dft16<true>(x); }
#pragma unroll
        for (int q = 0; q < 16; ++q) p[68 * q] = x[q];
    }
}
__device__ __forceinline__ void conv3_x8(const u16* urow, int t0, const float (&w)[4], float (&out)[8]) {
    const u32x4 r = *(const u32x4*)(urow + t0);
    const int tm = (t0 > 0) ? t0 - 1 : 0, tp = (t0 + 8 < SEQ) ? t0 + 8 : SEQ - 1;
    const float hm = bf2f(urow[tm]), hp = bf2f(urow[tp]);
    float e[10];
    e[0] = (t0 > 0) ? hm : 0.f; e[9] = (t0 + 8 < SEQ) ? hp : 0.f;
#pragma unroll
    for (int i = 0; i < 4; ++i) { e[1 + 2 * i] = bf2f(r[i] & 0xffffu); e[2 + 2 * i] = bf2f(r[i] >> 16); }
#pragma unroll
    for (int i = 0; i < 8; ++i) out[i] = e[i] * w[0] + e[i + 1] * w[1] + e[i + 2] * w[2] + w[3];
}
__device__ __forceinline__ void fft_stage_z(const u16* u1  , const u16* uv, const float (&w1)[4], const float (&wv)[4], LAS f32x2* a, int tid) {
#pragma unroll 1
    for (int k = 0; k < 2; ++k) {
        const int t0 = (tid + 512 * k) * 8;
        float a0[8], b0[8], a1[8], b1[8];
        conv3_x8(u1, t0, w1, a0); conv3_x8(uv, t0, wv, b0); conv3_x8(u1 + SEQ, t0, w1, a1); conv3_x8(uv + SEQ, t0, wv, b1);
        LAS f32x4* p = (LAS f32x4*)(a + t0 + ((t0 >> 6) << 2));
#pragma unroll
        for (int i = 0; i < 4; ++i) { f32x4 v; v.x = a0[2 * i] * b0[2 * i]; v.y = a1[2 * i] * b1[2 * i]; v.z = a0[2 * i + 1] * b0[2 * i + 1]; v.w = a1[2 * i + 1] * b1[2 * i + 1]; p[i] = v; }
    }
}
__device__ __forceinline__ void fft_p1_lds(LAS f32x2* a, int tid) {
#pragma unroll 1
    for (int k = 0; k < 2; ++k) {
        const int j = tid + 512 * k;
        LAS f32x2* p = a + j + ((j >> 6) << 2);
        f32x2 x[16];
#pragma unroll
        for (int q = 0; q < 8; ++q) x[q] = p[1088 * q];
#pragma unroll
        for (int q = 8; q < 16; ++q) x[q] = (f32x2){0.f, 0.f};
        dft16<false>(x); apply_twid<false>(x, (float)j * (1.0f / 16384.0f));
#pragma unroll
        for (int m = 0; m < 16; ++m) p[1088 * m] = x[m];
    }
}
__device__ __forceinline__ void fft_p1_filt(const float* hf, const float* hb, LAS f32x2* a, int tid) {
#pragma unroll 1
    for (int k = 0; k < 2; ++k) {
        const int j = tid + 512 * k;
        LAS f32x2* p = a + j + ((j >> 6) << 2);
        f32x2 x[16];
#pragma unroll
        for (int q = 0; q < 8; ++q) x[q] = (f32x2){hf[j + 1024 * q], 0.f};
#pragma unroll
        for (int q = 8; q < 16; ++q) { const int idx = 2 * SEQ - j - 1024 * q; x[q] = (f32x2){(idx < SEQ) ? hb[idx] : 0.f, 0.f}; }
        dft16<false>(x); apply_twid<false>(x, (float)j * (1.0f / 16384.0f));
#pragma unroll
        for (int m = 0; m < 16; ++m) p[1088 * m] = x[m];
    }
}
__device__ __forceinline__ void fft_last_inv_lds(LAS f32x2* a, int tid) {
#pragma unroll 1
    for (int k = 0; k < 2; ++k) {
        const int j = tid + 512 * k;
        LAS f32x2* p = a + j + ((j >> 6) << 2);
        f32x2 x[16];
#pragma unroll
        for (int m = 0; m < 16; ++m) x[m] = p[1088 * m];
        apply_twid<true>(x, (float)j * (1.0f / 16384.0f)); dft16<true>(x);
#pragma unroll
        for (int q = 0; q < 8; ++q) p[1088 * q] = x[q];
    }
}
__device__ __forceinline__ void fft_gate_out(const LAS f32x2* a, const u16* u0, const float (&w0)[4], u16* yg, int tid) {
#pragma unroll 1
    for (int k = 0; k < 2; ++k) {
        const int t0 = (tid + 512 * k) * 8;
        float g0[8], g1[8];
        conv3_x8(u0, t0, w0, g0); conv3_x8(u0 + SEQ, t0, w0, g1);
        const LAS f32x4* p = (const LAS f32x4*)(a + t0 + ((t0 >> 6) << 2));
        u32x4 o0, o1;
#pragma unroll
        for (int i = 0; i < 4; ++i) { const f32x4 v = p[i]; o0[i] = pk2(v.x * g0[2 * i], v.z * g0[2 * i + 1]); o1[i] = pk2(v.y * g1[2 * i], v.w * g1[2 * i + 1]); }
        *(u32x4*)(yg + t0) = o0; *(u32x4*)(yg + SEQ + t0) = o1;
    }
}
__device__ __forceinline__ float dpp_x2(float v) { return __builtin_bit_cast(float, __builtin_amdgcn_update_dpp(0, __builtin_bit_cast(int, v), 0x4E, 0xF, 0xF, false)); }
__device__ __forceinline__ float dpp_x1(float v) { return __builtin_bit_cast(float, __builtin_amdgcn_update_dpp(0, __builtin_bit_cast(int, v), 0xB1, 0xF, 0xF, false)); }
__device__ __forceinline__ f32x2 quad_fwd(f32x2 z, float s2, float s1, float rc, float rs) {
    f32x2 p; p.x = dpp_x2(z.x) + s2 * z.x; p.y = dpp_x2(z.y) + s2 * z.y;
    f32x2 r; r.x = rc * p.x + rs * p.y; r.y = rc * p.y - rs * p.x;
    f32x2 o; o.x = dpp_x1(r.x) + s1 * r.x; o.y = dpp_x1(r.y) + s1 * r.y;
    return o;
}
__device__ __forceinline__ f32x2 quad_inv(f32x2 o, float s2, float s1, float rc, float rs) {
    f32x2 p; p.x = dpp_x1(o.x) + s1 * o.x; p.y = dpp_x1(o.y) + s1 * o.y;
    f32x2 r; r.x = rc * p.x - rs * p.y; r.y = rc * p.y + rs * p.x;
    f32x2 z; z.x = dpp_x2(r.x) + s2 * r.x; z.y = dpp_x2(r.y) + s2 * r.y;
    return z;
}
__device__ __forceinline__ void fft_mid_filter(LAS f32x2* a, f32x2* Hg  , float skipv, int u) {
    const int j = u & 3;
    const float s2 = (j & 2) ? -1.f : 1.f, s1 = (j & 1) ? -1.f : 1.f, rc = (j == 3) ? 0.f : 1.f, rs = (j == 3) ? 1.f : 0.f;
    const LAS f32x2* p = a + (u >> 2) * 68 + j;
    f32x2 x[16];
#pragma unroll
    for (int q = 0; q < 16; ++q) x[q] = p[4 * q];
    dft16<false>(x); apply_twid<false>(x, (float)j * (1.0f / 64.0f));
#pragma unroll
    for (int m = 0; m < 16; ++m) { f32x2 v = quad_fwd(x[m], s2, s1, rc, rs); v = v * (1.0f / 16384.0f); v.x += skipv * (1.0f / 16384.0f); Hg[512 * m] = v; }
}
__device__ __forceinline__ void fft_mid_z(LAS f32x2* a, const f32x2* Hg, int u) {
    const int j = u & 3;
    const float s2 = (j & 2) ? -1.f : 1.f, s1 = (j & 1) ? -1.f : 1.f, rc = (j == 3) ? 0.f : 1.f, rs = (j == 3) ? 1.f : 0.f;
    LAS f32x2* p = a + (u >> 2) * 68 + j;
    f32x2 x[16], H[16];
#pragma unroll
    for (int m = 0; m < 16; ++m) H[m] = Hg[512 * m];
#pragma unroll
    for (int q = 0; q < 16; ++q) x[q] = p[4 * q];
    dft16<false>(x); apply_twid<false>(x, (float)j * (1.0f / 64.0f));
#pragma unroll
    for (int m = 0; m < 16; ++m) x[m] = quad_inv(cmul(quad_fwd(x[m], s2, s1, rc, rs), H[m]), s2, s1, rc, rs);
    apply_twid<true>(x, (float)j * (1.0f / 64.0f)); dft16<true>(x);
#pragma unroll
    for (int q = 0; q < 16; ++q) p[4 * q] = x[q];
}
constexpr int FFT_LDS_BYTES = (16384 + 1024) * 8;
__device__ __forceinline__ void hy_fftconv(const u16* UT  , const float* cw  , const float* cbias  , const float* FT, f32x2* HS, const float* skip, u16* YGT  ,
                                           LAS unsigned char* lds, int tid0, int blk, int G) {
    LAS f32x2* a = (LAS f32x2*)lds;
#define OPQT() ({ int _t = tid0; asm volatile("" : "+v"(_t)); _t; })
#pragma unroll 1
    for (int ch = blk; ch < D; ch += G) {
        { const int tid = OPQT(); fft_p1_filt(FT + (size_t)ch * SEQ, FT + (size_t)(D + ch) * SEQ, a, tid); }
        __syncthreads();
        { const int tid = OPQT(); fft_pass64<false>(a, tid); }
        __syncthreads();
        { const int tid = OPQT(); f32x2* hs = HS + (size_t)blk * 16384 + tid; const float sk = skip[ch]; fft_mid_filter(a, hs, sk, tid); }
        { const int tid = OPQT(); f32x2* hs = HS + (size_t)blk * 16384 + tid; const float sk = skip[ch]; fft_mid_filter(a, hs + 8192, sk, tid + 512); }
        __syncthreads();
        { const int tid = OPQT();
          const float w1[4] = {cw[0 * 3 * D + D + ch], cw[1 * 3 * D + D + ch], cw[2 * 3 * D + D + ch], cbias[D + ch]};
          const float wv[4] = {cw[0 * 3 * D + 2 * D + ch], cw[1 * 3 * D + 2 * D + ch], cw[2 * 3 * D + 2 * D + ch], cbias[2 * D + ch]};
          fft_stage_z(UT + (size_t)(D + ch) * M, UT + (size_t)(2 * D + ch) * M, w1, wv, a, tid); }
        __syncthreads();
        { const int tid = OPQT(); fft_p1_lds(a, tid); }
        __syncthreads();
        { const int tid = OPQT(); fft_pass64<false>(a, tid); }
        __syncthreads();
        { const int tid = OPQT(); const f32x2* hs = HS + (size_t)blk * 16384 + tid; fft_mid_z(a, hs, tid); }
        { const int tid = OPQT(); const f32x2* hs = HS + (size_t)blk * 16384 + tid; fft_mid_z(a, hs + 8192, tid + 512); }
        __syncthreads();
        { const int tid = OPQT(); fft_pass64<true>(a, tid); }
        __syncthreads();
        { const int tid = OPQT(); fft_last_inv_lds(a, tid); }
        __syncthreads();
        { const int tid = OPQT();
          const float w0[4] = {cw[0 * 3 * D + ch], cw[1 * 3 * D + ch], cw[2 * 3 * D + ch], cbias[ch]};
          fft_gate_out(a, UT + (size_t)ch * M, w0, YGT + (size_t)ch * M, tid); }
        __syncthreads();
    }
#undef OPQT
}
__device__ __forceinline__ void transpose_cm(const u16* src, u16* dst, LAS unsigned char* lds, int tid, int blk, int G) {
    LAS u16* tile = (LAS u16*)lds;
    for (int it = blk; it < (D / 64) * (M / 64); it += G) {
        const int c0 = (it & 15) * 64, m0 = (it >> 4) * 64;
        { const int chl = tid >> 3, seg = tid & 7; const u32x4 v = *(const u32x4*)(src + (size_t)(c0 + chl) * M + m0 + seg * 8); *(LAS u32x4*)(tile + chl * 72 + seg * 8) = v; }
        __syncthreads();
        { const int ml = tid >> 3, cs = tid & 7; unsigned e[8];
#pragma unroll
          for (int i = 0; i < 8; ++i) e[i] = tile[(cs * 8 + i) * 72 + ml];
          u32x4 w; w.x = e[0] | (e[1] << 16); w.y = e[2] | (e[3] << 16); w.z = e[4] | (e[5] << 16); w.w = e[6] | (e[7] << 16);
          *(u32x4*)(dst + (size_t)(m0 + ml) * D + c0 + cs * 8) = w; }
        __syncthreads();
    }
}


#ifndef PROBE_KIND
#define PROBE_KIND 0
#endif
#define PH_BEGIN(kind) const unsigned long long _t0 = (PROBE_KIND == (kind)) ? __builtin_amdgcn_s_memrealtime() : 0ull
#define PH_END(kind) do { if (PROBE_KIND == (kind)) { __syncthreads(); const unsigned long long _dt = __builtin_amdgcn_s_memrealtime() - _t0; \
    while (__builtin_amdgcn_s_memrealtime() - _t0 < 2 * _dt) __builtin_amdgcn_s_sleep(8); } } while (0)
struct Args { const float* in[23]; float* out; unsigned char* ws; int ph_lo, ph_hi, li, pad; };

__global__ void __launch_bounds__(512, 2) mega_fwd(Args args) {
    extern __shared__ __attribute__((aligned(16))) unsigned char lds_raw[];
    LAS unsigned char* lds = (LAS unsigned char*)lds_raw;
    volatile LAS unsigned* MISC = (volatile LAS unsigned*)(lds + MISC_OFF);
    for (int u = threadIdx.x; u < (LDS_BYTES - LDSCTL_OFF) / 4; u += 512) ((LAS unsigned*)(lds + LDSCTL_OFF))[u] = 0u;
    __syncthreads();
    XcdBarrier bar; bar.bar = (unsigned*)(args.ws + WS_CTL) + CW_BAR + args.li * XCD_BAR_WORDS; bar.x = 0; bar.st = nullptr;
#if !MK_PER_PHASE
    bar = xcd_barrier_post((unsigned*)(args.ws + WS_CTL) + CW_BAR + args.li * XCD_BAR_WORDS, MISC + 8);
#endif
    const int lo = args.ph_lo, hi = args.ph_hi;
    int pc = 0;
#define RUN() (pc >= lo && pc < hi)
#if MK_PER_PHASE
#define SEAM() do { ++pc; } while (0)
#else
#define SEAM() do { ++pc; if (pc > lo && pc < hi) xcd_barrier(bar); } while (0)
#endif
#define COORDS() const int tid = opq_tid(), lane = tid & 63, wave = __builtin_amdgcn_readfirstlane(tid >> 6); const int G = opq_s((int)gridDim.x), blk = opq_s((int)blockIdx.x); \
                 const int gw = blk * 8 + wave, NGW = G * 8; unsigned char* ws = arg_ws(); (void)lane; (void)gw; (void)NGW; (void)ws
#define SCR() ((LAS float*)(lds + wave * 16384))

    if (RUN()) { COORDS(); PH_BEGIN(9); phase_p0(arg_in(1), arg_in(2), arg_in(3), (float*)(ws + WS_ADA), arg_in(13), arg_in(14), arg_in(15), arg_in(16), (float*)(ws + WS_HDN), arg_in(17), (float*)(ws + WS_WOT), lds, tid, blk, G);  PH_END(9); }
    SEAM();

#pragma unroll 1
    for (int layer = 0; layer < DEPTH; ++layer) {
        const int jl = layer >> 1;
        if ((layer & 1) == 0) {
            if (RUN()) { COORDS(); PH_BEGIN(5); const unsigned long long _t1 = (PROBE_KIND == 10) ? __builtin_amdgcn_s_memrealtime() : 0ull;
                convert_weights(arg_in(5) + (size_t)jl * D * 5 * D, D, 5 * D, (u16*)(ws + WS_WIN), arg_in(8) + (size_t)jl * D * D, D, D, (u16*)(ws + WS_WOUT),
                                arg_in(20) + (size_t)layer * D * FF, D, FF, (u16*)(ws + WS_W1), arg_in(21) + (size_t)layer * FF * D, FF, D, (u16*)(ws + WS_W2), SCR(), gw, NGW, lane);
                if (PROBE_KIND == 10) { __syncthreads(); const unsigned long long _dt = __builtin_amdgcn_s_memrealtime() - _t1; while (__builtin_amdgcn_s_memrealtime() - _t1 < 2 * _dt) __builtin_amdgcn_s_sleep(8); }
                norm_rows(layer == 0 ? arg_in(0) : arg_out(), arg_in(4) + (size_t)(layer * 2 + 0) * D, (const float*)(ws + WS_ADA) + (size_t)(layer * 2 + 0) * 2 * 3 * D, (u16*)(ws + WS_HN), gw, NGW, lane);
             PH_END(5); }
            SEAM();
            if (RUN()) { COORDS(); PH_BEGIN(1);
                pg8::Gemm g{(const u16*)(ws + WS_HN), (const u16*)(ws + WS_WIN), M, 5 * D, D}; pg8::StaticOrder S; S.init(M, 5 * D, G, blk);
                pg8::EpiHgIn E{(u16*)(ws + WS_Q), (u16*)(ws + WS_V), (u16*)(ws + WS_GT), (u16*)(ws + WS_GF), (u16*)(ws + WS_GB), arg_in(6), jl};
                pg8::gemm_phase<pg8::EpiHgIn, pg8::StaticOrder, true, true>(lds, g, S, E);
             PH_END(1); }
            SEAM();
            if (RUN()) { COORDS(); PH_BEGIN(2); hg_scan1((const u16*)(ws + WS_GF), (const u16*)(ws + WS_GB), (const u16*)(ws + WS_V), (u16*)(ws + WS_S), lds, tid, blk, G);  PH_END(2); }
            SEAM();
            if (RUN()) { COORDS(); PH_BEGIN(3); hg_out((const u16*)(ws + WS_Q), (const u16*)(ws + WS_V), (const u16*)(ws + WS_GT), (const u16*)(ws + WS_GF), (const u16*)(ws + WS_GB), (const u16*)(ws + WS_S),
                              arg_in(7) + (size_t)jl * DV, (u16*)(ws + WS_HN), lds, tid, blk, G);  PH_END(3); }
            SEAM();
        } else {
            if (RUN()) { COORDS(); PH_BEGIN(5); const unsigned long long _t1 = (PROBE_KIND == 10) ? __builtin_amdgcn_s_memrealtime() : 0ull;
                convert_weights(arg_in(9) + (size_t)jl * D * 3 * D, D, 3 * D, (u16*)(ws + WS_WIN), arg_in(19) + (size_t)jl * D * D, D, D, (u16*)(ws + WS_WOUT),
                                arg_in(20) + (size_t)layer * D * FF, D, FF, (u16*)(ws + WS_W1), arg_in(21) + (size_t)layer * FF * D, FF, D, (u16*)(ws + WS_W2), SCR(), gw, NGW, lane);
                if (PROBE_KIND == 10) { __syncthreads(); const unsigned long long _dt = __builtin_amdgcn_s_memrealtime() - _t1; while (__builtin_amdgcn_s_memrealtime() - _t1 < 2 * _dt) __builtin_amdgcn_s_sleep(8); }
                norm_rows(arg_out(), arg_in(4) + (size_t)(layer * 2 + 0) * D, (const float*)(ws + WS_ADA) + (size_t)(layer * 2 + 0) * 2 * 3 * D, (u16*)(ws + WS_HN), gw, NGW, lane);
                const unsigned long long _t2 = (PROBE_KIND == 11) ? __builtin_amdgcn_s_memrealtime() : 0ull;
                filter_gen((const float*)(ws + WS_HDN) + (size_t)jl * SEQ * FW, (const float*)(ws + WS_WOT) + (size_t)jl * 2 * D * FW, (float*)(ws + WS_FT), tid, blk, G);
                if (PROBE_KIND == 11) { __syncthreads(); const unsigned long long _dt = __builtin_amdgcn_s_memrealtime() - _t2; while (__builtin_amdgcn_s_memrealtime() - _t2 < 2 * _dt) __builtin_amdgcn_s_sleep(8); }
             PH_END(5); }
            SEAM();
            if (RUN()) { COORDS(); PH_BEGIN(1);
                pg8::Gemm g{(const u16*)(ws + WS_WIN), (const u16*)(ws + WS_HN), 3 * D, M, D}; pg8::StaticOrder S; S.init(3 * D, M, G, blk);
                pg8::EpiRowBias E{(u16*)(ws + WS_U), M, arg_in(10) + (size_t)jl * 3 * D};
                pg8::gemm_phase<pg8::EpiRowBias, pg8::StaticOrder, true, true>(lds, g, S, E);
                 PH_END(1); }
            SEAM();
            if (RUN()) { COORDS(); PH_BEGIN(4); hy_fftconv((const u16*)(ws + WS_U), arg_in(11) + (size_t)jl * 3 * 3 * D, arg_in(12) + (size_t)jl * 3 * D, (const float*)(ws + WS_FT), (f32x2*)(ws + WS_HS),
                                                       arg_in(18) + (size_t)jl * D, (u16*)(ws + WS_ZT), lds, tid, blk, G);  PH_END(4); }
            SEAM();
            if (RUN()) { COORDS(); PH_BEGIN(6); transpose_cm((const u16*)(ws + WS_ZT), (u16*)(ws + WS_HN), lds, tid, blk, G);  PH_END(6); }
            SEAM();
        }
        if (RUN()) { COORDS(); PH_BEGIN(7);
            pg8::Gemm g{(const u16*)(ws + WS_HN), (const u16*)(ws + WS_WOUT), M, D, D}; pg8::StaticOrder S; S.init(M, D, G, blk);
            pg8::EpiResid E{layer == 0 ? arg_in(0) : arg_out(), arg_out(), (const float*)(ws + WS_ADA) + (size_t)(layer * 2 + 0) * 2 * 3 * D + 2 * D};
            pg8::gemm_phase<pg8::EpiResid, pg8::StaticOrder, true, true>(lds, g, S, E);
         PH_END(7); }
        SEAM();
        if (RUN()) { COORDS(); PH_BEGIN(5); norm_rows(arg_out(), arg_in(4) + (size_t)(layer * 2 + 1) * D, (const float*)(ws + WS_ADA) + (size_t)(layer * 2 + 1) * 2 * 3 * D, (u16*)(ws + WS_HN), gw, NGW, lane);  PH_END(5); }
        SEAM();
        if (RUN()) { COORDS(); PH_BEGIN(8);
            pg8::Gemm g{(const u16*)(ws + WS_HN), (const u16*)(ws + WS_W1), M, FF, D}; pg8::StaticOrder S; S.init(M, FF, G, blk);
            pg8::EpiRelu2 E{(u16*)(ws + WS_H), FF};
            pg8::gemm_phase<pg8::EpiRelu2, pg8::StaticOrder, true, true>(lds, g, S, E);
         PH_END(8); }
        SEAM();
        if (RUN()) { COORDS(); PH_BEGIN(7);
            pg8::Gemm g{(const u16*)(ws + WS_H), (const u16*)(ws + WS_W2), M, D, FF}; pg8::StaticOrder S; S.init(M, D, G, blk);
            pg8::EpiResid E{arg_out(), arg_out(), (const float*)(ws + WS_ADA) + (size_t)(layer * 2 + 1) * 2 * 3 * D + 2 * D};
            pg8::gemm_phase<pg8::EpiResid, pg8::StaticOrder, true, true>(lds, g, S, E);
         PH_END(7); }
        SEAM();
    }
    if (RUN()) { COORDS(); PH_BEGIN(5); final_norm_rows(arg_out(), arg_in(22), gw, NGW, lane);  PH_END(5); }
#undef RUN
#undef SEAM
#undef COORDS
#undef SCR
}

constexpr int N_PHASES = 1 + 2 * 8 + 2 * 8 + 1;

extern "C" void kernel_launch(void* const* d_in, const int* in_sizes, int n_in, void* d_out, int out_size, void* d_ws, size_t ws_size, hipStream_t stream) {
    static int grid = 0;
    if (grid == 0) {
        if (n_in != 23 || in_sizes[0] != M * D || out_size != M * D || ws_size < WS_END) {
            fprintf(stderr, "kernel_launch: unexpected problem: n_in %d in0 %d out %d ws %zu (need %zu)\n", n_in, n_in > 0 ? in_sizes[0] : -1, out_size, ws_size, (size_t)WS_END); grid = -1; return; }
        int dev = 0, cus = 0;
        if (hipGetDevice(&dev) != hipSuccess || hipDeviceGetAttribute(&cus, hipDeviceAttributeMultiprocessorCount, dev) != hipSuccess) { grid = -1; return; }
        if (hipFuncSetAttribute((const void*)mega_fwd, hipFuncAttributeMaxDynamicSharedMemorySize, LDS_BYTES) != hipSuccess) { fprintf(stderr, "kernel_launch: hipFuncSetAttribute failed\n"); grid = -1; return; }
        int per_cu = 0;
        if (hipOccupancyMaxActiveBlocksPerMultiprocessor(&per_cu, (const void*)mega_fwd, 512, LDS_BYTES) != hipSuccess || per_cu < 1)
            fprintf(stderr, "kernel_launch: occupancy query reports %d per CU\n", per_cu);
        (void)hipGetLastError();
        grid = cus;
    }
    if (grid < 0) return;
    if (hipMemsetAsync((char*)d_ws + WS_CTL, 0, CTL_ZERO_BYTES, stream) != hipSuccess) { fprintf(stderr, "kernel_launch: memset failed\n"); return; }
    Args a{};
    for (int i = 0; i < 23; ++i) a.in[i] = (const float*)d_in[i];
    a.out = (float*)d_out; a.ws = (unsigned char*)d_ws;
#if MK_PER_PHASE
    for (int p = 0; p < N_PHASES; ++p) { a.ph_lo = p; a.ph_hi = p + 1; a.li = 0; hipLaunchKernelGGL(mega_fwd, dim3(grid), dim3(512), LDS_BYTES, stream, a); }
#else
    a.ph_lo = 0; a.ph_hi = N_PHASES; a.li = 0;
    hipLaunchKernelGGL(mega_fwd, dim3(grid), dim3(512), LDS_BYTES, stream, a);
#endif
    const hipError_t le = hipPeekAtLastError();
    if (le != hipSuccess) fprintf(stderr, "kernel_launch: launch failed: %s\n", hipGetErrorName(le));
}
```

```cpp
#include <hip/hip_runtime.h>
#include <cstdio>
#include <cstdint>

#ifndef MK_PER_PHASE
#define MK_PER_PHASE 0
#endif

#define GAS __attribute__((address_space(1)))
#define LAS __attribute__((address_space(3)))
typedef unsigned short u16;
typedef float f32x4 __attribute__((ext_vector_type(4)));
typedef float f32x2 __attribute__((ext_vector_type(2)));
typedef short bf16x8 __attribute__((ext_vector_type(8)));
typedef unsigned u32x4 __attribute__((ext_vector_type(4)));
typedef unsigned u32x2 __attribute__((ext_vector_type(2)));
typedef _Float16 h16x2 __attribute__((ext_vector_type(2)));

constexpr int D = 1024, NB = 2, SEQ = 8192, M = NB * SEQ, DEPTH = 4, NH = 8, DK = 128, DV = 128, CH = 64, NCH = SEQ / CH, FF = 4096;
constexpr int FW = 64, EMB = 33;
constexpr float NORM_EPS = 1e-6f;
constexpr float HY_MAX_DECAY = -15.350567286626973f;
constexpr float HY_MIN_DECAY = -3.0701134573253946f;

constexpr size_t MiB = 1u << 20;
constexpr size_t WS_CTL = 0, CTL_ZERO_BYTES = 1 * MiB;
constexpr size_t WS_ADA = 1 * MiB;
constexpr size_t WS_HDN = 2 * MiB;
constexpr size_t WS_WOT = 6 * MiB;
constexpr size_t WS_W = 8 * MiB;
constexpr size_t WS_WIN = WS_W, WS_WOUT = WS_W + 10 * MiB, WS_W1 = WS_W + 12 * MiB, WS_W2 = WS_W + 20 * MiB;
constexpr size_t WS_HN = 36 * MiB;
constexpr size_t WS_Q = 68 * MiB, WS_V = 100 * MiB, WS_GT = 132 * MiB, WS_GF = 164 * MiB, WS_GB = 196 * MiB, WS_S = 228 * MiB;
constexpr size_t WS_H = 228 * MiB;
constexpr size_t WS_U = 68 * MiB;
constexpr size_t WS_ZT = 164 * MiB;
constexpr size_t WS_FT = 228 * MiB;
constexpr size_t WS_HS = 292 * MiB;
constexpr size_t WS_END = 356 * MiB;
constexpr int CW_BAR = 4096;

constexpr int RING_BYTES = 131072;
constexpr int LDSCTL_OFF = (16384 + 1024) * 8  , MISC_OFF = LDSCTL_OFF + 320;
constexpr int LDS_BYTES = 147456;

__device__ __forceinline__ unsigned f2bf(float f) { unsigned u = __builtin_bit_cast(unsigned, f); return (u + 0x7fffu + ((u >> 16) & 1u)) >> 16; }
__device__ __forceinline__ unsigned pk2(float lo, float hi) { return f2bf(lo) | (f2bf(hi) << 16); }
__device__ __forceinline__ float bf2f(unsigned b) { return __builtin_bit_cast(float, b << 16); }
__device__ __forceinline__ unsigned pkh2(float lo, float hi) { h16x2 v; v.x = (_Float16)lo; v.y = (_Float16)hi; return __builtin_bit_cast(unsigned, v); }
__device__ __forceinline__ float h2f(unsigned short b) { return (float)__builtin_bit_cast(_Float16, b); }
__device__ __forceinline__ float sin_rev(float r) { return __builtin_amdgcn_sinf(r); }
__device__ __forceinline__ float cos_rev(float r) { return __builtin_amdgcn_cosf(r); }
__device__ __forceinline__ float fast_sin(float x) { float r = x * 0.15915494309189535f; r = r - floorf(r); return sin_rev(r); }
__device__ __forceinline__ float sigmoidf_(float x) { return 1.0f / (1.0f + __expf(-x)); }
__device__ __forceinline__ float siluf_(float x) { return x / (1.0f + __expf(-x)); }
__device__ __forceinline__ float wave_sum(float v) {
#pragma unroll
    for (int o = 1; o < 64; o <<= 1) v += __shfl_xor(v, o);
    return v;
}
#define LDS_WAIT() asm volatile("s_waitcnt lgkmcnt(0)" ::: "memory")

#define CAS __attribute__((address_space(4)))
__device__ __forceinline__ int opq_tid() { int t = threadIdx.x; asm volatile("" : "+v"(t)); return t; }
__device__ __forceinline__ int opq_s(int x) { asm volatile("" : "+s"(x)); return x; }
__device__ __forceinline__ const float* arg_in(int i) { const CAS char* p = (const CAS char*)__builtin_amdgcn_kernarg_segment_ptr(); asm volatile("" : "+s"(p)); return *(const float* const CAS*)(p + 8 * i); }
__device__ __forceinline__ float* arg_out() { const CAS char* p = (const CAS char*)__builtin_amdgcn_kernarg_segment_ptr(); asm volatile("" : "+s"(p)); return *(float* const CAS*)(p + 8 * 23); }
__device__ __forceinline__ unsigned char* arg_ws() { const CAS char* p = (const CAS char*)__builtin_amdgcn_kernarg_segment_ptr(); asm volatile("" : "+s"(p)); return *(unsigned char* const CAS*)(p + 8 * 24); }

namespace pg8 {
#define PG8_LAS __attribute__((address_space(3)))
typedef unsigned short bf16_t;
constexpr int BM = 256, BK = 64, HALF = 128, HTB = HALF * BK * 2, STAGE_BYTES = 8 * HTB, NXCD = 8, WGM = 8;
__host__ __device__ __forceinline__ int lds_byte(int r, int c) { const int st = (r >> 4) * 2 + (c >> 5), rr = r & 15, cc = c & 31, ob = rr * 64 + cc * 2; return st * 1024 + (ob ^ (((ob >> 9) & 1) << 5)); }
__host__ __device__ __forceinline__ void stage_rc(int b, int& R, int& C) { const int st = b / 1024, sb = b % 1024, swz = sb ^ (((sb >> 9) & 1) << 5); R = (st >> 1) * 16 + swz / 64; C = (st & 1) * 32 + (swz % 64) / 2; }
__host__ __device__ __forceinline__ int perm32(int rho) { const int n = rho >> 4, i = rho & 15; return 8 * (i >> 2) + 4 * n + (i & 3); }
struct Unit { int pm, pn; };
struct Gemm { const bf16_t* A; const bf16_t* Bt; int M, N, K; };
struct StaticOrder {
    int nM, nN, nwg, G, c;
    __host__ __device__ void init(int M_, int N_, int G_, int c_) { nM = M_ / BM; nN = N_ / BM; nwg = nM * nN; G = G_; c = c_; }
    __host__ __device__ bool next(int i, Unit& u) const {
        const long L = (long)i * G + c; if (L >= nwg) return false;
        int wgid = (int)L; { const int q = nwg / NXCD, r = nwg % NXCD, xcd = wgid % NXCD, off = wgid / NXCD; wgid = (xcd < r ? xcd * (q + 1) : r * (q + 1) + (xcd - r) * q) + off; }
        const int nig = WGM * nN, gid = wgid / nig, fm = gid * WGM, gsz = (nM - fm) < WGM ? (nM - fm) : WGM;
        u.pm = fm + ((wgid % nig) % gsz); u.pn = (wgid % nig) / gsz; return true;
    }
    __device__ __forceinline__ void a_ready(const Unit&) const {}
    __device__ __forceinline__ void done(const Unit&) const {}
};
__device__ __forceinline__ unsigned cvt_pk_bf16(float lo, float hi) { unsigned r; asm volatile("v_cvt_pk_bf16_f32 %0, %1, %2" : "=v"(r) : "v"(lo), "v"(hi)); return r; }

template <class Epi, class Sched, bool ALIGN_EPI = false, bool SP2 = false>
__device__ __forceinline__ void gemm_phase(PG8_LAS unsigned char* lds, const Gemm g, const Sched& S, const Epi& E) {
    const int tid = opq_tid(), wid = __builtin_amdgcn_readfirstlane(tid >> 6), lane = tid & 63, wr = wid >> 2, wc = wid & 3, fr = lane & 15, fq = lane >> 4;
    const int K = g.K, nt = K / BK;
    unsigned voffA[2], voffB[2];
#pragma unroll
    for (int i = 0; i < 2; ++i) { int R, C; stage_rc(tid * 16 + i * 8192, R, C); const int Rb = Epi::PERM ? ((R & ~31) + perm32(R & 31)) : R;
        voffA[i] = (unsigned)(R * K + C) * 2u; voffB[i] = (unsigned)(Rb * K + C) * 2u; }
    const size_t kstep = (size_t)(BK * 2);
    const size_t hstep = (size_t)HALF * K * 2;
    const size_t tstep = 2 * hstep;
    const unsigned ldsw = (unsigned)wid * 1024u;
    const int aoff = lds_byte(wr * 64 + fr, fq * 8), boff = lds_byte(wc * 32 + fr, fq * 8);
#define PG8_SA(b, h) (((b) * 2 + (h)) * HTB)
#define PG8_SB(b, h) ((4 + (b) * 2 + (h)) * HTB)
#define PG8_STAGE(bufoff, gbase, voff) do { _Pragma("unroll") for (int _i = 0; _i < 2; ++_i) \
        __builtin_amdgcn_global_load_lds((const unsigned*)((const char*)(gbase) + (voff)[_i]), (PG8_LAS unsigned*)(lds + (bufoff) + ldsw + _i * 8192), 16, 0, 0); } while (0)
#define PG8_LDA(dst, b, h) do { _Pragma("unroll") for (int m = 0; m < 4; ++m) _Pragma("unroll") for (int k = 0; k < 2; ++k) dst[m][k] = *(const PG8_LAS bf16x8*)(lds + PG8_SA(b, h) + aoff + m * 2048 + k * 1024); } while (0)
#define PG8_LDB(dst, b, h) do { _Pragma("unroll") for (int n = 0; n < 2; ++n) _Pragma("unroll") for (int k = 0; k < 2; ++k) dst[n][k] = *(const PG8_LAS bf16x8*)(lds + PG8_SB(b, h) + boff + n * 2048 + k * 1024); } while (0)
#define PG8_MMA(ai, bj, At, Bt) do { __builtin_amdgcn_s_setprio(1); _Pragma("unroll") for (int m = 0; m < 4; ++m) _Pragma("unroll") for (int n = 0; n < 2; ++n) _Pragma("unroll") for (int k = 0; k < 2; ++k) \
        acc[ai][bj][m][n] = __builtin_amdgcn_mfma_f32_16x16x32_bf16(Bt[n][k], At[m][k], acc[ai][bj][m][n], 0, 0, 0); __builtin_amdgcn_s_setprio(0); } while (0)
#define PG8_WAIT_V(n) asm volatile("s_waitcnt vmcnt(" #n ")" ::: "memory")
#define PG8_WAIT_L(n) asm volatile("s_waitcnt lgkmcnt(" #n ")" ::: "memory")
#define PG8_BAR __builtin_amdgcn_s_barrier()
#define PG8_SCHED __builtin_amdgcn_sched_barrier(0)
    Unit cur, nxt; int ui = 0;
    if (!S.next(0, cur)) return;
    f32x4 acc[2][2][4][2];
#pragma unroll
    for (int a = 0; a < 2; ++a)
#pragma unroll
        for (int b = 0; b < 2; ++b)
#pragma unroll
            for (int m = 0; m < 4; ++m)
#pragma unroll
                for (int n = 0; n < 2; ++n) acc[a][b][m][n] = (f32x4){0.f, 0.f, 0.f, 0.f};
    bf16x8 At[4][2], B0[2][2], B1[2][2];
    const char* cA = (const char*)g.A + (size_t)cur.pm * tstep; const char* cB = (const char*)g.Bt + (size_t)cur.pn * tstep;
    S.a_ready(cur);
    if constexpr (SP2) {
        PG8_STAGE(PG8_SB(0, 0), cB, voffB); PG8_STAGE(PG8_SB(0, 1), cB + hstep, voffB); PG8_STAGE(PG8_SA(0, 0), cA, voffA); PG8_STAGE(PG8_SA(0, 1), cA + hstep, voffA);
        if (wr == 1) PG8_BAR;
        PG8_WAIT_V(2); PG8_BAR;
        PG8_STAGE(PG8_SB(1, 0), cB + kstep, voffB); PG8_STAGE(PG8_SA(1, 0), cA + kstep, voffA); PG8_STAGE(PG8_SB(1, 1), cB + hstep + kstep, voffB);
        PG8_WAIT_V(6); PG8_BAR;
    } else {
        PG8_STAGE(PG8_SB(0, 0), cB, voffB); PG8_STAGE(PG8_SA(0, 0), cA, voffA); PG8_STAGE(PG8_SB(0, 1), cB + hstep, voffB); PG8_STAGE(PG8_SA(0, 1), cA + hstep, voffA);
        if (wr == 1) PG8_BAR;
        PG8_WAIT_V(4); PG8_BAR;
        PG8_STAGE(PG8_SB(1, 0), cB + kstep, voffB); PG8_STAGE(PG8_SA(1, 0), cA + kstep, voffA); PG8_STAGE(PG8_SB(1, 1), cB + hstep + kstep, voffB);
        PG8_WAIT_V(6); PG8_BAR;
    }
    for (;;) {
        const bool has_next = S.next(ui + 1, nxt);
        const char* nA = has_next ? (const char*)g.A + (size_t)nxt.pm * tstep : cA; const char* nB = has_next ? (const char*)g.Bt + (size_t)nxt.pn * tstep : cB;
        for (int t = 0; t < nt; t += 2) {
            const bool last = (t == nt - 2);
            const char* a1 = cA + (size_t)(t + 1) * kstep;
            const char* a2 = last ? nA : cA + (size_t)(t + 2) * kstep; const char* b2 = last ? nB : cB + (size_t)(t + 2) * kstep;
            const char* a3 = a2 + kstep; const char* b3 = b2 + kstep;
            if (last && has_next) S.a_ready(nxt);
            if constexpr (SP2) {
            PG8_LDB(B0, 0, 0); PG8_LDB(B1, 0, 1); PG8_SCHED; PG8_LDA(At, 0, 0); PG8_STAGE(PG8_SA(1, 1), a1 + hstep, voffA);
            PG8_WAIT_V(8); PG8_WAIT_L(0); PG8_BAR; PG8_MMA(0, 0, At, B0); PG8_MMA(0, 1, At, B1); PG8_BAR; PG8_SCHED;
            PG8_LDA(At, 0, 1); PG8_STAGE(PG8_SB(0, 0), b2, voffB); PG8_STAGE(PG8_SB(0, 1), b2 + hstep, voffB); PG8_STAGE(PG8_SA(0, 0), a2, voffA);
            PG8_WAIT_V(8); PG8_WAIT_L(0); PG8_BAR; PG8_MMA(1, 0, At, B0); PG8_MMA(1, 1, At, B1); PG8_BAR; PG8_SCHED;
            PG8_LDB(B0, 1, 0); PG8_LDB(B1, 1, 1); PG8_SCHED; PG8_LDA(At, 1, 0); PG8_STAGE(PG8_SA(0, 1), a2 + hstep, voffA);
            PG8_WAIT_V(8); PG8_WAIT_L(0); PG8_BAR; PG8_MMA(0, 0, At, B0); PG8_MMA(0, 1, At, B1); PG8_BAR; PG8_SCHED;
            PG8_LDA(At, 1, 1); PG8_STAGE(PG8_SB(1, 0), b3, voffB); PG8_STAGE(PG8_SB(1, 1), b3 + hstep, voffB); PG8_STAGE(PG8_SA(1, 0), a3, voffA);
            PG8_WAIT_V(8); PG8_WAIT_L(0); PG8_BAR; PG8_MMA(1, 0, At, B0); PG8_MMA(1, 1, At, B1); PG8_BAR; PG8_SCHED;
            } else {
            PG8_LDB(B0, 0, 0); PG8_SCHED; PG8_LDA(At, 0, 0); PG8_STAGE(PG8_SA(1, 1), a1 + hstep, voffA);
            PG8_WAIT_L(8); PG8_BAR; PG8_WAIT_L(0); PG8_MMA(0, 0, At, B0); PG8_BAR; PG8_SCHED;
            PG8_LDB(B1, 0, 1); PG8_STAGE(PG8_SB(0, 0), b2, voffB);
            PG8_BAR; PG8_WAIT_L(0); PG8_MMA(0, 1, At, B1); PG8_BAR;
            PG8_LDA(At, 0, 1); PG8_STAGE(PG8_SA(0, 0), a2, voffA);
            PG8_BAR; PG8_WAIT_L(0); PG8_MMA(1, 0, At, B0); PG8_BAR; PG8_SCHED;
            PG8_STAGE(PG8_SB(0, 1), b2 + hstep, voffB);
            PG8_WAIT_V(6); PG8_BAR; PG8_MMA(1, 1, At, B1); PG8_BAR;
            PG8_LDB(B0, 1, 0); PG8_SCHED; PG8_LDA(At, 1, 0); PG8_STAGE(PG8_SA(0, 1), a2 + hstep, voffA);
            PG8_WAIT_L(8); PG8_BAR; PG8_WAIT_L(0); PG8_MMA(0, 0, At, B0); PG8_BAR; PG8_SCHED;
            PG8_LDB(B1, 1, 1); PG8_STAGE(PG8_SB(1, 0), b3, voffB);
            PG8_BAR; PG8_WAIT_L(0); PG8_MMA(0, 1, At, B1); PG8_BAR;
            PG8_LDA(At, 1, 1); PG8_STAGE(PG8_SA(1, 0), a3, voffA);
            PG8_BAR; PG8_WAIT_L(0); PG8_MMA(1, 0, At, B0); PG8_BAR; PG8_SCHED;
            PG8_STAGE(PG8_SB(1, 1), b3 + hstep, voffB);
            PG8_WAIT_V(6); PG8_BAR; PG8_MMA(1, 1, At, B1); PG8_BAR;
            }
        }
        if constexpr (ALIGN_EPI) { if (wr == 0) PG8_BAR; }
        E(acc, cur, wr, wc, fr, fq); S.done(cur);
        if (!has_next) break;
#pragma unroll
        for (int a = 0; a < 2; ++a)
#pragma unroll
            for (int b = 0; b < 2; ++b)
#pragma unroll
                for (int m = 0; m < 4; ++m)
#pragma unroll
                    for (int n = 0; n < 2; ++n) acc[a][b][m][n] = (f32x4){0.f, 0.f, 0.f, 0.f};
        cur = nxt; cA = nA; cB = nB; ++ui;
        if constexpr (ALIGN_EPI) { if (wr == 1) PG8_BAR; }
    }
    PG8_WAIT_V(0);
    if constexpr (!ALIGN_EPI) { if (wr == 0) PG8_BAR; }
    PG8_BAR;
#undef PG8_SA
#undef PG8_SB
#undef PG8_STAGE
#undef PG8_LDA
#undef PG8_LDB
#undef PG8_MMA
#undef PG8_WAIT_V
#undef PG8_WAIT_L
#undef PG8_BAR
#undef PG8_SCHED
}

struct EpiResid {
    static constexpr bool PERM = false, AFTER_DRAIN = false;
    const float* xin; float* xout; const float* gate;
    __device__ __forceinline__ void operator()(const f32x4 (&acc)[2][2][4][2], const Unit& u, int wr, int wc, int fr, int fq) const {
        const int row0 = u.pm * BM + wr * 64 + fr, col0 = u.pn * BM + wc * 32 + 4 * fq;
        const float* gp = gate + (u.pm >= (SEQ / BM) ? 3 * D : 0);
        f32x4 gv[2][2];
#pragma unroll
        for (int bj = 0; bj < 2; ++bj)
#pragma unroll
            for (int n = 0; n < 2; ++n) gv[bj][n] = *(const f32x4*)(gp + col0 + bj * HALF + n * 16);
#pragma unroll
        for (int ai = 0; ai < 2; ++ai)
#pragma unroll
            for (int m = 0; m < 4; ++m) { const size_t off = (size_t)(row0 + ai * HALF + m * 16) * D + col0;
#pragma unroll
                for (int bj = 0; bj < 2; ++bj)
#pragma unroll
                    for (int n = 0; n < 2; ++n) { const f32x4 xi = *(const f32x4*)(xin + off + bj * HALF + n * 16);
                        *(f32x4*)(xout + off + bj * HALF + n * 16) = xi + gv[bj][n] * acc[ai][bj][m][n]; } }
    }
};
struct EpiRelu2 {
    static constexpr bool PERM = true, AFTER_DRAIN = false;
    bf16_t* O; int ldc;
    __device__ __forceinline__ void operator()(const f32x4 (&acc)[2][2][4][2], const Unit& u, int wr, int wc, int fr, int fq) const {
        const int row0 = u.pm * BM + wr * 64 + fr, col0 = u.pn * BM + wc * 32 + 8 * fq;
#pragma unroll
        for (int ai = 0; ai < 2; ++ai)
#pragma unroll
            for (int m = 0; m < 4; ++m) { bf16_t* rowp = O + (size_t)(row0 + ai * HALF + m * 16) * ldc + col0;
#pragma unroll
                for (int bj = 0; bj < 2; ++bj) { f32x4 v0 = acc[ai][bj][m][0], v1 = acc[ai][bj][m][1];
#pragma unroll
                    for (int j = 0; j < 4; ++j) { const float a = fmaxf(v0[j], 0.f), b = fmaxf(v1[j], 0.f); v0[j] = a * a; v1[j] = b * b; }
                    u32x4 w; w.x = cvt_pk_bf16(v0[0], v0[1]); w.y = cvt_pk_bf16(v0[2], v0[3]); w.z = cvt_pk_bf16(v1[0], v1[1]); w.w = cvt_pk_bf16(v1[2], v1[3]);
                    *(u32x4*)(rowp + bj * HALF) = w; } }
    }
};
struct EpiBias {
    static constexpr bool PERM = true, AFTER_DRAIN = false;
    bf16_t* O; int ldc; const float* bias;
    __device__ __forceinline__ void operator()(const f32x4 (&acc)[2][2][4][2], const Unit& u, int wr, int wc, int fr, int fq) const {
        const int row0 = u.pm * BM + wr * 64 + fr, col0 = u.pn * BM + wc * 32 + 8 * fq;
        f32x4 bv[2][2];
#pragma unroll
        for (int bj = 0; bj < 2; ++bj)
#pragma unroll
            for (int n = 0; n < 2; ++n) bv[bj][n] = *(const f32x4*)(bias + col0 + bj * HALF + 4 * n);
#pragma unroll
        for (int ai = 0; ai < 2; ++ai)
#pragma unroll
            for (int m = 0; m < 4; ++m) { bf16_t* rowp = O + (size_t)(row0 + ai * HALF + m * 16) * ldc + col0;
#pragma unroll
                for (int bj = 0; bj < 2; ++bj) { const f32x4 v0 = acc[ai][bj][m][0] + bv[bj][0], v1 = acc[ai][bj][m][1] + bv[bj][1];
                    u32x4 w; w.x = cvt_pk_bf16(v0[0], v0[1]); w.y = cvt_pk_bf16(v0[2], v0[3]); w.z = cvt_pk_bf16(v1[0], v1[1]); w.w = cvt_pk_bf16(v1[2], v1[3]);
                    *(u32x4*)(rowp + bj * HALF) = w; } }
    }
};
struct EpiRowBias {
    static constexpr bool PERM = true, AFTER_DRAIN = false;
    bf16_t* O; int ldc; const float* bias;
    __device__ __forceinline__ void operator()(const f32x4 (&acc)[2][2][4][2], const Unit& u, int wr, int wc, int fr, int fq) const {
        const int row0 = u.pm * BM + wr * 64 + fr, col0 = u.pn * BM + wc * 32 + 8 * fq;
#pragma unroll
        for (int ai = 0; ai < 2; ++ai)
#pragma unroll
            for (int m = 0; m < 4; ++m) { const int row = row0 + ai * HALF + m * 16; const float bb = bias[row]; bf16_t* rowp = O + (size_t)row * ldc + col0;
#pragma unroll
                for (int bj = 0; bj < 2; ++bj) { const f32x4 v0 = acc[ai][bj][m][0] + bb, v1 = acc[ai][bj][m][1] + bb;
                    u32x4 w; w.x = cvt_pk_bf16(v0[0], v0[1]); w.y = cvt_pk_bf16(v0[2], v0[3]); w.z = cvt_pk_bf16(v1[0], v1[1]); w.w = cvt_pk_bf16(v1[2], v1[3]);
                    *(u32x4*)(rowp + bj * HALF) = w; } }
    }
};
struct EpiHgIn {
    static constexpr bool PERM = true, AFTER_DRAIN = false;
    bf16_t *Q, *V, *GT, *GF, *GB; const float* lbraw; int jl;
    __device__ __forceinline__ void operator()(const f32x4 (&acc)[2][2][4][2], const Unit& u, int wr, int wc, int fr, int fq) const {
        const int sec = u.pn >> 2;
        const int row0 = u.pm * BM + wr * 64 + fr, col0 = (u.pn & 3) * BM + wc * 32 + 8 * fq;
        bf16_t* base = sec == 0 ? Q : sec == 1 ? V : sec == 2 ? GF : sec == 3 ? GB : GT;
        float lb[2][8];
#pragma unroll
        for (int bj = 0; bj < 2; ++bj)
#pragma unroll
            for (int j = 0; j < 8; ++j) lb[bj][j] = 0.f;
        if ((sec == 2 || sec == 3) && jl == 1) {
            const float* r0 = lbraw + (size_t)(sec - 2) * 2 * D;
#pragma unroll
            for (int bj = 0; bj < 2; ++bj)
#pragma unroll
                for (int j = 0; j < 8; ++j) { const int c = col0 + bj * HALF + j; const float a0 = r0[c], a1 = r0[D + c]; lb[bj][j] = 1.0f / (1.0f + __expf(a0 - a1));   }
        }
#pragma unroll
        for (int ai = 0; ai < 2; ++ai)
#pragma unroll
            for (int m = 0; m < 4; ++m) { bf16_t* rowp = base + (size_t)(row0 + ai * HALF + m * 16) * D + col0;
#pragma unroll
                for (int bj = 0; bj < 2; ++bj) { float v[8];
#pragma unroll
                    for (int j = 0; j < 4; ++j) { v[j] = acc[ai][bj][m][0][j]; v[4 + j] = acc[ai][bj][m][1][j]; }
                    u32x4 w;
                    if (sec == 0 || sec == 4) {
#pragma unroll
                        for (int j = 0; j < 8; ++j) v[j] = siluf_(v[j]);
                        w.x = cvt_pk_bf16(v[0], v[1]); w.y = cvt_pk_bf16(v[2], v[3]); w.z = cvt_pk_bf16(v[4], v[5]); w.w = cvt_pk_bf16(v[6], v[7]);
                    } else if (sec == 1) {
                        w.x = cvt_pk_bf16(v[0], v[1]); w.y = cvt_pk_bf16(v[2], v[3]); w.z = cvt_pk_bf16(v[4], v[5]); w.w = cvt_pk_bf16(v[6], v[7]);
                    } else {
#pragma unroll
                        for (int j = 0; j < 8; ++j) { const float l = lb[bj][j]; const float f = l + (1.0f - l) * sigmoidf_(v[j]); v[j] = fmaxf(__logf(f), -100.0f); }
                        w.x = pkh2(v[0], v[1]); w.y = pkh2(v[2], v[3]); w.z = pkh2(v[4], v[5]); w.w = pkh2(v[6], v[7]);
                    }
                    *(u32x4*)(rowp + bj * HALF) = w; } }
    }
};
}

#define XB_TMO      128
#define XB_XCNT(j)  (256  + 64 * (j))
#define XB_XSUB(j)  (1280 + 64 * (j))
#define XB_XGEN(j)  (2304 + 64 * (j))
#define XB_TOP      3328
#define XB_TOPGEN   3392
#define XCD_BAR_WORDS 3456
#define XB_SPIN_CAP (1u << 18)
__device__ __forceinline__ unsigned xb_ld(unsigned* p)              { return __hip_atomic_load(p, __ATOMIC_RELAXED, __HIP_MEMORY_SCOPE_AGENT); }
__device__ __forceinline__ unsigned xb_add(unsigned* p, unsigned v) { return __hip_atomic_fetch_add(p, v, __ATOMIC_RELAXED, __HIP_MEMORY_SCOPE_AGENT); }
__device__ __forceinline__ unsigned xb_xcc_id() { return (unsigned)__builtin_amdgcn_s_getreg((3 << 11) | 20) & 0xFu; }
#define XB_SPIN(cond, bar) do { unsigned _sp = 0; while (cond) { __builtin_amdgcn_s_sleep(1); \
    if ((++_sp & 255u) == 0u) { if (xb_ld(&(bar)[XB_TMO])) break; if (_sp > XB_SPIN_CAP) { atomicAdd(&(bar)[XB_TMO], 1u); break; } } } } while (0)
struct XcdBarrier { unsigned* bar; unsigned x; volatile LAS unsigned* st; };
__device__ __forceinline__ XcdBarrier xcd_barrier_post(unsigned* bar, volatile LAS unsigned* st) {
    XcdBarrier b; b.bar = bar; b.x = xb_xcc_id(); b.st = st;
    if (threadIdx.x == 0) (void)xb_add(&bar[XB_XCNT(b.x)], 1u);
    return b;
}
__device__ __forceinline__ void xcd_barrier_complete(unsigned* bar, unsigned x, unsigned& nloc, unsigned& nx) {
    const unsigned G = gridDim.x * gridDim.y * gridDim.z;
    unsigned sum, cnt, mine, sp = 0u;
    for (;;) {
        sum = 0u; cnt = 0u; mine = 0u;
#pragma unroll
        for (unsigned j = 0; j < 16; ++j) { const unsigned c = xb_ld(&bar[XB_XCNT(j)]); sum += c; cnt += (c > 0u) ? 1u : 0u; mine = (j == x) ? c : mine; }
        if (sum == G) break;
        __builtin_amdgcn_s_sleep(1);
        if ((++sp & 255u) == 0u) { if (xb_ld(&bar[XB_TMO])) break; if (sp > XB_SPIN_CAP) { atomicAdd(&bar[XB_TMO], 1u); break; } }
    }
    nloc = mine > 0u ? mine : 1u; nx = cnt > 0u ? cnt : 1u;
}
__device__ __forceinline__ void xcd_barrier(const XcdBarrier& b) {
    asm volatile("s_waitcnt vmcnt(0)" ::: "memory");
    __syncthreads();
    if (threadIdx.x == 0) {
        unsigned* bar = b.bar;
        __builtin_amdgcn_s_waitcnt(0);
        unsigned nloc = b.st[0], nx = b.st[1];
        if (nloc == 0u) { xcd_barrier_complete(bar, b.x, nloc, nx); b.st[0] = nloc; b.st[1] = nx; }
        const unsigned old = xb_add(&bar[XB_XSUB(b.x)], 1u);
        const unsigned gen = old / nloc;
        if (old + 1u == (gen + 1u) * nloc) {
            __builtin_amdgcn_fence(__ATOMIC_RELEASE, "agent");
            asm volatile("s_waitcnt vmcnt(0)" ::: "memory");
            const unsigned og = xb_add(&bar[XB_TOP], 1u);
            const unsigned tg = og / nx;
            if (og + 1u == (tg + 1u) * nx) xb_add(&bar[XB_TOPGEN], 1u);
            else XB_SPIN(xb_ld(&bar[XB_TOPGEN]) == tg, bar);
            __builtin_amdgcn_fence(__ATOMIC_ACQUIRE, "agent");
            xb_add(&bar[XB_XGEN(b.x)], 1u);
            asm volatile("s_waitcnt vmcnt(0)" ::: "memory");
        } else {
            XB_SPIN(xb_ld(&bar[XB_XGEN(b.x)]) == gen, bar);
            __builtin_amdgcn_fence(__ATOMIC_ACQUIRE, "agent");
            asm volatile("s_waitcnt vmcnt(0)" ::: "memory");
        }
    }
    __syncthreads();
}

__device__ __forceinline__ void transpose_item(const float* W, int K, int N, u16* WT, LAS float* scr, int item, int lane) {
    const int nblk = N / 32, kb = item / nblk, nb = item % nblk, k0 = 64 * kb, n0 = 32 * nb;
#pragma unroll 8
    for (int i = 0; i < 32; ++i) { const int kk = 2 * i + (lane >> 5); scr[kk * 33 + (lane & 31)] = W[(size_t)(k0 + kk) * N + n0 + (lane & 31)]; }
    LDS_WAIT(); asm volatile("" ::: "memory");
    const int c = lane & 7;
#pragma unroll
    for (int j = 0; j < 4; ++j) { const int n = (lane >> 3) + 8 * j; const LAS float* s = scr + (8 * c) * 33 + n;
        u32x4 o; o.x = pk2(s[0 * 33], s[1 * 33]); o.y = pk2(s[2 * 33], s[3 * 33]); o.z = pk2(s[4 * 33], s[5 * 33]); o.w = pk2(s[6 * 33], s[7 * 33]);
        *(u32x4*)(WT + (size_t)(n0 + n) * K + k0 + 8 * c) = o; }
    LDS_WAIT(); asm volatile("" ::: "memory");
}
__device__ __forceinline__ void convert_weights(const float* w0, int K0, int N0, u16* o0, const float* w1, int K1, int N1, u16* o1, const float* w2, int K2, int N2, u16* o2,
                                                const float* w3, int K3, int N3, u16* o3, LAS float* scr, int gw, int NGW, int lane) {
    const int I0 = (K0 / 64) * (N0 / 32), I1 = (K1 / 64) * (N1 / 32), I2 = (K2 / 64) * (N2 / 32), I3 = (K3 / 64) * (N3 / 32);
    for (int it = gw; it < I0 + I1 + I2 + I3; it += NGW) {
        int r = it;
        if (r < I0) { transpose_item(w0, K0, N0, o0, scr, r, lane); continue; } r -= I0;
        if (r < I1) { transpose_item(w1, K1, N1, o1, scr, r, lane); continue; } r -= I1;
        if (r < I2) { transpose_item(w2, K2, N2, o2, scr, r, lane); continue; } r -= I2;
        transpose_item(w3, K3, N3, o3, scr, r, lane);
    }
}
__device__ __forceinline__ void norm_rows(const float* x, const float* g, const float* ada, u16* hn, int gw, int NGW, int lane) {
#pragma unroll 1
    for (int b = 0; b < NB; ++b) {
        f32x4 gs[4], sh[4];
#pragma unroll
        for (int j = 0; j < 4; ++j) { const int c = 4 * (lane + 64 * j);
            gs[j] = *(const f32x4*)(g + c) * (*(const f32x4*)(ada + b * 3 * D + D + c) + 1.0f); sh[j] = *(const f32x4*)(ada + b * 3 * D + c); }
        int m = b * SEQ + gw;
#pragma unroll 1
        for (; m + NGW < (b + 1) * SEQ; m += 2 * NGW) {
            const f32x4* xa = (const f32x4*)(x + (size_t)m * D) + lane; const f32x4* xb = (const f32x4*)(x + (size_t)(m + NGW) * D) + lane;
            f32x4 va[4], vb[4]; float sa = 0.f, sb = 0.f;
#pragma unroll
            for (int j = 0; j < 4; ++j) { va[j] = xa[64 * j]; vb[j] = xb[64 * j]; }
#pragma unroll
            for (int j = 0; j < 4; ++j) { sa += (va[j].x * va[j].x + va[j].y * va[j].y) + (va[j].z * va[j].z + va[j].w * va[j].w); sb += (vb[j].x * vb[j].x + vb[j].y * vb[j].y) + (vb[j].z * vb[j].z + vb[j].w * vb[j].w); }
#pragma unroll
            for (int o = 1; o < 64; o <<= 1) { sa += __shfl_xor(sa, o); sb += __shfl_xor(sb, o); }
            const float ra = 1.0f / sqrtf(sa * (1.0f / D) + NORM_EPS), rb = 1.0f / sqrtf(sb * (1.0f / D) + NORM_EPS);
            u32x2* oa = (u32x2*)(hn + (size_t)m * D) + lane; u32x2* ob = (u32x2*)(hn + (size_t)(m + NGW) * D) + lane;
#pragma unroll
            for (int j = 0; j < 4; ++j) { const f32x4 ya = va[j] * ra * gs[j] + sh[j], yb = vb[j] * rb * gs[j] + sh[j];
                u32x2 w; w.x = pk2(ya.x, ya.y); w.y = pk2(ya.z, ya.w); oa[64 * j] = w; w.x = pk2(yb.x, yb.y); w.y = pk2(yb.z, yb.w); ob[64 * j] = w; }
        }
        for (; m < (b + 1) * SEQ; m += NGW) {
            const f32x4* xr = (const f32x4*)(x + (size_t)m * D) + lane;
            f32x4 v[4]; float s = 0.f;
#pragma unroll
            for (int j = 0; j < 4; ++j) { v[j] = xr[64 * j]; s += (v[j].x * v[j].x + v[j].y * v[j].y) + (v[j].z * v[j].z + v[j].w * v[j].w); }
            const float r = 1.0f / sqrtf(wave_sum(s) * (1.0f / D) + NORM_EPS);
            u32x2* o8 = (u32x2*)(hn + (size_t)m * D) + lane;
#pragma unroll
            for (int j = 0; j < 4; ++j) { const f32x4 y = v[j] * r * gs[j] + sh[j]; u32x2 w; w.x = pk2(y.x, y.y); w.y = pk2(y.z, y.w); o8[64 * j] = w; }
        }
    }
}
__device__ __forceinline__ void final_norm_rows(float* x, const float* g, int gw, int NGW, int lane) {
    for (int m = gw; m < M; m += NGW) {
        f32x4* xr = (f32x4*)(x + (size_t)m * D) + lane;
        f32x4 v[4]; float s = 0.f;
#pragma unroll
        for (int j = 0; j < 4; ++j) { v[j] = xr[64 * j]; s += (v[j].x * v[j].x + v[j].y * v[j].y) + (v[j].z * v[j].z + v[j].w * v[j].w); }
        const float r = 1.0f / sqrtf(wave_sum(s) * (1.0f / D) + NORM_EPS);
#pragma unroll
        for (int j = 0; j < 4; ++j) { const f32x4 gg = *(const f32x4*)(g + 4 * (lane + 64 * j)); xr[64 * j] = v[j] * r * gg; }
    }
}

__device__ __forceinline__ void phase_p0(const float* cin, const float* ada_w, const float* ada_b, float* ADA,
                                         const float* fwin, const float* fwmid, const float* fb, const float* ffreq, float* HDN, const float* fwout, float* WOT,
                                         LAS unsigned char* lds, int tid, int blk, int G) {
    for (int i = blk * 512 + tid; i < 2 * 2 * D * FW; i += G * 512) { const int w = i & 63, col = (i >> 6) & (2 * D - 1), j = i >> 17; WOT[i] = fwout[(size_t)(j * FW + w) * 2 * D + col]; }
    LAS float* sc = (LAS float*)lds;
    LAS float* red = sc + 2048;
    for (int i = tid; i < 2 * D; i += 512) sc[i] = siluf_(cin[i]);
    __syncthreads();
    {
        const int cl = tid & 31, ks = tid >> 5;
        for (int gidx = blk; gidx < 8 * 96; gidx += G) {
            const int mat = gidx / 96, col0 = (gidx % 96) * 32;
            const float* w = ada_w + (size_t)mat * D * 3 * D + col0 + cl;
            float a0 = 0.f, a1 = 0.f;
#pragma unroll 1
            for (int kh = 0; kh < 2; ++kh) { float wv[32];
#pragma unroll
                for (int k = 0; k < 32; ++k) wv[k] = w[(size_t)(ks * 64 + kh * 32 + k) * 3 * D];
#pragma unroll
                for (int k = 0; k < 32; ++k) { a0 += sc[ks * 64 + kh * 32 + k] * wv[k]; a1 += sc[D + ks * 64 + kh * 32 + k] * wv[k]; } }
            red[(ks * 2 + 0) * 32 + cl] = a0; red[(ks * 2 + 1) * 32 + cl] = a1;
            __syncthreads();
            if (tid < 64) { const int b = tid >> 5; float s = ada_b[mat * 3 * D + col0 + cl];
                for (int k2 = 0; k2 < 16; ++k2) s += red[(k2 * 2 + b) * 32 + cl];
                ADA[(size_t)(mat * 2 + b) * 3 * D + col0 + cl] = s; }
            __syncthreads();
        }
    }
    {
        LAS float* emb = (LAS float*)lds + 4096;
        LAS float* hA = emb + 8 * 36;
        LAS float* hB = hA + 512;
        for (int it = blk; it < 2 * (SEQ / 8); it += G) {
            const int j = it / (SEQ / 8), t0 = (it % (SEQ / 8)) * 8;
            if (tid < 8 * EMB) { const int tl = tid / EMB, e = tid % EMB, t = t0 + tl; float val;
                if (e == 0) val = (float)t / (float)(SEQ - 1);
                else { const int bi = (e - 1) & 15; const float band = 1e-4f + (float)bi * ((15.0f - 1e-4f) / 15.0f);
                    float rv = (float)t * band * (1.0f / SEQ); rv = rv - floorf(rv); val = (e <= 16) ? cos_rev(rv) : -sin_rev(rv); }
                emb[tl * 36 + e] = val; }
            __syncthreads();
            const int tl = tid >> 6, w = tid & 63;
            const float fq_ = ffreq[j * FW + w];
            float a = fb[(j * 3 + 0) * FW + w];
            for (int e = 0; e < EMB; ++e) a += emb[tl * 36 + e] * fwin[(size_t)(j * EMB + e) * FW + w];
            hA[tl * 64 + w] = fast_sin(fq_ * a);
            __syncthreads();
            a = fb[(j * 3 + 1) * FW + w];
            for (int v = 0; v < FW; ++v) a += hA[tl * 64 + v] * fwmid[(size_t)((j * 2 + 0) * FW + v) * FW + w];
            hB[tl * 64 + w] = fast_sin(fq_ * a);
            __syncthreads();
            a = fb[(j * 3 + 2) * FW + w];
            for (int v = 0; v < FW; ++v) a += hB[tl * 64 + v] * fwmid[(size_t)((j * 2 + 1) * FW + v) * FW + w];
            HDN[((size_t)j * SEQ + t0 + tl) * FW + w] = fast_sin(fq_ * a);
            __syncthreads();
        }
    }
}
__device__ __forceinline__ void split_bf16x8(const f32x4 a, const f32x4 b, bf16x8& hi, bf16x8& lo) {
    const float v[8] = {a.x, a.y, a.z, a.w, b.x, b.y, b.z, b.w};
#pragma unroll
    for (int i = 0; i < 8; ++i) { const unsigned h = f2bf(v[i]); hi[i] = (short)h; lo[i] = (short)f2bf(v[i] - bf2f(h)); }
}
__device__ __forceinline__ void filter_gen(const float* HDNj  , const float* WOTj  , float* FT, int tid, int blk, int G) {
    const int lane = tid & 63, wv = tid >> 6, q4 = lane >> 4, r16 = lane & 15;
    for (int it = blk * 8 + wv; it < 128 * 16; it += G * 8) {
        const int ct = it >> 4, tb = it & 15, col0 = ct * 16;
        bf16x8 ah[2], al[2];
#pragma unroll
        for (int kk = 0; kk < 2; ++kk) { const f32x4* wp = (const f32x4*)(WOTj + (size_t)(col0 + r16) * FW + 32 * kk + 8 * q4); split_bf16x8(wp[0], wp[1], ah[kk], al[kk]); }
        float dl[4];
#pragma unroll
        for (int r = 0; r < 4; ++r) { const int ch = (col0 + 4 * q4 + r) & (D - 1); dl[r] = fabsf(HY_MIN_DECAY + (float)ch * ((HY_MAX_DECAY - HY_MIN_DECAY) / (float)(D - 1))) * (1.0f / (float)(SEQ - 1)); }
#pragma unroll 2
        for (int tt = 0; tt < 32; ++tt) {
            const int t = tb * 512 + tt * 16 + r16;
            f32x4 acc = (f32x4){0.f, 0.f, 0.f, 0.f};
#pragma unroll
            for (int kk = 0; kk < 2; ++kk) { const f32x4* hp = (const f32x4*)(HDNj + (size_t)t * FW + 32 * kk + 8 * q4); bf16x8 bh, bl; split_bf16x8(hp[0], hp[1], bh, bl);
                acc = __builtin_amdgcn_mfma_f32_16x16x32_bf16(al[kk], bh, acc, 0, 0, 0);
                acc = __builtin_amdgcn_mfma_f32_16x16x32_bf16(ah[kk], bl, acc, 0, 0, 0);
                acc = __builtin_amdgcn_mfma_f32_16x16x32_bf16(ah[kk], bh, acc, 0, 0, 0); }
#pragma unroll
            for (int r = 0; r < 4; ++r) FT[(size_t)(col0 + 4 * q4 + r) * SEQ + t] = acc[r] * __expf(-(float)t * dl[r]);
        }
    }
}

constexpr int S1_PV = 272, S1_PG = 48;
constexpr int S1_VL = 0, S1_GL = 2 * 64 * S1_PV, S1_KA = S1_GL + 2 * 64 * S1_PG, S1_SEG = S1_KA + 2 * 64 * 16, S1_ET = S1_SEG + 8 * 16 * 4, S1_END = S1_ET + 64;
typedef unsigned short u16x4v __attribute__((ext_vector_type(4)));
__device__ __forceinline__ void hg_scan1(const u16* GF, const u16* GB, const u16* V, u16* Sbuf, LAS unsigned char* lds, int tid, int blk, int G) {
    const int lane = tid & 63, wv = __builtin_amdgcn_readfirstlane(tid >> 6);
    const int q4 = lane >> 4, r16 = lane & 15;
    LAS float* SEGS = (LAS float*)(lds + S1_SEG); LAS float* ET = (LAS float*)(lds + S1_ET);
    for (int wi = blk; wi < 256; wi += G) {
        const int n = (wi >> 3) & 3, h = wi & 7, ds = wi >> 5, dir = n >> 1, b = n & 1;
        const int vrow = tid >> 3, vch = (tid & 7) * 2, grow = (tid >> 1) & 63, gch = tid & 1;
        const u16* Vg = V + ((size_t)b * SEQ + vrow) * D + h * DV + vch * 8;
        const u16* Gg = (dir ? GB : GF) + ((size_t)b * SEQ + grow) * D + h * DK + ds * 16 + gch * 8;
        u16* Sp = Sbuf + (size_t)(n * NH + h) * NCH * (DV * DK) + (size_t)((ds * DV + wv * 16 + r16) * 16 + 4 * q4);
        const unsigned vl_w = S1_VL + vrow * S1_PV + vch * 16, gl_w = S1_GL + grow * S1_PG + gch * 16;
        const int tp = tid >> 4, dkp = tid & 15;
        const unsigned gl_r = S1_GL + (2 * tp) * S1_PG + dkp * 2;
        const int t0 = 2 * tp, ka_w = S1_KA + (((t0 >> 5) * 64 + ((t0 & 31) >> 3) * 16 + dkp) * 8 + (t0 & 7)) * 2;
        const unsigned tr_a = S1_VL + (8 * q4 + (r16 >> 2)) * S1_PV + (16 * wv + 4 * (r16 & 3)) * 2;
        f32x4 S = (f32x4){0.f, 0.f, 0.f, 0.f};
        u32x4 av0, av1, ag, bv0, bv1, bg;
#define S1_LOAD(v0, v1, g, stp) do { const size_t co_ = (size_t)(dir ? (NCH - 1 - (stp)) : (stp)) * CH * D; v0 = *(const u32x4*)(Vg + co_); v1 = *(const u32x4*)(Vg + co_ + 8); g = *(const u32x4*)(Gg + co_); } while (0)
#define S1_STAGE(v0, v1, g, po) do { *(LAS u32x4*)(lds + vl_w + (po) * (64 * S1_PV)) = v0; *(LAS u32x4*)(lds + vl_w + (po) * (64 * S1_PV) + 16) = v1; if (tid < 128) *(LAS u32x4*)(lds + gl_w + (po) * (64 * S1_PG)) = g; } while (0)
        S1_LOAD(bv0, bv1, bg, 0); S1_STAGE(bv0, bv1, bg, 0);
        S1_LOAD(av0, av1, ag, 1); S1_LOAD(bv0, bv1, bg, 2);
        __syncthreads();
#define S1_STEP(step, p, v0, v1, g) do { \
            const int c = dir ? (NCH - 1 - (step)) : (step); \
            const float g0 = h2f(*(const LAS u16*)(lds + gl_r + (p) * (64 * S1_PG))), g1 = h2f(*(const LAS u16*)(lds + gl_r + (p) * (64 * S1_PG) + S1_PG)); \
            const float ps = g0 + g1; \
            const float p0 = __shfl(ps, r16), p1 = __shfl(ps, r16 + 16), p2 = __shfl(ps, r16 + 32), p3 = __shfl(ps, r16 + 48); \
            if (q4 == 0) SEGS[wv * 16 + dkp] = (p0 + p1) + (p2 + p3); \
            float w0, w1; \
            if (dir == 0) { const float aft = (q4 < 1 ? p1 : 0.f) + (q4 < 2 ? p2 : 0.f) + (q4 < 3 ? p3 : 0.f); w1 = aft; w0 = aft + g1; } \
            else          { const float bef = (q4 > 0 ? p0 : 0.f) + (q4 > 1 ? p1 : 0.f) + (q4 > 2 ? p2 : 0.f); w0 = bef; w1 = bef + g0; } \
            __syncthreads(); \
            if ((step) + 1 < NCH) S1_STAGE(v0, v1, g, (p) ^ 1);              \
            if ((step) + 3 < NCH) S1_LOAD(v0, v1, g, (step) + 3);            \
            { float tot = 0.f, off = 0.f; \
              _Pragma("unroll") for (int s2 = 0; s2 < 8; ++s2) { const float sg2 = SEGS[s2 * 16 + dkp]; tot += sg2; off += (dir ? (s2 < wv) : (s2 > wv)) ? sg2 : 0.f; } \
              const float k0 = (1.0f - __expf(g0)) * __expf(w0 + off), k1 = (1.0f - __expf(g1)) * __expf(w1 + off); \
              *(LAS unsigned*)(lds + ka_w) = pk2(k0, k1); \
              if (tid < 16) ET[dkp] = __expf(tot); } \
            __syncthreads(); \
            { u32x2 w; w.x = pk2(S[0], S[1]); w.y = pk2(S[2], S[3]); *(u32x2*)(Sp + (size_t)c * (DV * DK)) = w; } \
            const bf16x8 fa0 = *(const LAS bf16x8*)(lds + S1_KA + lane * 16), fa1 = *(const LAS bf16x8*)(lds + S1_KA + 1024 + lane * 16); \
            const f32x4 et = *(const LAS f32x4*)(ET + 4 * q4); \
            u16x4v r0, r1, r2, r3; \
            asm volatile("ds_read_b64_tr_b16 %0, %4\n\tds_read_b64_tr_b16 %1, %4 offset:1088\n\tds_read_b64_tr_b16 %2, %4 offset:8704\n\tds_read_b64_tr_b16 %3, %4 offset:9792\n\ts_waitcnt lgkmcnt(0)" \
                         : "=&v"(r0), "=&v"(r1), "=&v"(r2), "=&v"(r3) : "v"(tr_a + (p) * (64 * S1_PV)) : "memory"); \
            bf16x8 fb0, fb1; \
            _Pragma("unroll") for (int j = 0; j < 4; ++j) { fb0[j] = (short)r0[j]; fb0[4 + j] = (short)r1[j]; fb1[j] = (short)r2[j]; fb1[4 + j] = (short)r3[j]; } \
            S = S * et; \
            S = __builtin_amdgcn_mfma_f32_16x16x32_bf16(fa0, fb0, S, 0, 0, 0); \
            S = __builtin_amdgcn_mfma_f32_16x16x32_bf16(fa1, fb1, S, 0, 0, 0); } while (0)
#pragma unroll 1
        for (int step = 0; step < NCH; step += 2) {
            S1_STEP(step, 0, av0, av1, ag);
            S1_STEP(step + 1, 1, bv0, bv1, bg);
        }
#undef S1_STEP
#undef S1_LOAD
#undef S1_STAGE
        __syncthreads();
    }
}

constexpr int HO_LD = 136;
constexpr int HO_LV = 72;
constexpr int HO_QF = 0, HO_KF = 64 * HO_LD * 2, HO_KB = 2 * HO_KF, HO_QB = 3 * HO_KF, HO_VT = 4 * HO_KF, HO_AT = HO_VT + 128 * HO_LV * 2, HO_SEG = HO_AT + 64 * HO_LV * 2, HO_SSQ = HO_SEG + 2 * 4 * 128 * 4, HO_END = HO_SSQ + 64 * 8 * 4;
static_assert(HO_END <= RING_BYTES, "hg_out LDS");
__device__ __forceinline__ void hg_out(const u16* Qb, const u16* Vb, const u16* GTb, const u16* GF, const u16* GB, const u16* Sbuf, const float* hgn  , u16* ON,
                                       LAS unsigned char* lds, int tid, int blk, int G) {
    const int lane = tid & 63, wv = __builtin_amdgcn_readfirstlane(tid >> 6), q4 = lane >> 4, r16 = lane & 15;
    LAS u16* QF = (LAS u16*)(lds + HO_QF); LAS u16* KF = (LAS u16*)(lds + HO_KF); LAS u16* KBt = (LAS u16*)(lds + HO_KB); LAS u16* QBt = (LAS u16*)(lds + HO_QB);
    LAS u16* VT = (LAS u16*)(lds + HO_VT); LAS u16* AT = (LAS u16*)(lds + HO_AT); LAS float* SEG = (LAS float*)(lds + HO_SEG); LAS float* SSQ = (LAS float*)(lds + HO_SSQ);
    const int lrow = tid >> 3, lch = (tid & 7) * 16;
    const unsigned l_off = lrow * (HO_LD * 2) + lch * 2;
    const int NIT = NB * NH * NCH;
    u32x4 pq0, pq1, pf0, pf1, pb0, pb1, pv0, pv1;
#define HO_ITEM(it_, b_, h_, c_) const int b_ = (it_) / (NH * NCH), h_ = ((it_) / NCH) % NH, c_ = (it_) % NCH
#define HO_PREFETCH(it_) do { HO_ITEM(it_, b_, h_, c_); const size_t go_ = ((size_t)b_ * SEQ + (size_t)c_ * CH + lrow) * D + h_ * DK + lch; \
        pq0 = *(const u32x4*)(Qb + go_); pq1 = *(const u32x4*)(Qb + go_ + 8); pf0 = *(const u32x4*)(GF + go_); pf1 = *(const u32x4*)(GF + go_ + 8); \
        pb0 = *(const u32x4*)(GB + go_); pb1 = *(const u32x4*)(GB + go_ + 8); pv0 = *(const u32x4*)(Vb + go_); pv1 = *(const u32x4*)(Vb + go_ + 8); } while (0)
    if (blk < NIT) HO_PREFETCH(blk);
    for (int it = blk; it < NIT; it += G) {
        HO_ITEM(it, b, h, c);
        const size_t m0 = (size_t)b * SEQ + (size_t)c * CH;
        *(LAS u32x4*)(lds + HO_QF + l_off) = pq0; *(LAS u32x4*)(lds + HO_QF + l_off + 16) = pq1; *(LAS u32x4*)(lds + HO_KF + l_off) = pf0; *(LAS u32x4*)(lds + HO_KF + l_off + 16) = pf1;
        *(LAS u32x4*)(lds + HO_KB + l_off) = pb0; *(LAS u32x4*)(lds + HO_KB + l_off + 16) = pb1; *(LAS u32x4*)(lds + HO_QB + l_off) = pv0; *(LAS u32x4*)(lds + HO_QB + l_off + 16) = pv1;
        const size_t go = (m0 + lrow) * D + h * DV + lch;
        const u32x4 gt0 = *(const u32x4*)(GTb + go), gt1 = *(const u32x4*)(GTb + go + 8);
        bf16x8 sfr[4], sbr[4];
        {
          const u16* Sf = Sbuf + ((size_t)((0 * 2 + b) * NH + h) * NCH + c) * (DV * DK) + (size_t)(((q4 >> 1) * DV + 16 * wv + r16) * 16 + 8 * (q4 & 1));
          const u16* Sb = Sbuf + ((size_t)((1 * 2 + b) * NH + h) * NCH + c) * (DV * DK) + (size_t)(((q4 >> 1) * DV + 16 * wv + r16) * 16 + 8 * (q4 & 1));
#pragma unroll
          for (int kk = 0; kk < 4; ++kk) { sfr[kk] = *(const bf16x8*)(Sf + kk * (2 * DV * 16)); sbr[kk] = *(const bf16x8*)(Sb + kk * (2 * DV * 16)); } }
        if (it + G < NIT) HO_PREFETCH(it + G);
        __syncthreads();
        {
            const int d = tid & 127, ts = tid >> 7;
            float gf[16], gb[16], qv[16]; unsigned vv[16];
#pragma unroll
            for (int j = 0; j < 16; ++j) { const int o = (16 * ts + j) * HO_LD + d; qv[j] = bf2f(QF[o]); gf[j] = h2f(KF[o]); gb[j] = h2f(KBt[o]); vv[j] = QBt[o]; }
            { u32x4 w0, w1; w0.x = vv[0] | (vv[1] << 16); w0.y = vv[2] | (vv[3] << 16); w0.z = vv[4] | (vv[5] << 16); w0.w = vv[6] | (vv[7] << 16);
              w1.x = vv[8] | (vv[9] << 16); w1.y = vv[10] | (vv[11] << 16); w1.z = vv[12] | (vv[13] << 16); w1.w = vv[14] | (vv[15] << 16);
              *(LAS u32x4*)(VT + d * HO_LV + 16 * ts) = w0; *(LAS u32x4*)(VT + d * HO_LV + 16 * ts + 8) = w1; }
            float pf[16], sb[16];
            { float r = 0.f;
#pragma unroll
              for (int j = 0; j < 16; ++j) { r += gf[j]; pf[j] = r; }
              SEG[(0 * 4 + ts) * 128 + d] = r; r = 0.f;
#pragma unroll
              for (int j = 15; j >= 0; --j) { r += gb[j]; sb[j] = r; }
              SEG[(1 * 4 + ts) * 128 + d] = r; }
            __syncthreads();
            float offf = 0.f, offb = 0.f;
#pragma unroll
            for (int s2 = 0; s2 < 4; ++s2) { const float a = SEG[(0 * 4 + s2) * 128 + d], bb = SEG[(1 * 4 + s2) * 128 + d]; offf += (s2 < ts) ? a : 0.f; offb += (s2 > ts) ? bb : 0.f; }
#pragma unroll
            for (int j = 0; j < 16; ++j) {
                const float bf_ = offf + pf[j], bb_ = offb + sb[j];
                const float kf = 1.0f - __expf(gf[j]), kb = 1.0f - __expf(gb[j]);
                const int o = (16 * ts + j) * HO_LD + d;
                QF[o] = (u16)f2bf(qv[j] * __expf(bf_)); KF[o] = (u16)f2bf(kf * __expf(fminf(-bf_, 80.f)));
                QBt[o] = (u16)f2bf(qv[j] * __expf(bb_)); KBt[o] = (u16)f2bf(kb * __expf(fminf(-bb_, 80.f)));
            }
        }
        __syncthreads();
#pragma unroll 1
        for (int tt = 0; tt < 2; ++tt) {
            const int tile = 2 * wv + tt, ti = tile >> 2, si = tile & 3;
            f32x4 af = (f32x4){0.f, 0.f, 0.f, 0.f}, ab = (f32x4){0.f, 0.f, 0.f, 0.f};
            if (ti >= si) {
#pragma unroll
                for (int kk = 0; kk < 4; ++kk) { const bf16x8 a = *(const LAS bf16x8*)(QF + (16 * ti + r16) * HO_LD + 32 * kk + 8 * q4), bb = *(const LAS bf16x8*)(KF + (16 * si + r16) * HO_LD + 32 * kk + 8 * q4);
                    af = __builtin_amdgcn_mfma_f32_16x16x32_bf16(a, bb, af, 0, 0, 0); }
            }
            if (ti <= si) {
#pragma unroll
                for (int kk = 0; kk < 4; ++kk) { const bf16x8 a = *(const LAS bf16x8*)(QBt + (16 * ti + r16) * HO_LD + 32 * kk + 8 * q4), bb = *(const LAS bf16x8*)(KBt + (16 * si + r16) * HO_LD + 32 * kk + 8 * q4);
                    ab = __builtin_amdgcn_mfma_f32_16x16x32_bf16(a, bb, ab, 0, 0, 0); }
            }
#pragma unroll
            for (int r = 0; r < 4; ++r) { const int t = 16 * ti + 4 * q4 + r, s = 16 * si + r16;
                const float vsum = (s <= t ? af[r] : 0.f) + (s >= t ? ab[r] : 0.f);
                AT[t * HO_LV + s] = (u16)f2bf(vsum); }
        }
        __syncthreads();
        f32x4 o[4];
#pragma unroll
        for (int ti = 0; ti < 4; ++ti) o[ti] = (f32x4){0.f, 0.f, 0.f, 0.f};
        {
#pragma unroll
            for (int kk = 0; kk < 2; ++kk) { const bf16x8 bv = *(const LAS bf16x8*)(VT + (16 * wv + r16) * HO_LV + 32 * kk + 8 * q4);
#pragma unroll
                for (int ti = 0; ti < 4; ++ti) { const bf16x8 a = *(const LAS bf16x8*)(AT + (16 * ti + r16) * HO_LV + 32 * kk + 8 * q4); o[ti] = __builtin_amdgcn_mfma_f32_16x16x32_bf16(a, bv, o[ti], 0, 0, 0); } }
#pragma unroll
            for (int kk = 0; kk < 4; ++kk) {
#pragma unroll
                for (int ti = 0; ti < 4; ++ti) { const bf16x8 a = *(const LAS bf16x8*)(QF + (16 * ti + r16) * HO_LD + 32 * kk + 8 * q4); o[ti] = __builtin_amdgcn_mfma_f32_16x16x32_bf16(a, sfr[kk], o[ti], 0, 0, 0);
                    const bf16x8 a2 = *(const LAS bf16x8*)(QBt + (16 * ti + r16) * HO_LD + 32 * kk + 8 * q4); o[ti] = __builtin_amdgcn_mfma_f32_16x16x32_bf16(a2, sbr[kk], o[ti], 0, 0, 0); } }
        }
#pragma unroll
        for (int ti = 0; ti < 4; ++ti)
#pragma unroll
            for (int r = 0; r < 4; ++r) { float s = o[ti][r] * o[ti][r]; s += __shfl_xor(s, 1); s += __shfl_xor(s, 2); s += __shfl_xor(s, 4); s += __shfl_xor(s, 8);
                if (r16 == 0) SSQ[(16 * ti + 4 * q4 + r) * 8 + wv] = s; }
        __syncthreads();
        {
            const int dv = 16 * wv + r16; const float gn = hgn[dv];
#pragma unroll
            for (int ti = 0; ti < 4; ++ti)
#pragma unroll
                for (int r = 0; r < 4; ++r) { const int t = 16 * ti + 4 * q4 + r; const LAS f32x4* sp = (const LAS f32x4*)(SSQ + t * 8); const f32x4 s0 = sp[0], s1 = sp[1];
                    const float ss = (s0.x + s0.y + s0.z + s0.w) + (s1.x + s1.y + s1.z + s1.w);
                    const float rn = 1.0f / sqrtf(ss * (1.0f / DV) + NORM_EPS);
                    QF[t * HO_LD + dv] = (u16)f2bf(o[ti][r] * rn * gn); }
        }
        __syncthreads();
        {
            const u32x4 o0 = *(const LAS u32x4*)(lds + HO_QF + l_off), o1 = *(const LAS u32x4*)(lds + HO_QF + l_off + 16);
            u32x4 w0, w1;
#pragma unroll
            for (int i = 0; i < 4; ++i) { w0[i] = pk2(bf2f(o0[i] & 0xffffu) * bf2f(gt0[i] & 0xffffu), bf2f(o0[i] >> 16) * bf2f(gt0[i] >> 16));
                                          w1[i] = pk2(bf2f(o1[i] & 0xffffu) * bf2f(gt1[i] & 0xffffu), bf2f(o1[i] >> 16) * bf2f(gt1[i] >> 16)); }
            *(u32x4*)(ON + go) = w0; *(u32x4*)(ON + go + 8) = w1;
        }
        __syncthreads();
    }
#undef HO_ITEM
#undef HO_PREFETCH
}

__device__ __forceinline__ void hy_zprep(const u16* U, const float* cw  , const float* cbias  , f32x2* ZT, LAS unsigned char* lds, int tid, int blk, int G) {
    LAS float* zt = (LAS float*)lds;
    for (int it = blk; it < (SEQ / 64) * (D / 64); it += G) {
        const int tb = it >> 4, cbk = it & 15, t0 = tb * 64, c0 = cbk * 64;
        const int ch = tid & 63, tq = tid >> 6, c = c0 + ch;
        const float a0 = cw[0 * 3 * D + D + c], a1 = cw[1 * 3 * D + D + c], a2 = cw[2 * 3 * D + D + c], ab = cbias[D + c];
        const float v0 = cw[0 * 3 * D + 2 * D + c], v1 = cw[1 * 3 * D + 2 * D + c], v2 = cw[2 * 3 * D + 2 * D + c], vb = cbias[2 * D + c];
#pragma unroll
        for (int b = 0; b < 2; ++b) {
            float u1[10], uv[10];
#pragma unroll
            for (int i = 0; i < 10; ++i) { const int tt = t0 + tq * 8 - 1 + i; const bool ok = (tt >= 0) && (tt < SEQ);
                const size_t ro = ((size_t)b * SEQ + (ok ? tt : 0)) * (3 * D);
                u1[i] = ok ? bf2f(U[ro + D + c]) : 0.f; uv[i] = ok ? bf2f(U[ro + 2 * D + c]) : 0.f; }
#pragma unroll
            for (int i = 0; i < 8; ++i) { const float x1c = u1[i] * a0 + u1[i + 1] * a1 + u1[i + 2] * a2 + ab, vc = uv[i] * v0 + uv[i + 1] * v1 + uv[i + 2] * v2 + vb;
                zt[(ch * 65 + tq * 8 + i) * 2 + b] = x1c * vc; }
        }
        __syncthreads();
        { const int tt = tid & 63;
#pragma unroll
          for (int r = 0; r < 8; ++r) { const int chh = (tid >> 6) + 8 * r; f32x2 v; v.x = zt[(chh * 65 + tt) * 2]; v.y = zt[(chh * 65 + tt) * 2 + 1]; ZT[(size_t)(c0 + chh) * SEQ + t0 + tt] = v; } }
        __syncthreads();
    }
}
__device__ __forceinline__ void hy_gate(const u16* U, const float* cw, const float* cbias, const f32x2* YT, u16* YG, LAS unsigned char* lds, int tid, int blk, int G) {
    LAS float* zt = (LAS float*)lds;
    for (int it = blk; it < (SEQ / 64) * (D / 64); it += G) {
        const int tb = it >> 4, cbk = it & 15, t0 = tb * 64, c0 = cbk * 64;
        { const int tt = tid & 63;
#pragma unroll
          for (int r = 0; r < 8; ++r) { const int chh = (tid >> 6) + 8 * r; const f32x2 v = YT[(size_t)(c0 + chh) * SEQ + t0 + tt]; zt[(chh * 65 + tt) * 2] = v.x; zt[(chh * 65 + tt) * 2 + 1] = v.y; } }
        __syncthreads();
        const int ch = tid & 63, tq = tid >> 6, c = c0 + ch;
        const float a0 = cw[0 * 3 * D + c], a1 = cw[1 * 3 * D + c], a2 = cw[2 * 3 * D + c], ab = cbias[c];
#pragma unroll
        for (int b = 0; b < 2; ++b) {
            float u0[10];
#pragma unroll
            for (int i = 0; i < 10; ++i) { const int tt = t0 + tq * 8 - 1 + i; const bool ok = (tt >= 0) && (tt < SEQ);
                const size_t ro = ((size_t)b * SEQ + (ok ? tt : 0)) * (3 * D); u0[i] = ok ? bf2f(U[ro + c]) : 0.f; }
#pragma unroll
            for (int i = 0; i < 8; ++i) { const float x0c = u0[i] * a0 + u0[i + 1] * a1 + u0[i + 2] * a2 + ab;
                YG[((size_t)b * SEQ + t0 + tq * 8 + i) * D + c] = (u16)f2bf(x0c * zt[(ch * 65 + tq * 8 + i) * 2 + b]); }
        }
        __syncthreads();
    }
}
__device__ __forceinline__ int fpad(int e) { return e + ((e >> 6) << 2); }
__device__ __forceinline__ f32x2 cmul(f32x2 a, f32x2 b) { f32x2 r; r.x = a.x * b.x - a.y * b.y; r.y = a.x * b.y + a.y * b.x; return r; }
__device__ __forceinline__ f32x2 cmulc(f32x2 a, f32x2 b) { f32x2 r; r.x = a.x * b.x + a.y * b.y; r.y = a.y * b.x - a.x * b.y; return r; }
template <bool INV> __device__ __forceinline__ void radix4(f32x2& a0, f32x2& a1, f32x2& a2, f32x2& a3) {
    const f32x2 t0 = a0 + a2, t1 = a0 - a2, t2 = a1 + a3, t3 = a1 - a3;
    a0 = t0 + t2; a2 = t0 - t2;
    if (!INV) { a1.x = t1.x + t3.y; a1.y = t1.y - t3.x; a3.x = t1.x - t3.y; a3.y = t1.y + t3.x; }
    else      { a1.x = t1.x - t3.y; a1.y = t1.y + t3.x; a3.x = t1.x + t3.y; a3.y = t1.y - t3.x; }
}
template <bool INV> __device__ __forceinline__ void dft16(f32x2 (&x)[16]) {
    constexpr float C1 = 0.92387953251128674f, S1 = 0.38268343236508977f, R2 = 0.70710678118654752f;
#pragma unroll
    for (int b = 0; b < 4; ++b) radix4<INV>(x[b], x[4 + b], x[8 + b], x[12 + b]);
    const f32x2 W1 = {C1, -S1}, W2 = {R2, -R2}, W3 = {S1, -C1}, W4 = {0.f, -1.f}, W6 = {-R2, -R2}, W9 = {-C1, S1};
    if (!INV) { x[5] = cmul(x[5], W1); x[9] = cmul(x[9], W2); x[13] = cmul(x[13], W3); x[6] = cmul(x[6], W2); x[10] = cmul(x[10], W4); x[14] = cmul(x[14], W6); x[7] = cmul(x[7], W3); x[11] = cmul(x[11], W6); x[15] = cmul(x[15], W9); }
    else      { x[5] = cmulc(x[5], W1); x[9] = cmulc(x[9], W2); x[13] = cmulc(x[13], W3); x[6] = cmulc(x[6], W2); x[10] = cmulc(x[10], W4); x[14] = cmulc(x[14], W6); x[7] = cmulc(x[7], W3); x[11] = cmulc(x[11], W6); x[15] = cmulc(x[15], W9); }
#pragma unroll
    for (int c = 0; c < 4; ++c) radix4<INV>(x[4 * c], x[4 * c + 1], x[4 * c + 2], x[4 * c + 3]);
    f32x2 y[16];
#pragma unroll
    for (int c = 0; c < 4; ++c)
#pragma unroll
        for (int d = 0; d < 4; ++d) y[c + 4 * d] = x[4 * c + d];
#pragma unroll
    for (int i = 0; i < 16; ++i) x[i] = y[i];
}
template <bool CONJ> __device__ __forceinline__ void apply_twid(f32x2 (&x)[16], float f) {
    const f32x2 w1 = {cos_rev(f), -sin_rev(f)}, w8 = {cos_rev(8.f * f), -sin_rev(8.f * f)};
    f32x2 wc = w1;
#pragma unroll
    for (int m = 1; m < 16; ++m) { if (m == 8) wc = w8; x[m] = CONJ ? cmulc(x[m], wc) : cmul(x[m], wc); if (m != 7 && m != 15) wc = cmul(wc, w1); }
}
template <bool INV> __device__ __forceinline__ void fft_pass64(LAS f32x2* a, int tid) {
#pragma unroll 1
    for (int k = 0; k < 2; ++k) {
        const int u = tid + 512 * k, j = u & 63;
        LAS f32x2* p = a + (u >> 6) * 1088 + j;
        f32x2 x[16];
#pragma unroll
        for (int q = 0; q < 16; ++q) x[q] = p[68 * q];
        if (!INV) { dft16<false>(x); apply_twid<false>(x, (float)j * (1.0f / 1024.0f)); }
        else { apply_twid<true>(x, (float)j * (1.0f / 1024.0f)); dft16<true>(x); }
#pragma unroll
        for (int q = 0; q < 16; ++q) p[68 * q] = x[q];
    }
}
__device__ __forceinline__ void conv3_x8(const u16* urow, int t0, const float (&w)[4], float (&out)[8]) {
    const u32x4 r = *(const u32x4*)(urow + t0);
    const int tm = (t0 > 0) ? t0 - 1 : 0, tp = (t0 + 8 < SEQ) ? t0 + 8 : SEQ - 1;
    const float hm = bf2f(urow[tm]), hp = bf2f(urow[tp]);
    float e[10];
    e[0] = (t0 > 0) ? hm : 0.f; e[9] = (t0 + 8 < SEQ) ? hp : 0.f;
#pragma unroll
    for (int i = 0; i < 4; ++i) { e[1 + 2 * i] = bf2f(r[i] & 0xffffu); e[2 + 2 * i] = bf2f(r[i] >> 16); }
#pragma unroll
    for (int i = 0; i < 8; ++i) out[i] = e[i] * w[0] + e[i + 1] * w[1] + e[i + 2] * w[2] + w[3];
}
__device__ __forceinline__ void fft_stage_z(const u16* u1  , const u16* uv, const float (&w1)[4], const float (&wv)[4], LAS f32x2* a, int tid) {
#pragma unroll 1
    for (int k = 0; k < 2; ++k) {
        const int t0 = (tid + 512 * k) * 8;
        float a0[8], b0[8], a1[8], b1[8];
        conv3_x8(u1, t0, w1, a0); conv3_x8(uv, t0, wv, b0); conv3_x8(u1 + SEQ, t0, w1, a1); conv3_x8(uv + SEQ, t0, wv, b1);
        LAS f32x4* p = (LAS f32x4*)(a + t0 + ((t0 >> 6) << 2));
#pragma unroll
        for (int i = 0; i < 4; ++i) { f32x4 v; v.x = a0[2 * i] * b0[2 * i]; v.y = a1[2 * i] * b1[2 * i]; v.z = a0[2 * i + 1] * b0[2 * i + 1]; v.w = a1[2 * i + 1] * b1[2 * i + 1]; p[i] = v; }
    }
}
__device__ __forceinline__ void fft_p1_lds(LAS f32x2* a, int tid) {
#pragma unroll 1
    for (int k = 0; k < 2; ++k) {
        const int j = tid + 512 * k;
        LAS f32x2* p = a + j + ((j >> 6) << 2);
        f32x2 x[16];
#pragma unroll
        for (int q = 0; q < 8; ++q) x[q] = p[1088 * q];
#pragma unroll
        for (int q = 8; q < 16; ++q) x[q] = (f32x2){0.f, 0.f};
        dft16<false>(x); apply_twid<false>(x, (float)j * (1.0f / 16384.0f));
#pragma unroll
        for (int m = 0; m < 16; ++m) p[1088 * m] = x[m];
    }
}
__device__ __forceinline__ void fft_p1_filt(const float* hf, const float* hb, LAS f32x2* a, int tid) {
#pragma unroll 1
    for (int k = 0; k < 2; ++k) {
        const int j = tid + 512 * k;
        LAS f32x2* p = a + j + ((j >> 6) << 2);
        f32x2 x[16];
#pragma unroll
        for (int q = 0; q < 8; ++q) x[q] = (f32x2){hf[j + 1024 * q], 0.f};
#pragma unroll
        for (int q = 8; q < 16; ++q) { const int idx = 2 * SEQ - j - 1024 * q; x[q] = (f32x2){(idx < SEQ) ? hb[idx] : 0.f, 0.f}; }
        dft16<false>(x); apply_twid<false>(x, (float)j * (1.0f / 16384.0f));
#pragma unroll
        for (int m = 0; m < 16; ++m) p[1088 * m] = x[m];
    }
}
__device__ __forceinline__ void fft_last_inv_lds(LAS f32x2* a, int tid) {
#pragma unroll 1
    for (int k = 0; k < 2; ++k) {
        const int j = tid + 512 * k;
        LAS f32x2* p = a + j + ((j >> 6) << 2);
        f32x2 x[16];
#pragma unroll
        for (int m = 0; m < 16; ++m) x[m] = p[1088 * m];
        apply_twid<true>(x, (float)j * (1.0f / 16384.0f)); dft16<true>(x);
#pragma unroll
        for (int q = 0; q < 8; ++q) p[1088 * q] = x[q];
    }
}
__device__ __forceinline__ void fft_gate_out(const LAS f32x2* a, const u16* u0, const float (&w0)[4], u16* yg, int tid) {
#pragma unroll 1
    for (int k = 0; k < 2; ++k) {
        const int t0 = (tid + 512 * k) * 8;
        float g0[8], g1[8];
        conv3_x8(u0, t0, w0, g0); conv3_x8(u0 + SEQ, t0, w0, g1);
        const LAS f32x4* p = (const LAS f32x4*)(a + t0 + ((t0 >> 6) << 2));
        u32x4 o0, o1;
#pragma unroll
        for (int i = 0; i < 4; ++i) { const f32x4 v = p[i]; o0[i] = pk2(v.x * g0[2 * i], v.z * g0[2 * i + 1]); o1[i] = pk2(v.y * g1[2 * i], v.w * g1[2 * i + 1]); }
        *(u32x4*)(yg + t0) = o0; *(u32x4*)(yg + SEQ + t0) = o1;
    }
}
__device__ __forceinline__ float dpp_x2(float v) { return __builtin_bit_cast(float, __builtin_amdgcn_update_dpp(0, __builtin_bit_cast(int, v), 0x4E, 0xF, 0xF, false)); }
__device__ __forceinline__ float dpp_x1(float v) { return __builtin_bit_cast(float, __builtin_amdgcn_update_dpp(0, __builtin_bit_cast(int, v), 0xB1, 0xF, 0xF, false)); }
__device__ __forceinline__ f32x2 quad_fwd(f32x2 z, float s2, float s1, float rc, float rs) {
    f32x2 p; p.x = dpp_x2(z.x) + s2 * z.x; p.y = dpp_x2(z.y) + s2 * z.y;
    f32x2 r; r.x = rc * p.x + rs * p.y; r.y = rc * p.y - rs * p.x;
    f32x2 o; o.x = dpp_x1(r.x) + s1 * r.x; o.y = dpp_x1(r.y) + s1 * r.y;
    return o;
}
__device__ __forceinline__ f32x2 quad_inv(f32x2 o, float s2, float s1, float rc, float rs) {
    f32x2 p; p.x = dpp_x1(o.x) + s1 * o.x; p.y = dpp_x1(o.y) + s1 * o.y;
    f32x2 r; r.x = rc * p.x - rs * p.y; r.y = rc * p.y + rs * p.x;
    f32x2 z; z.x = dpp_x2(r.x) + s2 * r.x; z.y = dpp_x2(r.y) + s2 * r.y;
    return z;
}
__device__ __forceinline__ void fft_mid_filter(LAS f32x2* a, f32x2* Hg  , float skipv, int u) {
    const int j = u & 3;
    const float s2 = (j & 2) ? -1.f : 1.f, s1 = (j & 1) ? -1.f : 1.f, rc = (j == 3) ? 0.f : 1.f, rs = (j == 3) ? 1.f : 0.f;
    const LAS f32x2* p = a + (u >> 2) * 68 + j;
    f32x2 x[16];
#pragma unroll
    for (int q = 0; q < 16; ++q) x[q] = p[4 * q];
    dft16<false>(x); apply_twid<false>(x, (float)j * (1.0f / 64.0f));
#pragma unroll
    for (int m = 0; m < 16; ++m) { f32x2 v = quad_fwd(x[m], s2, s1, rc, rs); v = v * (1.0f / 16384.0f); v.x += skipv * (1.0f / 16384.0f); Hg[512 * m] = v; }
}
__device__ __forceinline__ void fft_mid_z(LAS f32x2* a, const f32x2* Hg, int u) {
    const int j = u & 3;
    const float s2 = (j & 2) ? -1.f : 1.f, s1 = (j & 1) ? -1.f : 1.f, rc = (j == 3) ? 0.f : 1.f, rs = (j == 3) ? 1.f : 0.f;
    LAS f32x2* p = a + (u >> 2) * 68 + j;
    f32x2 x[16], H[16];
#pragma unroll
    for (int m = 0; m < 16; ++m) H[m] = Hg[512 * m];
#pragma unroll
    for (int q = 0; q < 16; ++q) x[q] = p[4 * q];
    dft16<false>(x); apply_twid<false>(x, (float)j * (1.0f / 64.0f));
#pragma unroll
    for (int m = 0; m < 16; ++m) x[m] = quad_inv(cmul(quad_fwd(x[m], s2, s1, rc, rs), H[m]), s2, s1, rc, rs);
    apply_twid<true>(x, (float)j * (1.0f / 64.0f)); dft16<true>(x);
#pragma unroll
    for (int q = 0; q < 16; ++q) p[4 * q] = x[q];
}
constexpr int FFT_LDS_BYTES = (16384 + 1024) * 8;
__device__ __forceinline__ void hy_fftconv(const u16* UT  , const float* cw  , const float* cbias  , const float* FT, f32x2* HS, const float* skip, u16* YGT  ,
                                           LAS unsigned char* lds, int tid0, int blk, int G) {
    LAS f32x2* a = (LAS f32x2*)lds;
#define OPQT() ({ int _t = tid0; asm volatile("" : "+v"(_t)); _t; })
#pragma unroll 1
    for (int ch = blk; ch < D; ch += G) {
        { const int tid = OPQT(); fft_p1_filt(FT + (size_t)ch * SEQ, FT + (size_t)(D + ch) * SEQ, a, tid); }
        __syncthreads();
        { const int tid = OPQT(); fft_pass64<false>(a, tid); }
        __syncthreads();
        { const int tid = OPQT(); f32x2* hs = HS + (size_t)blk * 16384 + tid; const float sk = skip[ch]; fft_mid_filter(a, hs, sk, tid); }
        { const int tid = OPQT(); f32x2* hs = HS + (size_t)blk * 16384 + tid; const float sk = skip[ch]; fft_mid_filter(a, hs + 8192, sk, tid + 512); }
        __syncthreads();
        { const int tid = OPQT();
          const float w1[4] = {cw[0 * 3 * D + D + ch], cw[1 * 3 * D + D + ch], cw[2 * 3 * D + D + ch], cbias[D + ch]};
          const float wv[4] = {cw[0 * 3 * D + 2 * D + ch], cw[1 * 3 * D + 2 * D + ch], cw[2 * 3 * D + 2 * D + ch], cbias[2 * D + ch]};
          fft_stage_z(UT + (size_t)(D + ch) * M, UT + (size_t)(2 * D + ch) * M, w1, wv, a, tid); }
        __syncthreads();
        { const int tid = OPQT(); fft_p1_lds(a, tid); }
        __syncthreads();
        { const int tid = OPQT(); fft_pass64<false>(a, tid); }
        __syncthreads();
        { const int tid = OPQT(); const f32x2* hs = HS + (size_t)blk * 16384 + tid; fft_mid_z(a, hs, tid); }
        { const int tid = OPQT(); const f32x2* hs = HS + (size_t)blk * 16384 + tid; fft_mid_z(a, hs + 8192, tid + 512); }
        __syncthreads();
        { const int tid = OPQT(); fft_pass64<true>(a, tid); }
        __syncthreads();
        { const int tid = OPQT(); fft_last_inv_lds(a, tid); }
        __syncthreads();
        { const int tid = OPQT();
          const float w0[4] = {cw[0 * 3 * D + ch], cw[1 * 3 * D + ch], cw[2 * 3 * D + ch], cbias[ch]};
          fft_gate_out(a, UT + (size_t)ch * M, w0, YGT + (size_t)ch * M, tid); }
        __syncthreads();
    }
#undef OPQT
}
__device__ __forceinline__ void transpose_cm(const u16* src, u16* dst, LAS unsigned char* lds, int tid, int blk, int G) {
    LAS u16* tile = (LAS u16*)lds;
    for (int it = blk; it < (D / 64) * (M / 64); it += G) {
        const int c0 = (it & 15) * 64, m0 = (it >> 4) * 64;
        { const int chl = tid >> 3, seg = tid & 7; const u32x4 v = *(const u32x4*)(src + (size_t)(c0 + chl) * M + m0 + seg * 8); *(LAS u32x4*)(tile + chl * 72 + seg * 8) = v; }
        __syncthreads();
        { const int ml = tid >> 3, cs = tid & 7; unsigned e[8];
#pragma unroll
          for (int i = 0; i < 8; ++i) e[i] = tile[(cs * 8 + i) * 72 + ml];
          u32x4 w; w.x = e[0] | (e[1] << 16); w.y = e[2] | (e[3] << 16); w.z = e[4] | (e[5] << 16); w.w = e[6] | (e[7] << 16);
          *(u32x4*)(dst + (size_t)(m0 + ml) * D + c0 + cs * 8) = w; }
        __syncthreads();
    }
}


#ifndef PROBE_KIND
#define PROBE_KIND 0
#endif
#define PH_BEGIN(kind) const unsigned long long _t0 = (PROBE_KIND == (kind)) ? __builtin_amdgcn_s_memrealtime() : 0ull
#define PH_END(kind) do { if (PROBE_KIND == (kind)) { __syncthreads(); const unsigned long long _dt = __builtin_amdgcn_s_memrealtime() - _t0; \
    while (__builtin_amdgcn_s_memrealtime() - _t0 < 2 * _dt) __builtin_amdgcn_s_sleep(8); } } while (0)
struct Args { const float* in[23]; float* out; unsigned char* ws; int ph_lo, ph_hi, li, pad; };

__global__ void __launch_bounds__(512, 2) mega_fwd(Args args) {
    extern __shared__ __attribute__((aligned(16))) unsigned char lds_raw[];
    LAS unsigned char* lds = (LAS unsigned char*)lds_raw;
    volatile LAS unsigned* MISC = (volatile LAS unsigned*)(lds + MISC_OFF);
    for (int u = threadIdx.x; u < (LDS_BYTES - LDSCTL_OFF) / 4; u += 512) ((LAS unsigned*)(lds + LDSCTL_OFF))[u] = 0u;
    __syncthreads();
    XcdBarrier bar; bar.bar = (unsigned*)(args.ws + WS_CTL) + CW_BAR + args.li * XCD_BAR_WORDS; bar.x = 0; bar.st = nullptr;
#if !MK_PER_PHASE
    bar = xcd_barrier_post((unsigned*)(args.ws + WS_CTL) + CW_BAR + args.li * XCD_BAR_WORDS, MISC + 8);
#endif
    const int lo = args.ph_lo, hi = args.ph_hi;
    int pc = 0;
#define RUN() (pc >= lo && pc < hi)
#if MK_PER_PHASE
#define SEAM() do { ++pc; } while (0)
#else
#define SEAM() do { ++pc; if (pc > lo && pc < hi) xcd_barrier(bar); } while (0)
#endif
#define COORDS() const int tid = opq_tid(), lane = tid & 63, wave = __builtin_amdgcn_readfirstlane(tid >> 6); const int G = opq_s((int)gridDim.x), blk = opq_s((int)blockIdx.x); \
                 const int gw = blk * 8 + wave, NGW = G * 8; unsigned char* ws = arg_ws(); (void)lane; (void)gw; (void)NGW; (void)ws
#define SCR() ((LAS float*)(lds + wave * 16384))

    if (RUN()) { COORDS(); PH_BEGIN(9); phase_p0(arg_in(1), arg_in(2), arg_in(3), (float*)(ws + WS_ADA), arg_in(13), arg_in(14), arg_in(15), arg_in(16), (float*)(ws + WS_HDN), arg_in(17), (float*)(ws + WS_WOT), lds, tid, blk, G);  PH_END(9); }
    SEAM();

#pragma unroll 1
    for (int layer = 0; layer < DEPTH; ++layer) {
        const int jl = layer >> 1;
        if ((layer & 1) == 0) {
            if (RUN()) { COORDS(); PH_BEGIN(5); const unsigned long long _t1 = (PROBE_KIND == 10) ? __builtin_amdgcn_s_memrealtime() : 0ull;
                convert_weights(arg_in(5) + (size_t)jl * D * 5 * D, D, 5 * D, (u16*)(ws + WS_WIN), arg_in(8) + (size_t)jl * D * D, D, D, (u16*)(ws + WS_WOUT),
                                arg_in(20) + (size_t)layer * D * FF, D, FF, (u16*)(ws + WS_W1), arg_in(21) + (size_t)layer * FF * D, FF, D, (u16*)(ws + WS_W2), SCR(), gw, NGW, lane);
                if (PROBE_KIND == 10) { __syncthreads(); const unsigned long long _dt = __builtin_amdgcn_s_memrealtime() - _t1; while (__builtin_amdgcn_s_memrealtime() - _t1 < 2 * _dt) __builtin_amdgcn_s_sleep(8); }
                norm_rows(layer == 0 ? arg_in(0) : arg_out(), arg_in(4) + (size_t)(layer * 2 + 0) * D, (const float*)(ws + WS_ADA) + (size_t)(layer * 2 + 0) * 2 * 3 * D, (u16*)(ws + WS_HN), gw, NGW, lane);
             PH_END(5); }
            SEAM();
            if (RUN()) { COORDS(); PH_BEGIN(1);
                pg8::Gemm g{(const u16*)(ws + WS_HN), (const u16*)(ws + WS_WIN), M, 5 * D, D}; pg8::StaticOrder S; S.init(M, 5 * D, G, blk);
                pg8::EpiHgIn E{(u16*)(ws + WS_Q), (u16*)(ws + WS_V), (u16*)(ws + WS_GT), (u16*)(ws + WS_GF), (u16*)(ws + WS_GB), arg_in(6), jl};
                pg8::gemm_phase<pg8::EpiHgIn, pg8::StaticOrder, true, true>(lds, g, S, E);
             PH_END(1); }
            SEAM();
            if (RUN()) { COORDS(); PH_BEGIN(2); hg_scan1((const u16*)(ws + WS_GF), (const u16*)(ws + WS_GB), (const u16*)(ws + WS_V), (u16*)(ws + WS_S), lds, tid, blk, G);  PH_END(2); }
            SEAM();
            if (RUN()) { COORDS(); PH_BEGIN(3); hg_out((const u16*)(ws + WS_Q), (const u16*)(ws + WS_V), (const u16*)(ws + WS_GT), (const u16*)(ws + WS_GF), (const u16*)(ws + WS_GB), (const u16*)(ws + WS_S),
                              arg_in(7) + (size_t)jl * DV, (u16*)(ws + WS_HN), lds, tid, blk, G);  PH_END(3); }
            SEAM();
        } else {
            if (RUN()) { COORDS(); PH_BEGIN(5); const unsigned long long _t1 = (PROBE_KIND == 10) ? __builtin_amdgcn_s_memrealtime() : 0ull;
                convert_weights(arg_in(9) + (size_t)jl * D * 3 * D, D, 3 * D, (u16*)(ws + WS_WIN), arg_in(19) + (size_t)jl * D * D, D, D, (u16*)(ws + WS_WOUT),
                                arg_in(20) + (size_t)layer * D * FF, D, FF, (u16*)(ws + WS_W1), arg_in(21) + (size_t)layer * FF * D, FF, D, (u16*)(ws + WS_W2), SCR(), gw, NGW, lane);
                if (PROBE_KIND == 10) { __syncthreads(); const unsigned long long _dt = __builtin_amdgcn_s_memrealtime() - _t1; while (__builtin_amdgcn_s_memrealtime() - _t1 < 2 * _dt) __builtin_amdgcn_s_sleep(8); }
                norm_rows(arg_out(), arg_in(4) + (size_t)(layer * 2 + 0) * D, (const float*)(ws + WS_ADA) + (size_t)(layer * 2 + 0) * 2 * 3 * D, (u16*)(ws + WS_HN), gw, NGW, lane);
                const unsigned long long _t2 = (PROBE_KIND == 11) ? __builtin_amdgcn_s_memrealtime() : 0ull;
                filter_gen((const float*)(ws + WS_HDN) + (size_t)jl * SEQ * FW, (const float*)(ws + WS_WOT) + (size_t)jl * 2 * D * FW, (float*)(ws + WS_FT), tid, blk, G);
                if (PROBE_KIND == 11) { __syncthreads(); const unsigned long long _dt = __builtin_amdgcn_s_memrealtime() - _t2; while (__builtin_amdgcn_s_memrealtime() - _t2 < 2 * _dt) __builtin_amdgcn_s_sleep(8); }
             PH_END(5); }
            SEAM();
            if (RUN()) { COORDS(); PH_BEGIN(1);
                pg8::Gemm g{(const u16*)(ws + WS_WIN), (const u16*)(ws + WS_HN), 3 * D, M, D}; pg8::StaticOrder S; S.init(3 * D, M, G, blk);
                pg8::EpiRowBias E{(u16*)(ws + WS_U), M, arg_in(10) + (size_t)jl * 3 * D};
                pg8::gemm_phase<pg8::EpiRowBias, pg8::StaticOrder, true, true>(lds, g, S, E);
                 PH_END(1); }
            SEAM();
            if (RUN()) { COORDS(); PH_BEGIN(4); hy_fftconv((const u16*)(ws + WS_U), arg_in(11) + (size_t)jl * 3 * 3 * D, arg_in(12) + (size_t)jl * 3 * D, (const float*)(ws + WS_FT), (f32x2*)(ws + WS_HS),
                                                       arg_in(18) + (size_t)jl * D, (u16*)(ws + WS_ZT), lds, tid, blk, G);  PH_END(4); }
            SEAM();
            if (RUN()) { COORDS(); PH_BEGIN(6); transpose_cm((const u16*)(ws + WS_ZT), (u16*)(ws + WS_HN), lds, tid, blk, G);  PH_END(6); }
            SEAM();
        }
        if (RUN()) { COORDS(); PH_BEGIN(7);
            pg8::Gemm g{(const u16*)(ws + WS_HN), (const u16*)(ws + WS_WOUT), M, D, D}; pg8::StaticOrder S; S.init(M, D, G, blk);
            pg8::EpiResid E{layer == 0 ? arg_in(0) : arg_out(), arg_out(), (const float*)(ws + WS_ADA) + (size_t)(layer * 2 + 0) * 2 * 3 * D + 2 * D};
            pg8::gemm_phase<pg8::EpiResid, pg8::StaticOrder, true, true>(lds, g, S, E);
         PH_END(7); }
        SEAM();
        if (RUN()) { COORDS(); PH_BEGIN(5); norm_rows(arg_out(), arg_in(4) + (size_t)(layer * 2 + 1) * D, (const float*)(ws + WS_ADA) + (size_t)(layer * 2 + 1) * 2 * 3 * D, (u16*)(ws + WS_HN), gw, NGW, lane);  PH_END(5); }
        SEAM();
        if (RUN()) { COORDS(); PH_BEGIN(8);
            pg8::Gemm g{(const u16*)(ws + WS_HN), (const u16*)(ws + WS_W1), M, FF, D}; pg8::StaticOrder S; S.init(M, FF, G, blk);
            pg8::EpiRelu2 E{(u16*)(ws + WS_H), FF};
            pg8::gemm_phase<pg8::EpiRelu2, pg8::StaticOrder, true, true>(lds, g, S, E);
         PH_END(8); }
        SEAM();
        if (RUN()) { COORDS(); PH_BEGIN(7);
            pg8::Gemm g{(const u16*)(ws + WS_H), (const u16*)(ws + WS_W2), M, D, FF}; pg8::StaticOrder S; S.init(M, D, G, blk);
            pg8::EpiResid E{arg_out(), arg_out(), (const float*)(ws + WS_ADA) + (size_t)(layer * 2 + 1) * 2 * 3 * D + 2 * D};
            pg8::gemm_phase<pg8::EpiResid, pg8::StaticOrder, true, true>(lds, g, S, E);
         PH_END(7); }
        SEAM();
    }
    if (RUN()) { COORDS(); PH_BEGIN(5); final_norm_rows(arg_out(), arg_in(22), gw, NGW, lane);  PH_END(5); }
#undef RUN
#undef SEAM
#undef COORDS
#undef SCR
}

constexpr int N_PHASES = 1 + 2 * 8 + 2 * 8 + 1;

extern "C" void kernel_launch(void* const* d_in, const int* in_sizes, int n_in, void* d_out, int out_size, void* d_ws, size_t ws_size, hipStream_t stream) {
    static int grid = 0;
    if (grid == 0) {
        if (n_in != 23 || in_sizes[0] != M * D || out_size != M * D || ws_size < WS_END) {
            fprintf(stderr, "kernel_launch: unexpected problem: n_in %d in0 %d out %d ws %zu (need %zu)\n", n_in, n_in > 0 ? in_sizes[0] : -1, out_size, ws_size, (size_t)WS_END); grid = -1; return; }
        int dev = 0, cus = 0;
        if (hipGetDevice(&dev) != hipSuccess || hipDeviceGetAttribute(&cus, hipDeviceAttributeMultiprocessorCount, dev) != hipSuccess) { grid = -1; return; }
        if (hipFuncSetAttribute((const void*)mega_fwd, hipFuncAttributeMaxDynamicSharedMemorySize, LDS_BYTES) != hipSuccess) { fprintf(stderr, "kernel_launch: hipFuncSetAttribute failed\n"); grid = -1; return; }
        int per_cu = 0;
        if (hipOccupancyMaxActiveBlocksPerMultiprocessor(&per_cu, (const void*)mega_fwd, 512, LDS_BYTES) != hipSuccess || per_cu < 1)
            fprintf(stderr, "kernel_launch: occupancy query reports %d per CU\n", per_cu);
        (void)hipGetLastError();
        grid = cus;
    }
    if (grid < 0) return;
    if (hipMemsetAsync((char*)d_ws + WS_CTL, 0, CTL_ZERO_BYTES, stream) != hipSuccess) { fprintf(stderr, "kernel_launch: memset failed\n"); return; }
    Args a{};
    for (int i = 0; i < 23; ++i) a.in[i] = (const float*)d_in[i];
    a.out = (float*)d_out; a.ws = (unsigned char*)d_ws;
#if MK_PER_PHASE
    for (int p = 0; p < N_PHASES; ++p) { a.ph_lo = p; a.ph_hi = p + 1; a.li = 0; hipLaunchKernelGGL(mega_fwd, dim3(grid), dim3(512), LDS_BYTES, stream, a); }
#else
    a.ph_lo = 0; a.ph_hi = N_PHASES; a.li = 0;
    hipLaunchKernelGGL(mega_fwd, dim3(grid), dim3(512), LDS_BYTES, stream, a);
#endif
    const hipError_t le = hipPeekAtLastError();
    if (le != hipSuccess) fprintf(stderr, "kernel_launch: launch failed: %s\n", hipGetErrorName(le));
}
```
